# Optimizing an MI355X kernel written in HIP

```python
import jax, jax.numpy as jnp
from jax import lax
import numpy as np

D_MODEL = 2048
BATCH = 4
SEQ = 2048
DEPTH = 2

N_META = 16
CONF_W = 1024
CONF_K = 31
SC_W = 1024
SC_K = 3
AB_SIZES = (CONF_W, CONF_W, SC_W, SC_W, SC_W)
AB_IN = sum(AB_SIZES)
GLA_HEADS = 4
GLA_DK = 128
GLA_DV = 256
GLA_QK = GLA_HEADS * GLA_DK
GLA_V = GLA_HEADS * GLA_DV
GLA_RANK = 16
GLA_GATE_NORM = 16.0
GLA_CHUNK = 64
GLA_SIZES = (GLA_QK, GLA_QK, GLA_V, GLA_V, GLA_RANK)
RW_HEADS = 16
RW_N = 64
RW_W = RW_HEADS * RW_N
RW_DECAY_RANK = 64
RW_A_RANK = 64
RW_G_RANK = 128
RW_SIZES = (RW_W, RW_W, RW_W, RW_DECAY_RANK, RW_A_RANK, RW_G_RANK)
GLA_COLS = sum(GLA_SIZES)
RW_COLS = sum(RW_SIZES)
CD_IN = GLA_COLS + RW_COLS
RW_GN_EPS = 64e-5
D_FF = 5632
FFN_K = 3
EPS = 1e-6
LN_EPS = 1e-5
N_EVEN = (DEPTH + 1) // 2
N_ODD = DEPTH // 2

kernel_name = "hybrid_conv_gla_rwkv7_meta"


def _splits(sizes):
    return [int(s) for s in np.cumsum(sizes)[:-1]]


def rmsnorm(x, g):
    x32 = x.astype(jnp.float32)
    y = x32 * lax.rsqrt(jnp.mean(x32 * x32, axis=-1, keepdims=True) + EPS)
    return (y * g.astype(jnp.float32)).astype(x.dtype)


def layernorm(x, g, b):
    x32 = x.astype(jnp.float32)
    mu = jnp.mean(x32, axis=-1, keepdims=True)
    var = jnp.mean(jnp.square(x32 - mu), axis=-1, keepdims=True)
    y = (x32 - mu) * lax.rsqrt(var + LN_EPS) * g.astype(jnp.float32) + b.astype(jnp.float32)
    return y.astype(x.dtype)


def causal_dwconv(x, w):
    K = w.shape[0]
    L = x.shape[1]
    xp = jnp.pad(x, ((0, 0), (K - 1, 0), (0, 0)))
    out = xp[:, 0:L] * w[0]
    for t in range(1, K):
        out = out + xp[:, t:t + L] * w[t]
    return out


def token_shift(z):
    return jnp.pad(z, ((0, 0), (1, 0), (0, 0)))[:, :-1]


def mixer_ab(h, w_in, conf_dw, conf_dw_b, conf_ln_g, conf_ln_b, sc_dw, w_out):
    z = h @ w_in
    a_val, a_gate, s_b, s_c, s_x = jnp.split(z, _splits(AB_SIZES), axis=-1)
    a = a_val * jax.nn.sigmoid(a_gate)
    a = causal_dwconv(a, conf_dw) + conf_dw_b
    a = jax.nn.silu(layernorm(a, conf_ln_g, conf_ln_b))
    s = s_b * causal_dwconv(s_c * s_x, sc_dw)
    return jnp.concatenate([a, s], axis=-1) @ w_out


def gla_chunked(q, k, v, log_a):
    Bs, T, H, dk = q.shape
    dv = v.shape[-1]
    C = GLA_CHUNK
    nc = T // C

    def blk(t):
        return t.reshape(Bs, nc, C, H, t.shape[-1]).transpose(0, 3, 1, 2, 4)

    q, k, v, g = blk(q), blk(k), blk(v), blk(log_a)
    cum = jnp.cumsum(g, axis=3)
    last = cum[:, :, :, -1:, :]
    q_dec = q * jnp.exp(cum)
    k_dec = k * jnp.exp(-cum)
    mask = jnp.tril(jnp.ones((C, C), dtype=bool))
    scores = jnp.where(mask, jnp.einsum('bhncd,bhnsd->bhncs', q_dec, k_dec), 0.0)
    o = jnp.einsum('bhncs,bhnsv->bhncv', scores, v)
    chunk_state = jnp.einsum('bhncd,bhncv->bhndv', k * jnp.exp(last - cum), v)
    chunk_decay = jnp.exp(last[:, :, :, 0, :])

    def step(S, inp):
        dec, cs = inp
        return S * dec[..., None] + cs, S

    _, S_prev = lax.scan(step, jnp.zeros((Bs, H, dk, dv), q.dtype),
                         (jnp.moveaxis(chunk_decay, 2, 0), jnp.moveaxis(chunk_state, 2, 0)))
    S_prev = jnp.moveaxis(S_prev, 0, 2)
    o = o + jnp.einsum('bhncd,bhndv->bhncv', q_dec, S_prev)
    return o.transpose(0, 2, 3, 1, 4).reshape(Bs, T, H, dv)


def rwkv7_scan(r, w, k, v, kk, a):
    Bs, L, H, N = r.shape

    def step(S, inp):
        r_t, w_t, k_t, v_t, kk_t, a_t = inp
        sa = jnp.einsum('bhvk,bhk->bhv', S, -kk_t)
        S = S * w_t[:, :, None, :] + sa[..., None] * (kk_t * a_t)[:, :, None, :] \
            + v_t[..., None] * k_t[:, :, None, :]
        return S, jnp.einsum('bhvk,bhk->bhv', S, r_t)

    xs = tuple(jnp.moveaxis(t, 1, 0) for t in (r, w, k, v, kk, a))
    _, y = lax.scan(step, jnp.zeros((Bs, H, N, N), r.dtype), xs)
    return jnp.moveaxis(y, 0, 1)


def mixer_cd(h, w_in, gla_w2, gla_b, gla_norm_g, rw_mu, rw_w0, rw_w2, rw_a0, rw_a2, rw_g2,
             rw_kk, rw_ka, rw_rk, rw_ln_g, rw_ln_b, w_out):
    dt = h.dtype
    Bs, L, _ = h.shape
    z = h @ w_in
    z_gla, z_rw = z[..., :GLA_COLS], z[..., GLA_COLS:]

    q, k, v, go, glr = jnp.split(z_gla.astype(jnp.float32), _splits(GLA_SIZES), axis=-1)
    log_a = jax.nn.log_sigmoid(glr @ gla_w2.astype(jnp.float32) + gla_b) / GLA_GATE_NORM
    q = q * (GLA_DK ** -0.5)
    heads = lambda t, d: t.reshape(Bs, L, GLA_HEADS, d)
    q, k, log_a, v = heads(q, GLA_DK), heads(k, GLA_DK), heads(log_a, GLA_DK), heads(v, GLA_DV)
    pad_front = (-N_META) % GLA_CHUNK
    pad_back = (-(pad_front + L)) % GLA_CHUNK
    pw = ((0, 0), (pad_front, pad_back), (0, 0), (0, 0))
    o = gla_chunked(jnp.pad(q, pw), jnp.pad(k, pw), jnp.pad(v, pw), jnp.pad(log_a, pw))
    o = o[:, pad_front:pad_front + L]
    o = o * lax.rsqrt(jnp.mean(o * o, axis=-1, keepdims=True) + EPS)
    o = o.reshape(Bs, L, GLA_V) * gla_norm_g * jax.nn.silu(go)

    zr = z_rw.astype(jnp.float32)
    zr = zr + (token_shift(zr) - zr) * rw_mu
    r, kr, vr, xw, xa, xg = jnp.split(zr, _splits(RW_SIZES), axis=-1)
    w_log = -jax.nn.softplus(-(rw_w0 + jnp.tanh(xw) @ rw_w2.astype(jnp.float32))) - 0.5
    decay = jnp.exp(-jnp.exp(w_log))
    a = jax.nn.sigmoid(rw_a0 + xa @ rw_a2.astype(jnp.float32))
    g = jax.nn.sigmoid(xg) @ rw_g2.astype(jnp.float32)
    rh = lambda t: t.reshape(Bs, L, RW_HEADS, RW_N)
    r, kr, vr, decay, a = rh(r), rh(kr), rh(vr), rh(decay), rh(a)
    kk = kr * rw_kk.reshape(RW_HEADS, RW_N)
    kk = kk / jnp.maximum(jnp.sqrt(jnp.sum(kk * kk, axis=-1, keepdims=True)), 1e-12)
    kr = kr * (1.0 + (a - 1.0) * rw_ka.reshape(RW_HEADS, RW_N))
    y = rwkv7_scan(r, decay, kr, vr, kk, a)
    mu = jnp.mean(y, axis=-1, keepdims=True)
    var = jnp.mean(jnp.square(y - mu), axis=-1, keepdims=True)
    y = (y - mu) * lax.rsqrt(var + RW_GN_EPS) * rw_ln_g.reshape(RW_HEADS, RW_N) \
        + rw_ln_b.reshape(RW_HEADS, RW_N)
    y = y + jnp.sum(r * kr * rw_rk.reshape(RW_HEADS, RW_N), axis=-1, keepdims=True) * vr
    y = y.reshape(Bs, L, RW_W) * g

    return jnp.concatenate([o, y], axis=-1).astype(dt) @ w_out


def conv_ffn(h, w_up, dw, w_down):
    u = causal_dwconv(h @ w_up, dw)
    val, gate = u[..., :D_FF], u[..., D_FF:]
    return (jax.nn.silu(gate) * val) @ w_down


def setup_inputs(seed: int = 0) -> dict:
    key = jax.random.key(seed)
    ks = iter(jax.random.split(key, 48))
    nrm = lambda shape, scale: jax.random.normal(next(ks), shape, jnp.float32) * scale
    uni = lambda shape, lo, hi: jax.random.uniform(next(ks), shape, jnp.float32, lo, hi)
    gain = lambda shape: 1.0 + nrm(shape, 0.02)
    D = D_MODEL
    NE, NO = N_EVEN, N_ODD
    return {
        "x": nrm((BATCH, SEQ, D), 1.0),
        "meta": nrm((N_META, D), 1.0),
        "ab_w_in": nrm((NE, D, AB_IN), D ** -0.5),
        "ab_conf_dw": nrm((NE, CONF_K, CONF_W), CONF_K ** -0.5),
        "ab_conf_dw_b": nrm((NE, CONF_W), 0.02),
        "ab_conf_ln_g": gain((NE, CONF_W)),
        "ab_conf_ln_b": nrm((NE, CONF_W), 0.02),
        "ab_sc_dw": nrm((NE, SC_K, SC_W), SC_K ** -0.5),
        "ab_w_out": nrm((NE, CONF_W + SC_W, D), (CONF_W + SC_W) ** -0.5),
        "cd_w_in": nrm((NO, D, CD_IN), D ** -0.5),
        "cd_gla_w2": nrm((NO, GLA_RANK, GLA_QK), GLA_RANK ** -0.5),
        "cd_gla_b": nrm((NO, GLA_QK), 0.1),
        "cd_gla_norm_g": gain((NO, GLA_V)),
        "cd_rw_mu": uni((NO, RW_COLS), 0.0, 1.0),
        "cd_rw_w0": uni((NO, RW_W), -6.0, -1.0),
        "cd_rw_w2": nrm((NO, RW_DECAY_RANK, RW_W), RW_DECAY_RANK ** -0.5),
        "cd_rw_a0": nrm((NO, RW_W), 0.1),
        "cd_rw_a2": nrm((NO, RW_A_RANK, RW_W), RW_A_RANK ** -0.5),
        "cd_rw_g2": nrm((NO, RW_G_RANK, RW_W), RW_G_RANK ** -0.5),
        "cd_rw_kk": 0.85 + nrm((NO, RW_W), 0.05),
        "cd_rw_ka": 1.0 + nrm((NO, RW_W), 0.05),
        "cd_rw_rk": nrm((NO, RW_W), 0.1),
        "cd_rw_ln_g": gain((NO, RW_W)),
        "cd_rw_ln_b": nrm((NO, RW_W), 0.02),
        "cd_w_out": nrm((NO, GLA_V + RW_W, D), (GLA_V + RW_W) ** -0.5),
        "norm_mix": gain((DEPTH, D)),
        "norm_ffn": gain((DEPTH, D)),
        "ffn_w_up": nrm((DEPTH, D, 2 * D_FF), D ** -0.5),
        "ffn_dw": nrm((DEPTH, FFN_K, 2 * D_FF), FFN_K ** -0.5),
        "ffn_w_down": nrm((DEPTH, D_FF, D), D_FF ** -0.5),
        "norm_final": gain((D,)),
    }


def reference(x, meta, ab_w_in, ab_conf_dw, ab_conf_dw_b, ab_conf_ln_g, ab_conf_ln_b, ab_sc_dw,
              ab_w_out, cd_w_in, cd_gla_w2, cd_gla_b, cd_gla_norm_g, cd_rw_mu, cd_rw_w0, cd_rw_w2,
              cd_rw_a0, cd_rw_a2, cd_rw_g2, cd_rw_kk, cd_rw_ka, cd_rw_rk, cd_rw_ln_g, cd_rw_ln_b,
              cd_w_out, norm_mix, norm_ffn, ffn_w_up, ffn_dw, ffn_w_down, norm_final):
    Bs = x.shape[0]
    h = jnp.concatenate([jnp.broadcast_to(meta[None].astype(x.dtype), (Bs, N_META, D_MODEL)), x],
                        axis=1)
    for i in range(DEPTH):
        hn = rmsnorm(h, norm_mix[i])
        j = i // 2
        if i % 2 == 0:
            mix = mixer_ab(hn, ab_w_in[j], ab_conf_dw[j], ab_conf_dw_b[j], ab_conf_ln_g[j],
                           ab_conf_ln_b[j], ab_sc_dw[j], ab_w_out[j])
        else:
            mix = mixer_cd(hn, cd_w_in[j], cd_gla_w2[j], cd_gla_b[j], cd_gla_norm_g[j], cd_rw_mu[j],
                           cd_rw_w0[j], cd_rw_w2[j], cd_rw_a0[j], cd_rw_a2[j], cd_rw_g2[j],
                           cd_rw_kk[j], cd_rw_ka[j], cd_rw_rk[j], cd_rw_ln_g[j], cd_rw_ln_b[j],
                           cd_w_out[j])
        h = h + mix.astype(h.dtype)
        h = h + conv_ffn(rmsnorm(h, norm_ffn[i]), ffn_w_up[i], ffn_dw[i], ffn_w_down[i]).astype(h.dtype)
    return rmsnorm(h, norm_final)[:, N_META:]
```

```cpp
#include <hip/hip_runtime.h>
#include <hip/hip_cooperative_groups.h>
#include <cstdio>
namespace cg = cooperative_groups;

#define LAS __attribute__((address_space(3)))
typedef unsigned short bf16_t;
typedef short bf16x8 __attribute__((ext_vector_type(8)));
typedef float f32x4 __attribute__((ext_vector_type(4)));
typedef float f32x2 __attribute__((ext_vector_type(2)));
typedef unsigned u32x4 __attribute__((ext_vector_type(4)));
typedef unsigned u32x2 __attribute__((ext_vector_type(2)));

constexpr int D = 2048, L = 2064, NBATCH = 4, SEQ = 2048, NMETA = 16, M = NBATCH * L  , MBIG = 8192;
constexpr int DFF = 5632, NUP = 2 * DFF, NAB = 5120, NCD = 6416, NCDP = 6656;
constexpr int NCH = 33;
constexpr int NGI = NBATCH * 4 * NCH;
constexpr int LDS_BYTES = 131072 + 16;
constexpr int NTHREADS = 512;

constexpr size_t al256(size_t x) { return (x + 255) & ~(size_t)255; }
constexpr size_t OFF_H = 0;
constexpr size_t OFF_W = OFF_H + al256((size_t)M * D * 4);
constexpr size_t OFF_HN = OFF_W + al256((size_t)NUP * D * 2);
constexpr size_t OFF_Z = OFF_HN + al256((size_t)M * D * 2);
constexpr size_t OFF_ACT = OFF_Z + al256((size_t)M * NCDP * 4);
constexpr size_t OFF_X = OFF_ACT + al256((size_t)M * DFF * 2);
constexpr size_t SZ_M1024F = al256((size_t)M * 1024 * 4);
constexpr size_t XO_R = OFF_X;
constexpr size_t XO_KR = XO_R + SZ_M1024F;
constexpr size_t XO_VR = XO_KR + SZ_M1024F;
constexpr size_t XO_G = XO_VR + SZ_M1024F;
constexpr size_t XO_Y = OFF_HN;
constexpr size_t XO_LW = XO_G + SZ_M1024F;
constexpr size_t XO_LA = XO_LW + al256((size_t)M * 64 * 2);
constexpr size_t XO_LG = XO_LA + al256((size_t)M * 64 * 2);
constexpr size_t XO_GATE = XO_LG + al256((size_t)M * 128 * 2);
constexpr size_t XO_QDEC = XO_GATE + al256((size_t)M * 1024 * 2);
constexpr size_t XO_KDEC = XO_QDEC + al256((size_t)NGI * 64 * 128 * 2);
constexpr size_t XO_K2T = XO_KDEC + al256((size_t)NGI * 64 * 128 * 2);
constexpr size_t XO_VT = XO_K2T + al256((size_t)NGI * 64 * 128 * 2);
constexpr size_t XO_CDEC = XO_VT + al256((size_t)NGI * 256 * 64 * 2);
constexpr size_t XO_BONUS = XO_CDEC + al256((size_t)NGI * 128 * 4);
constexpr size_t XO_W2T = XO_BONUS + al256((size_t)M * 16 * 4);
constexpr size_t XO_A2T = XO_W2T + al256((size_t)1024 * 64 * 2);
constexpr size_t XO_G2T = XO_A2T + al256((size_t)1024 * 64 * 2);
constexpr size_t XO_BAR = XO_G2T + al256((size_t)1024 * 128 * 2);
constexpr int BAR_WORDS = 3456 + 64;
constexpr size_t XO_SS = XO_BAR + al256((size_t)BAR_WORDS * 4);
constexpr size_t XO_WB = XO_SS + al256((size_t)3 * M * 4);
constexpr size_t XO_WC = XO_WB + al256((size_t)NCDP * D * 2);
constexpr size_t WS_END = XO_WC + al256((size_t)D * DFF * 2);
constexpr size_t ZO_DECAY = OFF_Z;
constexpr size_t ZO_A = ZO_DECAY + SZ_M1024F;
constexpr size_t ZO_KK = ZO_A + SZ_M1024F;
constexpr size_t ZO_O = ZO_KK + SZ_M1024F;
constexpr size_t ZO_CST = ZO_O + SZ_M1024F;
constexpr size_t ZO_SPT = ZO_CST + al256((size_t)NGI * 256 * 128 * 2);
constexpr size_t ZO_P = ZO_SPT + al256((size_t)NGI * 256 * 128 * 2);
constexpr size_t ZO_END = ZO_P + al256((size_t)NGI * 64 * 64 * 2);
static_assert(ZO_END <= OFF_ACT, "Z sub-regions overflow");
static_assert(SZ_M1024F <= (size_t)M * D * 2 + 256, "Y must fit in HN");

__device__ __forceinline__ float bf2f(unsigned b) { return __uint_as_float(b << 16); }
__device__ __forceinline__ unsigned f2bf(float f) { unsigned u = __float_as_uint(f); u += 0x7FFFu + ((u >> 16) & 1u); return u >> 16; }
__device__ __forceinline__ unsigned pk2(float lo, float hi) { return f2bf(lo) | (f2bf(hi) << 16); }
__device__ __forceinline__ float lo_f(unsigned w) { return __uint_as_float(w << 16); }
__device__ __forceinline__ float hi_f(unsigned w) { return __uint_as_float(w & 0xffff0000u); }
__device__ __forceinline__ float sigm(float x) { return 1.0f / (1.0f + expf(-x)); }
__device__ __forceinline__ float silu(float x) { return x * sigm(x); }
__device__ __forceinline__ float logsig(float x) { return fminf(x, 0.f) - log1pf(expf(-fabsf(x))); }
__device__ __forceinline__ float wave_sum(float v) {
#pragma unroll
    for (int o = 32; o >= 1; o >>= 1) v += __shfl_xor(v, o);
    return v;
}
__device__ __forceinline__ float sum16(float v) {
#pragma unroll
    for (int o = 8; o >= 1; o >>= 1) v += __shfl_xor(v, o);
    return v;
}
__device__ __forceinline__ float quad_sum(float x) {
    x += __int_as_float(__builtin_amdgcn_update_dpp(0, __float_as_int(x), 0xB1, 0xF, 0xF, false));
    x += __int_as_float(__builtin_amdgcn_update_dpp(0, __float_as_int(x), 0x4E, 0xF, 0xF, false));
    return x;
}


#define XB_TMO      128
#define XB_XCNT(j)  (256  + 64 * (j))
#define XB_XSUB(j)  (1280 + 64 * (j))
#define XB_XGEN(j)  (2304 + 64 * (j))
#define XB_TOP      3328
#define XB_TOPGEN   3392
#define XCD_BAR_WORDS 3456
#define XB_SPIN_CAP (1u << 20)
__device__ __forceinline__ unsigned xb_ld(unsigned* p)              { return __hip_atomic_load(p, __ATOMIC_RELAXED, __HIP_MEMORY_SCOPE_AGENT); }
__device__ __forceinline__ unsigned xb_add(unsigned* p, unsigned v) { return __hip_atomic_fetch_add(p, v, __ATOMIC_RELAXED, __HIP_MEMORY_SCOPE_AGENT); }
__device__ __forceinline__ unsigned xb_xcc_id() { return (unsigned)__builtin_amdgcn_s_getreg((3 << 11) | 20) & 0xFu; }
#define XB_SPIN(cond, bar) do { unsigned _sp = 0; while (cond) { __builtin_amdgcn_s_sleep(1); \
    if ((++_sp & 255u) == 0u) { if (xb_ld(&(bar)[XB_TMO])) break; if (_sp > XB_SPIN_CAP) { atomicAdd(&(bar)[XB_TMO], 1u); break; } } } } while (0)
struct XcdBarrier { unsigned* bar; unsigned x; volatile LAS unsigned* st; };
__device__ __forceinline__ XcdBarrier xcd_barrier_post(unsigned* bar, volatile LAS unsigned* st) {
    XcdBarrier b; b.bar = bar; b.x = xb_xcc_id(); b.st = st;
    if (threadIdx.x == 0) (void)xb_add(&bar[XB_XCNT(b.x)], 1u);
    return b;
}
__device__ __forceinline__ void xcd_barrier_complete(unsigned* bar, unsigned x, unsigned& nloc, unsigned& nx) {
    const unsigned G = gridDim.x * gridDim.y * gridDim.z;
    unsigned sum, cnt, mine, sp = 0u;
    for (;;) {
        sum = 0u; cnt = 0u; mine = 0u;
#pragma unroll
        for (unsigned j = 0; j < 16; ++j) { const unsigned c = xb_ld(&bar[XB_XCNT(j)]); sum += c; cnt += (c > 0u) ? 1u : 0u; mine = (j == x) ? c : mine; }
        if (sum == G) break;
        __builtin_amdgcn_s_sleep(1);
        if ((++sp & 255u) == 0u) { if (xb_ld(&bar[XB_TMO])) break; if (sp > XB_SPIN_CAP) { atomicAdd(&bar[XB_TMO], 1u); break; } }
    }
    nloc = mine > 0u ? mine : 1u; nx = cnt > 0u ? cnt : 1u;
}
__device__ __forceinline__ void xcd_barrier(const XcdBarrier& b) {
    asm volatile("s_waitcnt vmcnt(0)" ::: "memory");
    __syncthreads();
    if (threadIdx.x == 0) {
        unsigned* bar = b.bar;
        __builtin_amdgcn_s_waitcnt(0);
        unsigned nloc = b.st[0], nx = b.st[1];
        if (nloc == 0u) { xcd_barrier_complete(bar, b.x, nloc, nx); b.st[0] = nloc; b.st[1] = nx; }
        const unsigned old = xb_add(&bar[XB_XSUB(b.x)], 1u);
        const unsigned gen = old / nloc;
        if (old + 1u == (gen + 1u) * nloc) {
            __builtin_amdgcn_fence(__ATOMIC_RELEASE, "agent");
            asm volatile("s_waitcnt vmcnt(0)" ::: "memory");
            const unsigned og = xb_add(&bar[XB_TOP], 1u);
            const unsigned tg = og / nx;
            if (og + 1u == (tg + 1u) * nx) xb_add(&bar[XB_TOPGEN], 1u);
            else XB_SPIN(xb_ld(&bar[XB_TOPGEN]) == tg, bar);
            __builtin_amdgcn_fence(__ATOMIC_ACQUIRE, "agent");
            xb_add(&bar[XB_XGEN(b.x)], 1u);
            asm volatile("s_waitcnt vmcnt(0)" ::: "memory");
        } else {
            XB_SPIN(xb_ld(&bar[XB_XGEN(b.x)]) == gen, bar);
            __builtin_amdgcn_fence(__ATOMIC_ACQUIRE, "agent");
            asm volatile("s_waitcnt vmcnt(0)" ::: "memory");
        }
    }
    __syncthreads();
}

namespace pg8 {
constexpr int BM = 256, BK = 64, HALF = 128, HTB = HALF * BK * 2, NXCD = 8, WGM = 8;
__device__ __forceinline__ int lds_byte(int r, int c) { const int st = (r >> 4) * 2 + (c >> 5), rr = r & 15, cc = c & 31, ob = rr * 64 + cc * 2; return st * 1024 + (ob ^ (((ob >> 9) & 1) << 5)); }
__device__ __forceinline__ void stage_rc(int b, int& R, int& C) { const int st = b / 1024, sb = b % 1024, swz = sb ^ (((sb >> 9) & 1) << 5); R = (st >> 1) * 16 + swz / 64; C = (st & 1) * 32 + (swz % 64) / 2; }
struct Unit { int pm, pn; };
struct StaticOrder {
    int nM, nN, nwg, G, c;
    __device__ void init(int Mr, int N, int G_, int c_) { nM = Mr / BM; nN = N / BM; nwg = nM * nN; G = G_; c = c_; }
    __device__ bool next(int i, Unit& u) const {
        const long Lx = (long)i * G + c; if (Lx >= nwg) return false;
        int wgid = (int)Lx; { const int q = nwg / NXCD, r = nwg % NXCD, xcd = wgid % NXCD, off = wgid / NXCD; wgid = (xcd < r ? xcd * (q + 1) : r * (q + 1) + (xcd - r) * q) + off; }
        const int nig = WGM * nN, gid = wgid / nig, fm = gid * WGM, gsz = (nM - fm) < WGM ? (nM - fm) : WGM;
        u.pm = fm + ((wgid % nig) % gsz); u.pn = (wgid % nig) / gsz; return true;
    }
};
template <class F>
__device__ __forceinline__ void gemm_phase(LAS unsigned char* lds, const bf16_t* gA, const bf16_t* gBt, const int K, const StaticOrder& S, const F& f) {
    int tid = threadIdx.x; asm volatile("" : "+v"(tid));
    const int wid = __builtin_amdgcn_readfirstlane(tid >> 6), lane = tid & 63, wr = wid >> 2, wc = wid & 3, fr = lane & 15, fq = lane >> 4;
    const int nt = K / BK;
    unsigned voffA[2];
#pragma unroll
    for (int i = 0; i < 2; ++i) { int R, C; stage_rc(tid * 16 + i * 8192, R, C); voffA[i] = (unsigned)(R * K + C) * 2u; }
    const size_t kstep = (size_t)(BK * 2);
    const size_t hstep = (size_t)HALF * K * 2;
    const size_t tstep = 2 * hstep;
    const unsigned ldsw = (unsigned)wid * 1024u;
    const int aoff = lds_byte(wr * 64 + fr, fq * 8), boff = lds_byte(wc * 32 + fr, fq * 8);
#define PG8_SA(b, h) (((b) * 2 + (h)) * HTB)
#define PG8_SB(b, h) ((4 + (b) * 2 + (h)) * HTB)
#define PG8_STAGE(bufoff, gbase, voff) do { _Pragma("unroll") for (int _i = 0; _i < 2; ++_i) \
        __builtin_amdgcn_global_load_lds((const unsigned*)((const char*)(gbase) + (voff)[_i]), (LAS unsigned*)(lds + (bufoff) + ldsw + _i * 8192), 16, 0, 0); } while (0)
#define PG8_LDA(dst, b, h) do { _Pragma("unroll") for (int m = 0; m < 4; ++m) _Pragma("unroll") for (int k = 0; k < 2; ++k) dst[m][k] = *(const LAS bf16x8*)(lds + PG8_SA(b, h) + aoff + m * 2048 + k * 1024); } while (0)
#define PG8_LDB(dst, b, h) do { _Pragma("unroll") for (int n = 0; n < 2; ++n) _Pragma("unroll") for (int k = 0; k < 2; ++k) dst[n][k] = *(const LAS bf16x8*)(lds + PG8_SB(b, h) + boff + n * 2048 + k * 1024); } while (0)
#define PG8_MMA(ai, bj, At, Bt) do { __builtin_amdgcn_s_setprio(1); _Pragma("unroll") for (int m = 0; m < 4; ++m) _Pragma("unroll") for (int n = 0; n < 2; ++n) _Pragma("unroll") for (int k = 0; k < 2; ++k) \
        acc[ai][bj][m][n] = __builtin_amdgcn_mfma_f32_16x16x32_bf16(Bt[n][k], At[m][k], acc[ai][bj][m][n], 0, 0, 0); __builtin_amdgcn_s_setprio(0); } while (0)
#define PG8_WAIT_V(n) asm volatile("s_waitcnt vmcnt(" #n ")" ::: "memory")
#define PG8_WAIT_L(n) asm volatile("s_waitcnt lgkmcnt(" #n ")" ::: "memory")
#define PG8_BAR __builtin_amdgcn_s_barrier()
#define PG8_SCHED __builtin_amdgcn_sched_barrier(0)
    Unit cur, nxt; int ui = 0;
    if (!S.next(0, cur)) return;
    f32x4 acc[2][2][4][2];
#pragma unroll
    for (int a = 0; a < 2; ++a)
#pragma unroll
        for (int b = 0; b < 2; ++b)
#pragma unroll
            for (int m = 0; m < 4; ++m)
#pragma unroll
                for (int n = 0; n < 2; ++n) acc[a][b][m][n] = (f32x4){0.f, 0.f, 0.f, 0.f};
    bf16x8 At[4][2], B0[2][2], B1[2][2];
    const char* cA = (const char*)gA + (size_t)cur.pm * tstep; const char* cB = (const char*)gBt + (size_t)cur.pn * tstep;
    PG8_STAGE(PG8_SB(0, 0), cB, voffA); PG8_STAGE(PG8_SA(0, 0), cA, voffA); PG8_STAGE(PG8_SB(0, 1), cB + hstep, voffA); PG8_STAGE(PG8_SA(0, 1), cA + hstep, voffA);
    if (wr == 1) PG8_BAR;
    PG8_WAIT_V(4); PG8_BAR;
    PG8_STAGE(PG8_SB(1, 0), cB + kstep, voffA); PG8_STAGE(PG8_SA(1, 0), cA + kstep, voffA); PG8_STAGE(PG8_SB(1, 1), cB + hstep + kstep, voffA);
    PG8_WAIT_V(6); PG8_BAR;
    for (;;) {
        const bool has_next = S.next(ui + 1, nxt);
        const char* nA = has_next ? (const char*)gA + (size_t)nxt.pm * tstep : cA; const char* nB = has_next ? (const char*)gBt + (size_t)nxt.pn * tstep : cB;
        for (int t = 0; t < nt; t += 2) {
            const bool last = (t == nt - 2);
            const char* a1 = cA + (size_t)(t + 1) * kstep;
            const char* a2 = last ? nA : cA + (size_t)(t + 2) * kstep; const char* b2 = last ? nB : cB + (size_t)(t + 2) * kstep;
            const char* a3 = a2 + kstep; const char* b3 = b2 + kstep;
            PG8_LDB(B0, 0, 0); PG8_SCHED; PG8_LDA(At, 0, 0); PG8_STAGE(PG8_SA(1, 1), a1 + hstep, voffA);
            PG8_WAIT_L(8); PG8_BAR; PG8_WAIT_L(0); PG8_MMA(0, 0, At, B0); PG8_BAR; PG8_SCHED;
            PG8_LDB(B1, 0, 1); PG8_STAGE(PG8_SB(0, 0), b2, voffA);
            PG8_BAR; PG8_WAIT_L(0); PG8_MMA(0, 1, At, B1); PG8_BAR;
            PG8_LDA(At, 0, 1); PG8_STAGE(PG8_SA(0, 0), a2, voffA);
            PG8_BAR; PG8_WAIT_L(0); PG8_MMA(1, 0, At, B0); PG8_BAR; PG8_SCHED;
            PG8_STAGE(PG8_SB(0, 1), b2 + hstep, voffA);
            PG8_WAIT_V(6); PG8_BAR; PG8_MMA(1, 1, At, B1); PG8_BAR;
            PG8_LDB(B0, 1, 0); PG8_SCHED; PG8_LDA(At, 1, 0); PG8_STAGE(PG8_SA(0, 1), a2 + hstep, voffA);
            PG8_WAIT_L(8); PG8_BAR; PG8_WAIT_L(0); PG8_MMA(0, 0, At, B0); PG8_BAR; PG8_SCHED;
            PG8_LDB(B1, 1, 1); PG8_STAGE(PG8_SB(1, 0), b3, voffA);
            PG8_BAR; PG8_WAIT_L(0); PG8_MMA(0, 1, At, B1); PG8_BAR;
            PG8_LDA(At, 1, 1); PG8_STAGE(PG8_SA(1, 0), a3, voffA);
            PG8_BAR; PG8_WAIT_L(0); PG8_MMA(1, 0, At, B0); PG8_BAR; PG8_SCHED;
            PG8_STAGE(PG8_SB(1, 1), b3 + hstep, voffA);
            PG8_WAIT_V(6); PG8_BAR; PG8_MMA(1, 1, At, B1); PG8_BAR;
        }
        {
            const int row0 = cur.pm * BM + wr * 64 + fr, col0 = cur.pn * BM + wc * 32 + 4 * fq;
#pragma unroll
            for (int ai = 0; ai < 2; ++ai)
#pragma unroll
                for (int m = 0; m < 4; ++m) {
                    const int row = row0 + ai * HALF + m * 16;
                    const float sc = f.begin(row); float ssq = 0.f;
#pragma unroll
                    for (int bj = 0; bj < 2; ++bj)
#pragma unroll
                        for (int n = 0; n < 2; ++n) ssq += f(row, col0 + bj * HALF + n * 16, acc[ai][bj][m][n], sc);
                    f.end(row, ssq, 0);
                }
        }
        if (!has_next) break;
#pragma unroll
        for (int a = 0; a < 2; ++a)
#pragma unroll
            for (int b = 0; b < 2; ++b)
#pragma unroll
                for (int m = 0; m < 4; ++m)
#pragma unroll
                    for (int n = 0; n < 2; ++n) acc[a][b][m][n] = (f32x4){0.f, 0.f, 0.f, 0.f};
        cur = nxt; cA = nA; cB = nB; ++ui;
    }
    PG8_WAIT_V(0);
    if (wr == 0) PG8_BAR;
    PG8_BAR;
#undef PG8_SA
#undef PG8_SB
#undef PG8_STAGE
#undef PG8_LDA
#undef PG8_LDB
#undef PG8_MMA
#undef PG8_WAIT_V
#undef PG8_WAIT_L
#undef PG8_BAR
#undef PG8_SCHED
}
}

__device__ __forceinline__ void wave_tile_mma(const bf16_t* __restrict__ A, int lda, const bf16_t* __restrict__ Bt, int ldb, int k0, int k1, f32x4 (&acc)[4][4], int fr, int fq) {
    const bf16_t* ap = A + (size_t)fr * lda + fq * 8;
    const bf16_t* bp = Bt + (size_t)fr * ldb + fq * 8;
#pragma unroll 2
    for (int k = k0; k < k1; k += 32) {
        bf16x8 a[4], b[4];
#pragma unroll
        for (int i = 0; i < 4; ++i) { a[i] = *(const bf16x8*)(ap + (size_t)i * 16 * lda + k); b[i] = *(const bf16x8*)(bp + (size_t)i * 16 * ldb + k); }
#pragma unroll
        for (int mi = 0; mi < 4; ++mi)
#pragma unroll
            for (int ni = 0; ni < 4; ++ni) acc[mi][ni] = __builtin_amdgcn_mfma_f32_16x16x32_bf16(b[ni], a[mi], acc[mi][ni], 0, 0, 0);
    }
}
__device__ __forceinline__ void zero_acc(f32x4 (&acc)[4][4]) {
#pragma unroll
    for (int i = 0; i < 4; ++i)
#pragma unroll
        for (int j = 0; j < 4; ++j) acc[i][j] = (f32x4){0.f, 0.f, 0.f, 0.f};
}

template <class F>
__device__ __forceinline__ void gemm_rem_phase(LAS unsigned char* lds, const bf16_t* A, const bf16_t* Bt, int N, int K, const F& f) {
    const int tid = threadIdx.x, wid = __builtin_amdgcn_readfirstlane(tid >> 6), lane = tid & 63, fr = lane & 15, fq = lane >> 4;
    const int ntiles = N / 64, kw = K / 8;
    for (int tile = (int)gridDim.x - 1 - (int)blockIdx.x; tile < ntiles; tile += gridDim.x) {
        const int n0 = tile * 64;
        f32x4 acc[4][4]; zero_acc(acc);
        wave_tile_mma(A + (size_t)MBIG * K, K, Bt + (size_t)n0 * K, K, wid * kw, (wid + 1) * kw, acc, fr, fq);
        LAS float* P = (LAS float*)lds + wid * 4096;
#pragma unroll
        for (int mi = 0; mi < 4; ++mi)
#pragma unroll
            for (int ni = 0; ni < 4; ++ni) *(LAS f32x4*)(P + (mi * 16 + fr) * 64 + ni * 16 + fq * 4) = acc[mi][ni];
        __syncthreads();
#pragma unroll
        for (int i = 0; i < 2; ++i) {
            const int idx = tid + i * 512, r = idx >> 4, c4 = (idx & 15) * 4;
            f32x4 s = (f32x4){0.f, 0.f, 0.f, 0.f};
#pragma unroll
            for (int w = 0; w < 8; ++w) s += *(const LAS f32x4*)((LAS float*)lds + w * 4096 + r * 64 + c4);
            const float sc = f.begin(MBIG + r);
            const float ssq = f(MBIG + r, n0 + c4, s, sc);
            f.end(MBIG + r, ssq, 1);
        }
        __syncthreads();
    }
}

__device__ __forceinline__ float rstd_of(const float* SS, int row) { return rsqrtf(SS[row] * (1.0f / D) + 1e-6f); }
struct EpStoreBf16 { bf16_t* O; int ld;
    __device__ __forceinline__ float begin(int) const { return 1.f; }
    __device__ __forceinline__ float operator()(int row, int col, f32x4 v, float) const { u32x2 w; w.x = pk2(v[0], v[1]); w.y = pk2(v[2], v[3]); *(u32x2*)(O + (size_t)row * ld + col) = w; return 0.f; }
    __device__ __forceinline__ void end(int, float, int) const {} };
struct EpScaleStoreBf16 { bf16_t* O; int ld; const float* SS;
    __device__ __forceinline__ float begin(int row) const { return rstd_of(SS, row); }
    __device__ __forceinline__ float operator()(int row, int col, f32x4 v, float s) const { v = v * s; u32x2 w; w.x = pk2(v[0], v[1]); w.y = pk2(v[2], v[3]); *(u32x2*)(O + (size_t)row * ld + col) = w; return 0.f; }
    __device__ __forceinline__ void end(int, float, int) const {} };
struct EpScaleStoreF32 { float* O; int ld; const float* SS;
    __device__ __forceinline__ float begin(int row) const { return rstd_of(SS, row); }
    __device__ __forceinline__ float operator()(int row, int col, f32x4 v, float s) const { *(f32x4*)(O + (size_t)row * ld + col) = v * s; return 0.f; }
    __device__ __forceinline__ void end(int, float, int) const {} };
struct EpAddF32 { float* H; int ld;
    __device__ __forceinline__ float begin(int) const { return 1.f; }
    __device__ __forceinline__ float operator()(int row, int col, f32x4 v, float) const { f32x4* p = (f32x4*)(H + (size_t)row * ld + col); *p = *p + v; return 0.f; }
    __device__ __forceinline__ void end(int, float, int) const {} };
struct EpResid { float* H; bf16_t* HB; float* SS;
    __device__ __forceinline__ float begin(int) const { return 1.f; }
    __device__ __forceinline__ float operator()(int row, int col, f32x4 v, float) const {
        f32x4* p = (f32x4*)(H + (size_t)row * D + col); const f32x4 h = *p + v; *p = h;
        u32x2 w; w.x = pk2(h[0], h[1]); w.y = pk2(h[2], h[3]); *(u32x2*)(HB + (size_t)row * D + col) = w;
        return (h[0] * h[0] + h[1] * h[1]) + (h[2] * h[2] + h[3] * h[3]); }
    __device__ __forceinline__ void end(int row, float ssq, int kind) const {
        const int lane = threadIdx.x & 63;
        if (kind == 0) { ssq += __shfl_xor(ssq, 16); ssq += __shfl_xor(ssq, 32); if (lane < 16) atomicAdd(SS + row, ssq); }
        else { ssq = sum16(ssq); if ((lane & 15) == 0) atomicAdd(SS + row, ssq); } } };

template <class F>
__device__ __forceinline__ void gemm_full(LAS unsigned char* lds, const bf16_t* A, const bf16_t* Bt, int N, int K, const F& f) {
    pg8::StaticOrder S; S.init(MBIG, N, (int)gridDim.x, (int)blockIdx.x);
    pg8::gemm_phase(lds, A, Bt, K, S, f);
    gemm_rem_phase(lds, A, Bt, N, K, f);
}

__device__ __forceinline__ void convert_tile(const float* __restrict__ src, bf16_t* __restrict__ dst, int K, int N, const float* __restrict__ gain, int t, LAS float* tile) {
    const int tid = threadIdx.x;
    const int tk = K / 64;
    const int k0 = (t % tk) * 64, n0 = (t / tk) * 64;
#pragma unroll
    for (int i = 0; i < 2; ++i) {
        const int idx = tid + i * 512, k = idx >> 4, n4 = (idx & 15) * 4;
        f32x4 v = (f32x4){0.f, 0.f, 0.f, 0.f};
        if (n0 + n4 < N) v = *(const f32x4*)(src + (size_t)(k0 + k) * N + n0 + n4);
        if (gain) v = v * gain[k0 + k];
        tile[k * 65 + n4 + 0] = v[0]; tile[k * 65 + n4 + 1] = v[1]; tile[k * 65 + n4 + 2] = v[2]; tile[k * 65 + n4 + 3] = v[3];
    }
    __syncthreads();
    {
        const int n = tid >> 3, ks = (tid & 7) * 8;
        u32x4 w;
        w.x = pk2(tile[(ks + 0) * 65 + n], tile[(ks + 1) * 65 + n]); w.y = pk2(tile[(ks + 2) * 65 + n], tile[(ks + 3) * 65 + n]);
        w.z = pk2(tile[(ks + 4) * 65 + n], tile[(ks + 5) * 65 + n]); w.w = pk2(tile[(ks + 6) * 65 + n], tile[(ks + 7) * 65 + n]);
        *(u32x4*)(dst + (size_t)(n0 + n) * K + k0 + ks) = w;
    }
    __syncthreads();
}
__device__ void convert_wt(const float* __restrict__ src, bf16_t* __restrict__ dst, int K, int N, int Npad, const float* __restrict__ gain, LAS unsigned char* lds) {
    const int ntiles = (K / 64) * (Npad / 64);
    for (int t = blockIdx.x; t < ntiles; t += gridDim.x) convert_tile(src, dst, K, N, gain, t, (LAS float*)lds);
}
__device__ void convert_steal(const float* __restrict__ src, bf16_t* __restrict__ dst, int K, int N, int Npad, const float* __restrict__ gain, unsigned* ctr, LAS unsigned char* lds) {
    const int ntiles = (K / 64) * (Npad / 64);
    volatile LAS unsigned* slot = (volatile LAS unsigned*)(lds + 131072 + 8);
    for (;;) {
        if (threadIdx.x == 0) *slot = __hip_atomic_fetch_add(ctr, 4u, __ATOMIC_RELAXED, __HIP_MEMORY_SCOPE_AGENT);
        __syncthreads();
        const int t0 = (int)*slot;
        __syncthreads();
        if (t0 >= ntiles) break;
#pragma unroll 1
        for (int t = t0; t < t0 + 4 && t < ntiles; ++t) convert_tile(src, dst, K, N, gain, t, (LAS float*)lds);
    }
}

template <int MODE>
__device__ void rms_phase(const float* __restrict__ h_in, float* __restrict__ h_out, const float* __restrict__ x, const float* __restrict__ meta,
                          const float* __restrict__ gain, bf16_t* __restrict__ hn, float* __restrict__ out) {
    const int lane = threadIdx.x & 63, gw = blockIdx.x * 8 + (threadIdx.x >> 6), nw = gridDim.x * 8;
    for (int row = gw; row < M; row += nw) {
        const int b = row / L, t = row - b * L;
        if (MODE == 2 && t < NMETA) continue;
        const float* src;
        if (MODE == 1) src = (t < NMETA) ? meta + (size_t)t * D : x + ((size_t)b * SEQ + (t - NMETA)) * D;
        else src = h_in + (size_t)row * D;
        f32x4 v[8]; float ss = 0.f;
#pragma unroll
        for (int i = 0; i < 8; ++i) { v[i] = *(const f32x4*)(src + (lane + i * 64) * 4); ss += v[i][0] * v[i][0] + v[i][1] * v[i][1] + v[i][2] * v[i][2] + v[i][3] * v[i][3]; }
        ss = wave_sum(ss);
        const float r = rsqrtf(ss * (1.0f / D) + 1e-6f);
#pragma unroll
        for (int i = 0; i < 8; ++i) {
            const int c = (lane + i * 64) * 4;
            const f32x4 g = *(const f32x4*)(gain + c);
            const f32x4 o = v[i] * r * g;
            if (MODE == 1) *(f32x4*)(h_out + (size_t)row * D + c) = v[i];
            if (MODE == 2) *(f32x4*)(out + ((size_t)b * SEQ + (t - NMETA)) * D + c) = o;
            else { u32x2 w; w.x = pk2(o[0], o[1]); w.y = pk2(o[2], o[3]); *(u32x2*)(hn + (size_t)row * D + c) = w; }
        }
    }
}

__device__ void mixer_ab_phase(const bf16_t* __restrict__ z1, const float* __restrict__ conf_dw, const float* __restrict__ conf_b, const float* __restrict__ ln_g,
                               const float* __restrict__ ln_b, const float* __restrict__ sc_dw, bf16_t* __restrict__ cat, LAS unsigned char* lds) {
    const int tid = threadIdx.x, wid = __builtin_amdgcn_readfirstlane(tid >> 6), lane = tid & 63;
    LAS unsigned* S32 = (LAS unsigned*)lds;
    LAS float* C = (LAS float*)lds;
    for (int tile = blockIdx.x; tile < NBATCH * 65; tile += gridDim.x) {
        const int b = tile / 65, t0 = (tile % 65) * 32;
        const int nt = (L - t0) < 32 ? (L - t0) : 32;
        for (int r = 0; r < 62; ++r) {
            const int t = t0 - 30 + r; unsigned w = 0u;
            if (t >= 0 && t < L) {
                const bf16_t* zr = z1 + (size_t)(b * L + t) * NAB;
                const unsigned a = *(const unsigned*)(zr + 2 * tid), g = *(const unsigned*)(zr + 1024 + 2 * tid);
                w = pk2(lo_f(a) * sigm(lo_f(g)), hi_f(a) * sigm(hi_f(g)));
            }
            S32[r * 512 + tid] = w;
        }
        __syncthreads();
        f32x2 acc[32];
#pragma unroll
        for (int t = 0; t < 32; ++t) acc[t] = (f32x2){0.f, 0.f};
#pragma unroll 1
        for (int j = 0; j < 31; ++j) {
            const f32x2 w = *(const f32x2*)(conf_dw + j * 1024 + 2 * tid);
#pragma unroll
            for (int t = 0; t < 32; ++t) { const unsigned xw = S32[(t + j) * 512 + tid]; acc[t] += (f32x2){lo_f(xw), hi_f(xw)} * w; }
        }
        const f32x2 bias = *(const f32x2*)(conf_b + 2 * tid);
        __syncthreads();
#pragma unroll
        for (int t = 0; t < 32; ++t) *(LAS f32x2*)(C + t * 1024 + 2 * tid) = acc[t] + bias;
        __syncthreads();
        for (int q = 0; q < 4; ++q) {
            const int tt = wid * 4 + q;
            if (tt < nt) {
                f32x4 v[4]; float s = 0.f;
#pragma unroll
                for (int i = 0; i < 4; ++i) { v[i] = *(const LAS f32x4*)(C + tt * 1024 + (lane + i * 64) * 4); s += (v[i][0] + v[i][1]) + (v[i][2] + v[i][3]); }
                const float mean = wave_sum(s) * (1.0f / 1024.0f);
                float qv = 0.f;
#pragma unroll
                for (int i = 0; i < 4; ++i) { const f32x4 d = v[i] - mean; qv += d[0] * d[0] + d[1] * d[1] + d[2] * d[2] + d[3] * d[3]; }
                const float rstd = rsqrtf(wave_sum(qv) * (1.0f / 1024.0f) + 1e-5f);
                bf16_t* orow = cat + (size_t)(b * L + t0 + tt) * D;
#pragma unroll
                for (int i = 0; i < 4; ++i) {
                    const int c = (lane + i * 64) * 4;
                    const f32x4 g = *(const f32x4*)(ln_g + c), bb = *(const f32x4*)(ln_b + c);
                    const f32x4 y = (v[i] - mean) * rstd * g + bb;
                    u32x2 w; w.x = pk2(silu(y[0]), silu(y[1])); w.y = pk2(silu(y[2]), silu(y[3]));
                    *(u32x2*)(orow + c) = w;
                }
            }
        }
        __syncthreads();
    }
    const int gtid = blockIdx.x * NTHREADS + tid, nth = gridDim.x * NTHREADS;
    for (int idx = gtid; idx < M * 128; idx += nth) {
        const int row = idx >> 7, c = (idx & 127) * 8, t = row % L;
        float acc[8];
#pragma unroll
        for (int e = 0; e < 8; ++e) acc[e] = 0.f;
#pragma unroll
        for (int j = 0; j < 3; ++j) {
            if (t - 2 + j >= 0) {
                const bf16_t* zr = z1 + (size_t)(row - 2 + j) * NAB;
                const u32x4 sc = *(const u32x4*)(zr + 3072 + c), sx = *(const u32x4*)(zr + 4096 + c);
                const f32x4 w0 = *(const f32x4*)(sc_dw + j * 1024 + c), w1 = *(const f32x4*)(sc_dw + j * 1024 + c + 4);
                acc[0] += lo_f(sc.x) * lo_f(sx.x) * w0[0]; acc[1] += hi_f(sc.x) * hi_f(sx.x) * w0[1];
                acc[2] += lo_f(sc.y) * lo_f(sx.y) * w0[2]; acc[3] += hi_f(sc.y) * hi_f(sx.y) * w0[3];
                acc[4] += lo_f(sc.z) * lo_f(sx.z) * w1[0]; acc[5] += hi_f(sc.z) * hi_f(sx.z) * w1[1];
                acc[6] += lo_f(sc.w) * lo_f(sx.w) * w1[2]; acc[7] += hi_f(sc.w) * hi_f(sx.w) * w1[3];
            }
        }
        const u32x4 sb = *(const u32x4*)(z1 + (size_t)row * NAB + 2048 + c);
        u32x4 o;
        o.x = pk2(lo_f(sb.x) * acc[0], hi_f(sb.x) * acc[1]); o.y = pk2(lo_f(sb.y) * acc[2], hi_f(sb.y) * acc[3]);
        o.z = pk2(lo_f(sb.z) * acc[4], hi_f(sb.z) * acc[5]); o.w = pk2(lo_f(sb.w) * acc[6], hi_f(sb.w) * acc[7]);
        *(u32x4*)(cat + (size_t)row * D + 1024 + c) = o;
    }
}

__device__ void ffn_gate_phase(const bf16_t* __restrict__ u, const float* __restrict__ dw  , bf16_t* __restrict__ g) {
    const int gtid = blockIdx.x * NTHREADS + threadIdx.x, nth = gridDim.x * NTHREADS;
    constexpr int NC8 = DFF / 8, NRUN = L / 16;
    for (int idx = gtid; idx < NBATCH * NRUN * NC8; idx += nth) {
        const int c = (idx % NC8) * 8, run = (idx / NC8) % NRUN, b = idx / (NC8 * NRUN), t0 = run * 16;
        float wv[3][8], wg[3][8];
#pragma unroll
        for (int j = 0; j < 3; ++j) {
            const f32x4 a0 = *(const f32x4*)(dw + j * NUP + c), a1 = *(const f32x4*)(dw + j * NUP + c + 4);
            const f32x4 g0 = *(const f32x4*)(dw + j * NUP + DFF + c), g1 = *(const f32x4*)(dw + j * NUP + DFF + c + 4);
#pragma unroll
            for (int e = 0; e < 4; ++e) { wv[j][e] = a0[e]; wv[j][4 + e] = a1[e]; wg[j][e] = g0[e]; wg[j][4 + e] = g1[e]; }
        }
        u32x4 v2 = (u32x4){0u, 0u, 0u, 0u}, v1 = v2, g2 = v2, g1 = v2;
        if (t0 >= 2) {
            const bf16_t* r2 = u + (size_t)(b * L + t0 - 2) * NUP; const bf16_t* r1 = r2 + NUP;
            v2 = *(const u32x4*)(r2 + c); g2 = *(const u32x4*)(r2 + DFF + c); v1 = *(const u32x4*)(r1 + c); g1 = *(const u32x4*)(r1 + DFF + c);
        }
#pragma unroll 4
        for (int i = 0; i < 16; ++i) {
            const size_t row = (size_t)(b * L + t0 + i);
            const u32x4 v0 = *(const u32x4*)(u + row * NUP + c), g0 = *(const u32x4*)(u + row * NUP + DFF + c);
            float val[8], gat[8];
#define TAP(e, W2, W1, W0, sel) \
            val[e] = sel(v2.W2) * wv[0][e] + sel(v1.W1) * wv[1][e] + sel(v0.W0) * wv[2][e]; gat[e] = sel(g2.W2) * wg[0][e] + sel(g1.W1) * wg[1][e] + sel(g0.W0) * wg[2][e];
            TAP(0, x, x, x, lo_f) TAP(1, x, x, x, hi_f) TAP(2, y, y, y, lo_f) TAP(3, y, y, y, hi_f)
            TAP(4, z, z, z, lo_f) TAP(5, z, z, z, hi_f) TAP(6, w, w, w, lo_f) TAP(7, w, w, w, hi_f)
#undef TAP
            u32x4 o;
            o.x = pk2(silu(gat[0]) * val[0], silu(gat[1]) * val[1]); o.y = pk2(silu(gat[2]) * val[2], silu(gat[3]) * val[3]);
            o.z = pk2(silu(gat[4]) * val[4], silu(gat[5]) * val[5]); o.w = pk2(silu(gat[6]) * val[6], silu(gat[7]) * val[7]);
            *(u32x4*)(g + row * DFF + c) = o;
            v2 = v1; g2 = g1; v1 = v0; g1 = g0;
        }
    }
}

struct CD {
    const float *z2, *gla_w2, *gla_b, *gla_norm_g, *rw_mu, *rw_w0, *rw_a0, *rw_kk, *rw_ka, *rw_rk, *rw_ln_g, *rw_ln_b;
    float *R, *KR, *VR, *G, *Y, *CDEC, *BONUS, *DECAY, *A, *KK, *O;
    bf16_t *LW, *LA, *LG, *GATE, *QDEC, *KDEC, *K2T, *VT, *W2T, *A2T, *G2T, *CST, *SPT, *P, *CAT;
};

__device__ void prep1_phase(const CD& p, LAS unsigned char* lds) {
    const int tid = threadIdx.x, wid = __builtin_amdgcn_readfirstlane(tid >> 6), lane = tid & 63;
    LAS float* tot = (LAS float*)lds;
    for (int item = blockIdx.x; item < NGI; item += gridDim.x) {
        const int bh = item / NCH, n = item - bh * NCH, b = bh >> 2, h = bh & 3;
        const int pg = wid >> 1, d = (wid & 1) * 64 + lane;
        float w2r[16];
#pragma unroll
        for (int r = 0; r < 16; ++r) w2r[r] = p.gla_w2[r * 512 + h * 128 + d];
        const float bias = p.gla_b[h * 128 + d];
        float la[16]; float run = 0.f;
#pragma unroll
        for (int i = 0; i < 16; ++i) {
            const int t = n * 64 + pg * 16 + i - 48;
            float v = 0.f;
            if (t >= 0 && t < L) {
                const float* gl = p.z2 + (size_t)(b * L + t) * NCDP + 3072;
                float xx = bias;
#pragma unroll
                for (int r = 0; r < 16; ++r) xx += gl[r] * w2r[r];
                v = logsig(xx) * (1.0f / 16.0f);
            }
            run += v; la[i] = run;
        }
        tot[pg * 128 + d] = run;
        __syncthreads();
        float off = 0.f, last = 0.f;
#pragma unroll
        for (int g4 = 0; g4 < 4; ++g4) { const float tv = tot[g4 * 128 + d]; if (g4 < pg) off += tv; last += tv; }
        unsigned k2p[8];
#pragma unroll
        for (int i = 0; i < 16; ++i) {
            const int pp = pg * 16 + i, t = n * 64 + pp - 48;
            const float cum = off + la[i];
            float q = 0.f, k = 0.f;
            if (t >= 0 && t < L) { const float* zr = p.z2 + (size_t)(b * L + t) * NCDP; q = zr[h * 128 + d] * 0.08838834764831845f; k = zr[512 + h * 128 + d]; }
            const float qd = q * expf(cum), kd = k * expf(-cum), k2 = k * expf(last - cum);
            p.QDEC[((size_t)item * 64 + pp) * 128 + d] = (bf16_t)f2bf(qd);
            p.KDEC[((size_t)item * 64 + pp) * 128 + d] = (bf16_t)f2bf(kd);
            if (i & 1) k2p[i >> 1] |= f2bf(k2) << 16; else k2p[i >> 1] = f2bf(k2);
        }
        {
            bf16_t* dst = p.K2T + ((size_t)item * 128 + d) * 64 + pg * 16;
            *(u32x4*)(dst) = (u32x4){k2p[0], k2p[1], k2p[2], k2p[3]};
            *(u32x4*)(dst + 8) = (u32x4){k2p[4], k2p[5], k2p[6], k2p[7]};
        }
        if (pg == 0) p.CDEC[item * 128 + d] = expf(last);
        {
            const int v = tid & 255, ph = tid >> 8;
            unsigned vp[16];
#pragma unroll
            for (int i = 0; i < 32; ++i) {
                const int t = n * 64 + ph * 32 + i - 48;
                float xv = 0.f;
                if (t >= 0 && t < L) xv = p.z2[(size_t)(b * L + t) * NCDP + 1024 + h * 256 + v];
                if (i & 1) vp[i >> 1] |= f2bf(xv) << 16; else vp[i >> 1] = f2bf(xv);
            }
            bf16_t* dst = p.VT + ((size_t)item * 256 + v) * 64 + ph * 32;
#pragma unroll
            for (int s = 0; s < 4; ++s) *(u32x4*)(dst + s * 8) = (u32x4){vp[s * 4 + 0], vp[s * 4 + 1], vp[s * 4 + 2], vp[s * 4 + 3]};
        }
        __syncthreads();
    }
    const int gtid = blockIdx.x * NTHREADS + tid, nth = gridDim.x * NTHREADS;
    for (int idx = gtid; idx < M * 256; idx += nth) {
        const int row = idx >> 8, c = (idx & 255) * 4;
        const f32x4 go = *(const f32x4*)(p.z2 + (size_t)row * NCDP + 2048 + c), ng = *(const f32x4*)(p.gla_norm_g + c);
        u32x2 w; w.x = pk2(silu(go[0]) * ng[0], silu(go[1]) * ng[1]); w.y = pk2(silu(go[2]) * ng[2], silu(go[3]) * ng[3]);
        *(u32x2*)(p.GATE + (size_t)row * 1024 + c) = w;
    }
    for (int idx = gtid; idx < M * 832; idx += nth) {
        const int row = idx / 832, c4 = (idx - row * 832) * 4, t = row % L;
        const f32x4 z = *(const f32x4*)(p.z2 + (size_t)row * NCDP + 3088 + c4);
        f32x4 zp = (f32x4){0.f, 0.f, 0.f, 0.f};
        if (t > 0) zp = *(const f32x4*)(p.z2 + (size_t)(row - 1) * NCDP + 3088 + c4);
        const f32x4 mu = *(const f32x4*)(p.rw_mu + c4);
        const f32x4 zr = z + (zp - z) * mu;
        if (c4 < 1024) *(f32x4*)(p.R + (size_t)row * 1024 + c4) = zr;
        else if (c4 < 2048) *(f32x4*)(p.KR + (size_t)row * 1024 + c4 - 1024) = zr;
        else if (c4 < 3072) *(f32x4*)(p.VR + (size_t)row * 1024 + c4 - 2048) = zr;
        else if (c4 < 3136) { u32x2 w; w.x = pk2(tanhf(zr[0]), tanhf(zr[1])); w.y = pk2(tanhf(zr[2]), tanhf(zr[3])); *(u32x2*)(p.LW + (size_t)row * 64 + c4 - 3072) = w; }
        else if (c4 < 3200) { u32x2 w; w.x = pk2(zr[0], zr[1]); w.y = pk2(zr[2], zr[3]); *(u32x2*)(p.LA + (size_t)row * 64 + c4 - 3136) = w; }
        else { u32x2 w; w.x = pk2(sigm(zr[0]), sigm(zr[1])); w.y = pk2(sigm(zr[2]), sigm(zr[3])); *(u32x2*)(p.LG + (size_t)row * 128 + c4 - 3200) = w; }
    }
}

__device__ void small_gemm_phase(const CD& p) {
    const int lane = threadIdx.x & 63, fr = lane & 15, fq = lane >> 4;
    const int gw = blockIdx.x * 8 + (threadIdx.x >> 6), nw = gridDim.x * 8;
    constexpr int TL = (M / 64) * 16;
    constexpr int T0 = 3 * TL, T1 = T0 + NGI, T2 = T1 + NGI * 8;
    for (int tix = gw; tix < T2; tix += nw) {
        f32x4 acc[4][4]; zero_acc(acc);
        if (tix < T0) {
            const int which = tix / TL, r = tix - which * TL, m0 = (r >> 4) * 64, n0 = (r & 15) * 64;
            if (which == 0) {
                wave_tile_mma(p.LW + (size_t)m0 * 64, 64, p.W2T + (size_t)n0 * 64, 64, 0, 64, acc, fr, fq);
#pragma unroll
                for (int mi = 0; mi < 4; ++mi)
#pragma unroll
                    for (int ni = 0; ni < 4; ++ni) {
                        const int row = m0 + mi * 16 + fr, col = n0 + ni * 16 + fq * 4;
                        const f32x4 w0 = *(const f32x4*)(p.rw_w0 + col); f32x4 o;
#pragma unroll
                        for (int e = 0; e < 4; ++e) o[e] = expf(-expf(logsig(w0[e] + acc[mi][ni][e]) - 0.5f));
                        *(f32x4*)(p.DECAY + (size_t)row * 1024 + col) = o;
                    }
            } else if (which == 1) {
                wave_tile_mma(p.LA + (size_t)m0 * 64, 64, p.A2T + (size_t)n0 * 64, 64, 0, 64, acc, fr, fq);
#pragma unroll
                for (int mi = 0; mi < 4; ++mi)
#pragma unroll
                    for (int ni = 0; ni < 4; ++ni) {
                        const int row = m0 + mi * 16 + fr, col = n0 + ni * 16 + fq * 4;
                        const f32x4 a0 = *(const f32x4*)(p.rw_a0 + col); f32x4 o;
#pragma unroll
                        for (int e = 0; e < 4; ++e) o[e] = sigm(a0[e] + acc[mi][ni][e]);
                        *(f32x4*)(p.A + (size_t)row * 1024 + col) = o;
                    }
            } else {
                wave_tile_mma(p.LG + (size_t)m0 * 128, 128, p.G2T + (size_t)n0 * 128, 128, 0, 128, acc, fr, fq);
#pragma unroll
                for (int mi = 0; mi < 4; ++mi)
#pragma unroll
                    for (int ni = 0; ni < 4; ++ni) {
                        const int row = m0 + mi * 16 + fr, col = n0 + ni * 16 + fq * 4;
                        *(f32x4*)(p.G + (size_t)row * 1024 + col) = acc[mi][ni];
                    }
            }
        } else if (tix < T1) {
            const int item = tix - T0;
            wave_tile_mma(p.QDEC + (size_t)item * 8192, 128, p.KDEC + (size_t)item * 8192, 128, 0, 128, acc, fr, fq);
#pragma unroll
            for (int mi = 0; mi < 4; ++mi)
#pragma unroll
                for (int ni = 0; ni < 4; ++ni) {
                    const int pp = mi * 16 + fr, s0 = ni * 16 + fq * 4;
                    f32x4 v = acc[mi][ni];
#pragma unroll
                    for (int e = 0; e < 4; ++e) if (s0 + e > pp) v[e] = 0.f;
                    u32x2 w; w.x = pk2(v[0], v[1]); w.y = pk2(v[2], v[3]);
                    *(u32x2*)(p.P + (size_t)item * 4096 + pp * 64 + s0) = w;
                }
        } else {
            const int r = tix - T1, item = r >> 3, vt = (r >> 1) & 3, dt = r & 1;
            wave_tile_mma(p.VT + ((size_t)item * 256 + vt * 64) * 64, 64, p.K2T + ((size_t)item * 128 + dt * 64) * 64, 64, 0, 64, acc, fr, fq);
#pragma unroll
            for (int mi = 0; mi < 4; ++mi)
#pragma unroll
                for (int ni = 0; ni < 4; ++ni) {
                    const int v = vt * 64 + mi * 16 + fr, d0 = dt * 64 + ni * 16 + fq * 4;
                    u32x2 w; w.x = pk2(acc[mi][ni][0], acc[mi][ni][1]); w.y = pk2(acc[mi][ni][2], acc[mi][ni][3]);
                    *(u32x2*)(p.CST + ((size_t)item * 256 + v) * 128 + d0) = w;
                }
        }
    }
}

__device__ void prep2_phase(const CD& p) {
    const int lane = threadIdx.x & 63;
    const int gw = blockIdx.x * 8 + (threadIdx.x >> 6), nw = gridDim.x * 8;
    for (int it = gw; it < M * 4; it += nw) {
        const int row = it >> 2, h = (it & 3) * 4 + (lane >> 4), c = h * 64 + (lane & 15) * 4;
        const size_t o = (size_t)row * 1024 + c;
        const f32x4 kr = *(const f32x4*)(p.KR + o), a = *(const f32x4*)(p.A + o), r = *(const f32x4*)(p.R + o);
        f32x4 kk = kr * *(const f32x4*)(p.rw_kk + c);
        const float ss = sum16(kk[0] * kk[0] + kk[1] * kk[1] + kk[2] * kk[2] + kk[3] * kk[3]);
        kk = kk * (1.0f / fmaxf(sqrtf(ss), 1e-12f));
        const f32x4 k = kr * (1.0f + (a - 1.0f) * *(const f32x4*)(p.rw_ka + c));
        const f32x4 rk = r * k * *(const f32x4*)(p.rw_rk + c);
        const float bs = sum16((rk[0] + rk[1]) + (rk[2] + rk[3]));
        *(f32x4*)(p.KK + o) = kk; *(f32x4*)(p.A + o) = kk * a; *(f32x4*)(p.KR + o) = k;
        if ((lane & 15) == 0) p.BONUS[row * 16 + h] = bs;
    }
    const int gtid = blockIdx.x * NTHREADS + threadIdx.x, nth = gridDim.x * NTHREADS;
    for (int e = gtid; e < 16 * 256 * 32; e += nth) {
        const int d4 = (e & 31) * 4, v = (e >> 5) & 255, bh = e >> 13;
        f32x4 S = (f32x4){0.f, 0.f, 0.f, 0.f};
#pragma unroll 3
        for (int n = 0; n < NCH; ++n) {
            const int item = bh * NCH + n;
            const size_t o = ((size_t)item * 256 + v) * 128 + d4;
            u32x2 w; w.x = pk2(S[0], S[1]); w.y = pk2(S[2], S[3]);
            *(u32x2*)(p.SPT + o) = w;
            const f32x4 dec = *(const f32x4*)(p.CDEC + item * 128 + d4);
            const u32x2 cs = *(const u32x2*)(p.CST + o);
            S = S * dec + (f32x4){lo_f(cs.x), hi_f(cs.x), lo_f(cs.y), hi_f(cs.y)};
        }
    }
}

__device__ void gla_out_phase(const CD& p) {
    const int lane = threadIdx.x & 63, fr = lane & 15, fq = lane >> 4;
    const int gw = blockIdx.x * 8 + (threadIdx.x >> 6), nw = gridDim.x * 8;
    for (int tix = gw; tix < NGI * 4; tix += nw) {
        const int item = tix >> 2, vt = tix & 3, bh = item / NCH, n = item - bh * NCH, b = bh >> 2, h = bh & 3;
        f32x4 acc[4][4]; zero_acc(acc);
        wave_tile_mma(p.P + (size_t)item * 4096, 64, p.VT + ((size_t)item * 256 + vt * 64) * 64, 64, 0, 64, acc, fr, fq);
        wave_tile_mma(p.QDEC + (size_t)item * 8192, 128, p.SPT + ((size_t)item * 256 + vt * 64) * 128, 128, 0, 128, acc, fr, fq);
#pragma unroll
        for (int mi = 0; mi < 4; ++mi) {
            const int t = n * 64 + mi * 16 + fr - 48;
            if (t >= 0 && t < L) {
#pragma unroll
                for (int ni = 0; ni < 4; ++ni) *(f32x4*)(p.O + (size_t)(b * L + t) * 1024 + h * 256 + vt * 64 + ni * 16 + fq * 4) = acc[mi][ni];
            }
        }
    }
}

__device__ __forceinline__ float oct_sum(float x) {
    x += __int_as_float(__builtin_amdgcn_update_dpp(0, __float_as_int(x), 0xB1, 0xF, 0xF, false));
    x += __int_as_float(__builtin_amdgcn_update_dpp(0, __float_as_int(x), 0x4E, 0xF, 0xF, false));
    x += __int_as_float(__builtin_amdgcn_update_dpp(0, __float_as_int(x), 0x141, 0xF, 0xF, false));
    return x;
}
struct StepOps { f32x4 r[2], w[2], k[2], kk[2], b[2]; float v; };
__device__ __forceinline__ void ld_ops(StepOps& o, const LAS float* bp, int s, int j, int vidx) {
    const LAS float* sp = bp + s * 64 + j * 8;
    o.r[0] = *(const LAS f32x4*)(sp); o.r[1] = *(const LAS f32x4*)(sp + 4);
    o.w[0] = *(const LAS f32x4*)(sp + 2048); o.w[1] = *(const LAS f32x4*)(sp + 2048 + 4);
    o.k[0] = *(const LAS f32x4*)(sp + 4096); o.k[1] = *(const LAS f32x4*)(sp + 4096 + 4);
    o.kk[0] = *(const LAS f32x4*)(sp + 6144); o.kk[1] = *(const LAS f32x4*)(sp + 6144 + 4);
    o.b[0] = *(const LAS f32x4*)(sp + 8192); o.b[1] = *(const LAS f32x4*)(sp + 8192 + 4);
    o.v = bp[10240 + s * 64 + vidx];
}
__device__ __forceinline__ float scan_step(f32x2 (&S)[4], const StepOps& o) {
    f32x2 sa2 = S[0] * o.kk[0].lo + S[1] * o.kk[0].hi;
    sa2 += S[2] * o.kk[1].lo + S[3] * o.kk[1].hi;
    const f32x2 vv = (f32x2){o.v, o.v};
    const f32x2 t0 = vv * o.k[0].lo, t1 = vv * o.k[0].hi, t2 = vv * o.k[1].lo, t3 = vv * o.k[1].hi;
    const float sa = -oct_sum(sa2[0] + sa2[1]);
    const f32x2 sv = (f32x2){sa, sa};
    S[0] = S[0] * o.w[0].lo + (sv * o.b[0].lo + t0);
    S[1] = S[1] * o.w[0].hi + (sv * o.b[0].hi + t1);
    S[2] = S[2] * o.w[1].lo + (sv * o.b[1].lo + t2);
    S[3] = S[3] * o.w[1].hi + (sv * o.b[1].hi + t3);
    f32x2 y2 = S[0] * o.r[0].lo + S[1] * o.r[0].hi;
    y2 += S[2] * o.r[1].lo + S[3] * o.r[1].hi;
    return oct_sum(y2[0] + y2[1]);
}
__device__ void rwkv_scan_phase(const CD& p, LAS unsigned char* lds) {
    const int tid = threadIdx.x, wid = __builtin_amdgcn_readfirstlane(tid >> 6), lane = tid & 63;
    LAS float* buf = (LAS float*)lds;
    constexpr int NCHUNK = (L + 31) / 32;
    for (int item = blockIdx.x; item < 256; item += gridDim.x) {
        const int bh = item >> 2, q = item & 3, b = bh >> 4, h = bh & 15;
        const int rr = tid >> 4, c4 = (tid & 15) * 4;
        const size_t gbase = (size_t)(b * L) * 1024 + h * 64 + c4;
        f32x4 st0, st1, st2, st3, st4, st5;
#define SCAN_LOADS(tn) do { const size_t _o = gbase + (size_t)(tn) * 1024; \
        st0 = *(const f32x4*)(p.R + _o); st1 = *(const f32x4*)(p.DECAY + _o); st2 = *(const f32x4*)(p.KR + _o); \
        st3 = *(const f32x4*)(p.KK + _o); st4 = *(const f32x4*)(p.A + _o); st5 = *(const f32x4*)(p.VR + _o); } while (0)
#define SCAN_STORES(bb) do { LAS float* _d = buf + (bb) * 12288 + rr * 64 + c4; \
        *(LAS f32x4*)(_d) = st0; *(LAS f32x4*)(_d + 2048) = st1; *(LAS f32x4*)(_d + 4096) = st2; \
        *(LAS f32x4*)(_d + 6144) = st3; *(LAS f32x4*)(_d + 8192) = st4; *(LAS f32x4*)(_d + 10240) = st5; } while (0)
        SCAN_LOADS(rr);
        SCAN_STORES(0);
        __syncthreads();
        f32x2 S[4];
#pragma unroll
        for (int i = 0; i < 4; ++i) S[i] = (f32x2){0.f, 0.f};
        const int srow = lane >> 3, j = lane & 7, vidx = q * 16 + wid * 8 + srow;
        int cb = 0;
        for (int c = 0; c < NCHUNK; ++c) {
            const int t0 = c * 32;
            const bool more = (c + 1 < NCHUNK);
            if (more) {
                const int tn = t0 + 32 + rr;
                if (tn < L) SCAN_LOADS(tn);
                else { st0 = (f32x4){0.f, 0.f, 0.f, 0.f}; st1 = st0; st2 = st0; st3 = st0; st4 = st0; st5 = st0; }
            }
            if (wid < 2) {
                const LAS float* bp = buf + cb * 12288;
                const int ns = (L - t0) < 32 ? (L - t0) : 32;
                float* yp = p.Y + (size_t)(b * L + t0) * 1024 + h * 64 + vidx;
                StepOps A, B;
                ld_ops(A, bp, 0, j, vidx);
                for (int s = 0; s < ns; s += 2) {
                    ld_ops(B, bp, s + 1, j, vidx);
                    const float ya = scan_step(S, A);
                    if (j == 0) yp[(size_t)s * 1024] = ya;
                    if (s + 2 < ns) ld_ops(A, bp, s + 2, j, vidx);
                    const float yb = scan_step(S, B);
                    if (j == 0) yp[(size_t)(s + 1) * 1024] = yb;
                }
            }
            if (more) SCAN_STORES(cb ^ 1);
            __syncthreads();
            cb ^= 1;
        }
#undef SCAN_LOADS
#undef SCAN_STORES
    }
}

__device__ void post_phase(const CD& p) {
    const int lane = threadIdx.x & 63;
    const int gw = blockIdx.x * 8 + (threadIdx.x >> 6), nw = gridDim.x * 8;
    for (int it = gw; it < M * 4; it += nw) {
        const int row = it >> 2, h = it & 3;
        const size_t o = (size_t)row * 1024 + h * 256 + lane * 4;
        const f32x4 v = *(const f32x4*)(p.O + o);
        const float ss = wave_sum(v[0] * v[0] + v[1] * v[1] + v[2] * v[2] + v[3] * v[3]);
        const float rs = rsqrtf(ss * (1.0f / 256.0f) + 1e-6f);
        const u32x2 gt = *(const u32x2*)(p.GATE + o);
        u32x2 w; w.x = pk2(v[0] * rs * lo_f(gt.x), v[1] * rs * hi_f(gt.x)); w.y = pk2(v[2] * rs * lo_f(gt.y), v[3] * rs * hi_f(gt.y));
        *(u32x2*)(p.CAT + (size_t)row * D + h * 256 + lane * 4) = w;
    }
    for (int it = gw; it < M * 4; it += nw) {
        const int row = it >> 2, h = (it & 3) * 4 + (lane >> 4), c = h * 64 + (lane & 15) * 4;
        const size_t o = (size_t)row * 1024 + c;
        const f32x4 y = *(const f32x4*)(p.Y + o);
        const float mu = sum16((y[0] + y[1]) + (y[2] + y[3])) * (1.0f / 64.0f);
        const f32x4 dv = y - mu;
        const float var = sum16(dv[0] * dv[0] + dv[1] * dv[1] + dv[2] * dv[2] + dv[3] * dv[3]) * (1.0f / 64.0f);
        const float rstd = rsqrtf(var + 64e-5f);
        const f32x4 yn = dv * rstd * *(const f32x4*)(p.rw_ln_g + c) + *(const f32x4*)(p.rw_ln_b + c);
        const float bonus = p.BONUS[row * 16 + h];
        const f32x4 res = (yn + bonus * *(const f32x4*)(p.VR + o)) * *(const f32x4*)(p.G + o);
        u32x2 w; w.x = pk2(res[0], res[1]); w.y = pk2(res[2], res[3]);
        *(u32x2*)(p.CAT + (size_t)row * D + 1024 + c) = w;
    }
}

struct Params { const float* in[31]; float* out; unsigned char* ws; };

__global__ void __launch_bounds__(NTHREADS, 2) fwd_megakernel(Params prm) {
    extern __shared__ __attribute__((aligned(16))) unsigned char lds_raw[];
    LAS unsigned char* lds = (LAS unsigned char*)lds_raw;
    cg::grid_group grid = cg::this_grid();
    size_t zoff = 0;
    unsigned char* ws = prm.ws;
    {
        unsigned* bw = (unsigned*)(ws + XO_BAR);
        if (blockIdx.x == 0) {
            for (int i = threadIdx.x; i < BAR_WORDS; i += NTHREADS) bw[i] = 0u;
            float* ss = (float*)(ws + XO_SS);
            for (int i = threadIdx.x; i < 3 * M; i += NTHREADS) ss[i] = 0.f;
        }
        if (threadIdx.x < 4) ((LAS unsigned*)(lds + 131072))[threadIdx.x] = 0u;
        __syncthreads();
    }
    XcdBarrier xbar; xbar.bar = (unsigned*)(ws + XO_BAR); xbar.x = 0; xbar.st = (volatile LAS unsigned*)(lds + 131072);
#define SYNC() do { xcd_barrier(xbar); asm volatile("" : "+s"(zoff) :: "memory"); ws = prm.ws + zoff; } while (0)
#define SYNC0() do { grid.sync(); xbar = xcd_barrier_post((unsigned*)(ws + XO_BAR), (volatile LAS unsigned*)(lds + 131072)); asm volatile("" : "+s"(zoff) :: "memory"); ws = prm.ws + zoff; } while (0)
#define WSF(off) ((float*)(ws + (off)))
#define WSB(off) ((bf16_t*)(ws + (off)))
#define CTR(j) ((unsigned*)(ws + XO_BAR) + 3456 + (j))
#define SSQ(j) (WSF(XO_SS) + (j) * M)
#define MKCD(p) CD p; \
        p.z2 = WSF(OFF_Z); p.gla_w2 = prm.in[10]; p.gla_b = prm.in[11]; p.gla_norm_g = prm.in[12]; p.rw_mu = prm.in[13]; p.rw_w0 = prm.in[14]; p.rw_a0 = prm.in[16]; \
        p.rw_kk = prm.in[19]; p.rw_ka = prm.in[20]; p.rw_rk = prm.in[21]; p.rw_ln_g = prm.in[22]; p.rw_ln_b = prm.in[23]; \
        p.R = WSF(XO_R); p.KR = WSF(XO_KR); p.VR = WSF(XO_VR); p.G = WSF(XO_G); p.Y = WSF(XO_Y); \
        p.CDEC = WSF(XO_CDEC); p.BONUS = WSF(XO_BONUS); p.DECAY = WSF(ZO_DECAY); p.A = WSF(ZO_A); p.KK = WSF(ZO_KK); p.O = WSF(ZO_O); \
        p.LW = WSB(XO_LW); p.LA = WSB(XO_LA); p.LG = WSB(XO_LG); p.GATE = WSB(XO_GATE); \
        p.QDEC = WSB(XO_QDEC); p.KDEC = WSB(XO_KDEC); p.K2T = WSB(XO_K2T); p.VT = WSB(XO_VT); \
        p.W2T = WSB(XO_W2T); p.A2T = WSB(XO_A2T); p.G2T = WSB(XO_G2T); \
        p.CST = WSB(ZO_CST); p.SPT = WSB(ZO_SPT); p.P = WSB(ZO_P); p.CAT = WSB(OFF_ACT);

    rms_phase<1>(nullptr, WSF(OFF_H), prm.in[0], prm.in[1], prm.in[25], WSB(OFF_HN), nullptr);
    convert_wt(prm.in[2], WSB(XO_WB), D, NAB, NAB, nullptr, lds);
    convert_wt(prm.in[15], WSB(XO_W2T), 64, 1024, 1024, nullptr, lds);
    convert_wt(prm.in[17], WSB(XO_A2T), 64, 1024, 1024, nullptr, lds);
    convert_wt(prm.in[18], WSB(XO_G2T), 128, 1024, 1024, nullptr, lds);
    SYNC0();
    gemm_full(lds, WSB(OFF_HN), WSB(XO_WB), NAB, D, EpStoreBf16{WSB(OFF_Z), NAB});
    convert_steal(prm.in[8], WSB(XO_WC), D, D, D, nullptr, CTR(0), lds);
    convert_steal(prm.in[27], WSB(OFF_W), D, NUP, NUP, prm.in[26], CTR(1), lds);
    SYNC();
    mixer_ab_phase(WSB(OFF_Z), prm.in[3], prm.in[4], prm.in[5], prm.in[6], prm.in[7], WSB(OFF_ACT), lds);
    SYNC();
    gemm_full(lds, WSB(OFF_ACT), WSB(XO_WC), D, D, EpResid{WSF(OFF_H), WSB(OFF_HN), SSQ(0)});
    SYNC();
    gemm_full(lds, WSB(OFF_HN), WSB(OFF_W), NUP, D, EpScaleStoreBf16{WSB(OFF_Z), NUP, SSQ(0)});
    convert_steal(prm.in[29], WSB(XO_WC), DFF, D, D, nullptr, CTR(2), lds);
    convert_steal(prm.in[9], WSB(XO_WB), D, NCD, NCDP, prm.in[25] + D, CTR(3), lds);
    SYNC();
    ffn_gate_phase(WSB(OFF_Z), prm.in[28], WSB(OFF_ACT));
    SYNC();
    gemm_full(lds, WSB(OFF_ACT), WSB(XO_WC), D, DFF, EpResid{WSF(OFF_H), WSB(OFF_HN), SSQ(1)});
    SYNC();
    gemm_full(lds, WSB(OFF_HN), WSB(XO_WB), NCDP, D, EpScaleStoreF32{WSF(OFF_Z), NCDP, SSQ(1)});
    convert_steal(prm.in[24], WSB(XO_WC), D, D, D, nullptr, CTR(4), lds);
    convert_steal(prm.in[27] + (size_t)D * NUP, WSB(OFF_W), D, NUP, NUP, prm.in[26] + D, CTR(5), lds);
    SYNC();
    { MKCD(p) prep1_phase(p, lds); }
    SYNC();
    { MKCD(p) small_gemm_phase(p); }
    SYNC();
    { MKCD(p) prep2_phase(p); }
    SYNC();
    { MKCD(p) gla_out_phase(p); }
    { MKCD(p) rwkv_scan_phase(p, lds); }
    SYNC();
    { MKCD(p) post_phase(p); }
    SYNC();
    gemm_full(lds, WSB(OFF_ACT), WSB(XO_WC), D, D, EpResid{WSF(OFF_H), WSB(OFF_HN), SSQ(2)});
    SYNC();
    gemm_full(lds, WSB(OFF_HN), WSB(OFF_W), NUP, D, EpScaleStoreBf16{WSB(OFF_Z), NUP, SSQ(2)});
    convert_steal(prm.in[29] + (size_t)DFF * D, WSB(XO_WC), DFF, D, D, nullptr, CTR(6), lds);
    SYNC();
    ffn_gate_phase(WSB(OFF_Z), prm.in[28] + (size_t)3 * NUP, WSB(OFF_ACT));
    SYNC();
    gemm_full(lds, WSB(OFF_ACT), WSB(XO_WC), D, DFF, EpAddF32{WSF(OFF_H), D});
    SYNC();
    rms_phase<2>(WSF(OFF_H), nullptr, nullptr, nullptr, prm.in[30], nullptr, prm.out);
}

extern "C" void kernel_launch(void* const* d_in, const int* in_sizes, int n_in, void* d_out, int out_size, void* d_ws, size_t ws_size, hipStream_t stream) {
    static int grid_blocks = 0;
    if (!grid_blocks) {
        if (n_in != 31 || ws_size < WS_END) { fprintf(stderr, "kernel_launch: expected 31 inputs and >= %zu bytes of workspace (got %d, %zu)\n", (size_t)WS_END, n_in, ws_size); grid_blocks = -1; return; }
        int dev = 0, cus = 0, per_cu = 0;
        hipGetDevice(&dev);
        hipDeviceGetAttribute(&cus, hipDeviceAttributeMultiprocessorCount, dev);
        hipFuncSetAttribute((const void*)fwd_megakernel, hipFuncAttributeMaxDynamicSharedMemorySize, LDS_BYTES);
        hipOccupancyMaxActiveBlocksPerMultiprocessor(&per_cu, (const void*)fwd_megakernel, NTHREADS, LDS_BYTES);
        if (per_cu < 1) per_cu = 1;
        if (per_cu > 1) per_cu = 1;
        (void)hipGetLastError();
        grid_blocks = cus * per_cu;
    }
    if (grid_blocks < 0) return;
    Params p{};
    for (int i = 0; i < 31; ++i) p.in[i] = (const float*)d_in[i];
    p.out = (float*)d_out; p.ws = (unsigned char*)d_ws;
    void* args[] = {&p};
    hipError_t e = hipLaunchCooperativeKernel((const void*)fwd_megakernel, dim3(grid_blocks), dim3(NTHREADS), args, LDS_BYTES, stream);
    if (e != hipSuccess) fprintf(stderr, "cooperative launch failed: %s (grid %d)\n", hipGetErrorString(e), grid_blocks);
}
```

```cpp
#include <hip/hip_runtime.h>
#include <hip/hip_cooperative_groups.h>
#include <cstdio>
namespace cg = cooperative_groups;

#define LAS __attribute__((address_space(3)))
typedef unsigned short bf16_t;
typedef short bf16x8 __attribute__((ext_vector_type(8)));
typedef float f32x4 __attribute__((ext_vector_type(4)));
typedef float f32x2 __attribute__((ext_vector_type(2)));
typedef unsigned u32x4 __attribute__((ext_vector_type(4)));
typedef unsigned u32x2 __attribute__((ext_vector_type(2)));

constexpr int D = 2048, L = 2064, NBATCH = 4, SEQ = 2048, NMETA = 16, M = NBATCH * L  , MBIG = 8192;
constexpr int DFF = 5632, NUP = 2 * DFF, NAB = 5120, NCD = 6416, NCDP = 6656;
constexpr int NCH = 33;
constexpr int NGI = NBATCH * 4 * NCH;
constexpr int LDS_BYTES = 131072 + 16;
constexpr int NTHREADS = 512;

constexpr size_t al256(size_t x) { return (x + 255) & ~(size_t)255; }
constexpr size_t OFF_H = 0;
constexpr size_t OFF_W = OFF_H + al256((size_t)M * D * 4);
constexpr size_t OFF_HN = OFF_W + al256((size_t)NUP * D * 2);
constexpr size_t OFF_Z = OFF_HN + al256((size_t)M * D * 2);
constexpr size_t OFF_ACT = OFF_Z + al256((size_t)M * NCDP * 4);
constexpr size_t OFF_X = OFF_ACT + al256((size_t)M * DFF * 2);
constexpr size_t SZ_M1024F = al256((size_t)M * 1024 * 4);
constexpr size_t XO_R = OFF_X;
constexpr size_t XO_KR = XO_R + SZ_M1024F;
constexpr size_t XO_VR = XO_KR + SZ_M1024F;
constexpr size_t XO_G = XO_VR + SZ_M1024F;
constexpr size_t XO_Y = OFF_HN;
constexpr size_t XO_LW = XO_G + SZ_M1024F;
constexpr size_t XO_LA = XO_LW + al256((size_t)M * 64 * 2);
constexpr size_t XO_LG = XO_LA + al256((size_t)M * 64 * 2);
constexpr size_t XO_GATE = XO_LG + al256((size_t)M * 128 * 2);
constexpr size_t XO_QDEC = XO_GATE + al256((size_t)M * 1024 * 2);
constexpr size_t XO_KDEC = XO_QDEC + al256((size_t)NGI * 64 * 128 * 2);
constexpr size_t XO_K2T = XO_KDEC + al256((size_t)NGI * 64 * 128 * 2);
constexpr size_t XO_VT = XO_K2T + al256((size_t)NGI * 64 * 128 * 2);
constexpr size_t XO_CDEC = XO_VT + al256((size_t)NGI * 256 * 64 * 2);
constexpr size_t XO_BONUS = XO_CDEC + al256((size_t)NGI * 128 * 4);
constexpr size_t XO_W2T = XO_BONUS + al256((size_t)M * 16 * 4);
constexpr size_t XO_A2T = XO_W2T + al256((size_t)1024 * 64 * 2);
constexpr size_t XO_G2T = XO_A2T + al256((size_t)1024 * 64 * 2);
constexpr size_t XO_BAR = XO_G2T + al256((size_t)1024 * 128 * 2);
constexpr int BAR_WORDS = 3456 + 64;
constexpr size_t XO_SS = XO_BAR + al256((size_t)BAR_WORDS * 4);
constexpr size_t XO_WB = XO_SS + al256((size_t)3 * M * 4);
constexpr size_t XO_WC = XO_WB + al256((size_t)NCDP * D * 2);
constexpr size_t WS_END = XO_WC + al256((size_t)D * DFF * 2);
constexpr size_t ZO_DECAY = OFF_Z;
constexpr size_t ZO_A = ZO_DECAY + SZ_M1024F;
constexpr size_t ZO_KK = ZO_A + SZ_M1024F;
constexpr size_t ZO_O = ZO_KK + SZ_M1024F;
constexpr size_t ZO_CST = ZO_O + SZ_M1024F;
constexpr size_t ZO_SPT = ZO_CST + al256((size_t)NGI * 256 * 128 * 2);
constexpr size_t ZO_P = ZO_SPT + al256((size_t)NGI * 256 * 128 * 2);
constexpr size_t ZO_END = ZO_P + al256((size_t)NGI * 64 * 64 * 2);
static_assert(ZO_END <= OFF_ACT, "Z sub-regions overflow");
static_assert(SZ_M1024F <= (size_t)M * D * 2 + 256, "Y must fit in HN");

__device__ __forceinline__ float bf2f(unsigned b) { return __uint_as_float(b << 16); }
__device__ __forceinline__ unsigned f2bf(float f) { unsigned u = __float_as_uint(f); u += 0x7FFFu + ((u >> 16) & 1u); return u >> 16; }
__device__ __forceinline__ unsigned pk2(float lo, float hi) { return f2bf(lo) | (f2bf(hi) << 16); }
__device__ __forceinline__ float lo_f(unsigned w) { return __uint_as_float(w << 16); }
__device__ __forceinline__ float hi_f(unsigned w) { return __uint_as_float(w & 0xffff0000u); }
__device__ __forceinline__ float sigm(float x) { return 1.0f / (1.0f + expf(-x)); }
__device__ __forceinline__ float silu(float x) { return x * sigm(x); }
__device__ __forceinline__ float logsig(float x) { return fminf(x, 0.f) - log1pf(expf(-fabsf(x))); }
__device__ __forceinline__ float wave_sum(float v) {
#pragma unroll
    for (int o = 32; o >= 1; o >>= 1) v += __shfl_xor(v, o);
    return v;
}
__device__ __forceinline__ float sum16(float v) {
#pragma unroll
    for (int o = 8; o >= 1; o >>= 1) v += __shfl_xor(v, o);
    return v;
}
__device__ __forceinline__ float quad_sum(float x) {
    x += __int_as_float(__builtin_amdgcn_update_dpp(0, __float_as_int(x), 0xB1, 0xF, 0xF, false));
    x += __int_as_float(__builtin_amdgcn_update_dpp(0, __float_as_int(x), 0x4E, 0xF, 0xF, false));
    return x;
}


#define XB_TMO      128
#define XB_XCNT(j)  (256  + 64 * (j))
#define XB_XSUB(j)  (1280 + 64 * (j))
#define XB_XGEN(j)  (2304 + 64 * (j))
#define XB_TOP      3328
#define XB_TOPGEN   3392
#define XCD_BAR_WORDS 3456
#define XB_SPIN_CAP (1u << 20)
__device__ __forceinline__ unsigned xb_ld(unsigned* p)              { return __hip_atomic_load(p, __ATOMIC_RELAXED, __HIP_MEMORY_SCOPE_AGENT); }
__device__ __forceinline__ unsigned xb_add(unsigned* p, unsigned v) { return __hip_atomic_fetch_add(p, v, __ATOMIC_RELAXED, __HIP_MEMORY_SCOPE_AGENT); }
__device__ __forceinline__ unsigned xb_xcc_id() { return (unsigned)__builtin_amdgcn_s_getreg((3 << 11) | 20) & 0xFu; }
#define XB_SPIN(cond, bar) do { unsigned _sp = 0; while (cond) { __builtin_amdgcn_s_sleep(1); \
    if ((++_sp & 255u) == 0u) { if (xb_ld(&(bar)[XB_TMO])) break; if (_sp > XB_SPIN_CAP) { atomicAdd(&(bar)[XB_TMO], 1u); break; } } } } while (0)
struct XcdBarrier { unsigned* bar; unsigned x; volatile LAS unsigned* st; };
__device__ __forceinline__ XcdBarrier xcd_barrier_post(unsigned* bar, volatile LAS unsigned* st) {
    XcdBarrier b; b.bar = bar; b.x = xb_xcc_id(); b.st = st;
    if (threadIdx.x == 0) (void)xb_add(&bar[XB_XCNT(b.x)], 1u);
    return b;
}
__device__ __forceinline__ void xcd_barrier_complete(unsigned* bar, unsigned x, unsigned& nloc, unsigned& nx) {
    const unsigned G = gridDim.x * gridDim.y * gridDim.z;
    unsigned sum, cnt, mine, sp = 0u;
    for (;;) {
        sum = 0u; cnt = 0u; mine = 0u;
#pragma unroll
        for (unsigned j = 0; j < 16; ++j) { const unsigned c = xb_ld(&bar[XB_XCNT(j)]); sum += c; cnt += (c > 0u) ? 1u : 0u; mine = (j == x) ? c : mine; }
        if (sum == G) break;
        __builtin_amdgcn_s_sleep(1);
        if ((++sp & 255u) == 0u) { if (xb_ld(&bar[XB_TMO])) break; if (sp > XB_SPIN_CAP) { atomicAdd(&bar[XB_TMO], 1u); break; } }
    }
    nloc = mine > 0u ? mine : 1u; nx = cnt > 0u ? cnt : 1u;
}
__device__ __forceinline__ void xcd_barrier(const XcdBarrier& b) {
    asm volatile("s_waitcnt vmcnt(0)" ::: "memory");
    __syncthreads();
    if (threadIdx.x == 0) {
        unsigned* bar = b.bar;
        __builtin_amdgcn_s_waitcnt(0);
        unsigned nloc = b.st[0], nx = b.st[1];
        if (nloc == 0u) { xcd_barrier_complete(bar, b.x, nloc, nx); b.st[0] = nloc; b.st[1] = nx; }
        const unsigned old = xb_add(&bar[XB_XSUB(b.x)], 1u);
        const unsigned gen = old / nloc;
        if (old + 1u == (gen + 1u) * nloc) {
            __builtin_amdgcn_fence(__ATOMIC_RELEASE, "agent");
            asm volatile("s_waitcnt vmcnt(0)" ::: "memory");
            const unsigned og = xb_add(&bar[XB_TOP], 1u);
            const unsigned tg = og / nx;
            if (og + 1u == (tg + 1u) * nx) xb_add(&bar[XB_TOPGEN], 1u);
            else XB_SPIN(xb_ld(&bar[XB_TOPGEN]) == tg, bar);
            __builtin_amdgcn_fence(__ATOMIC_ACQUIRE, "agent");
            xb_add(&bar[XB_XGEN(b.x)], 1u);
            asm volatile("s_waitcnt vmcnt(0)" ::: "memory");
        } else {
            XB_SPIN(xb_ld(&bar[XB_XGEN(b.x)]) == gen, bar);
            __builtin_amdgcn_fence(__ATOMIC_ACQUIRE, "agent");
            asm volatile("s_waitcnt vmcnt(0)" ::: "memory");
        }
    }
    __syncthreads();
}

namespace pg8 {
constexpr int BM = 256, BK = 64, HALF = 128, HTB = HALF * BK * 2, NXCD = 8, WGM = 8;
__device__ __forceinline__ int lds_byte(int r, int c) { const int st = (r >> 4) * 2 + (c >> 5), rr = r & 15, cc = c & 31, ob = rr * 64 + cc * 2; return st * 1024 + (ob ^ (((ob >> 9) & 1) << 5)); }
__device__ __forceinline__ void stage_rc(int b, int& R, int& C) { const int st = b / 1024, sb = b % 1024, swz = sb ^ (((sb >> 9) & 1) << 5); R = (st >> 1) * 16 + swz / 64; C = (st & 1) * 32 + (swz % 64) / 2; }
struct Unit { int pm, pn; };
struct StaticOrder {
    int nM, nN, nwg, G, c;
    __device__ void init(int Mr, int N, int G_, int c_) { nM = Mr / BM; nN = N / BM; nwg = nM * nN; G = G_; c = c_; }
    __device__ bool next(int i, Unit& u) const {
        const long Lx = (long)i * G + c; if (Lx >= nwg) return false;
        int wgid = (int)Lx; { const int q = nwg / NXCD, r = nwg % NXCD, xcd = wgid % NXCD, off = wgid / NXCD; wgid = (xcd < r ? xcd * (q + 1) : r * (q + 1) + (xcd - r) * q) + off; }
        const int nig = WGM * nN, gid = wgid / nig, fm = gid * WGM, gsz = (nM - fm) < WGM ? (nM - fm) : WGM;
        u.pm = fm + ((wgid % nig) % gsz); u.pn = (wgid % nig) / gsz; return true;
    }
};
template <class F>
__device__ __forceinline__ void gemm_phase(LAS unsigned char* lds, const bf16_t* gA, const bf16_t* gBt, const int K, const StaticOrder& S, const F& f) {
    int tid = threadIdx.x; asm volatile("" : "+v"(tid));
    const int wid = __builtin_amdgcn_readfirstlane(tid >> 6), lane = tid & 63, wr = wid >> 2, wc = wid & 3, fr = lane & 15, fq = lane >> 4;
    const int nt = K / BK;
    unsigned voffA[2];
#pragma unroll
    for (int i = 0; i < 2; ++i) { int R, C; stage_rc(tid * 16 + i * 8192, R, C); voffA[i] = (unsigned)(R * K + C) * 2u; }
    const size_t kstep = (size_t)(BK * 2);
    const size_t hstep = (size_t)HALF * K * 2;
    const size_t tstep = 2 * hstep;
    const unsigned ldsw = (unsigned)wid * 1024u;
    const int aoff = lds_byte(wr * 64 + fr, fq * 8), boff = lds_byte(wc * 32 + fr, fq * 8);
#define PG8_SA(b, h) (((b) * 2 + (h)) * HTB)
#define PG8_SB(b, h) ((4 + (b) * 2 + (h)) * HTB)
#define PG8_STAGE(bufoff, gbase, voff) do { _Pragma("unroll") for (int _i = 0; _i < 2; ++_i) \
        __builtin_amdgcn_global_load_lds((const unsigned*)((const char*)(gbase) + (voff)[_i]), (LAS unsigned*)(lds + (bufoff) + ldsw + _i * 8192), 16, 0, 0); } while (0)
#define PG8_LDA(dst, b, h) do { _Pragma("unroll") for (int m = 0; m < 4; ++m) _Pragma("unroll") for (int k = 0; k < 2; ++k) dst[m][k] = *(const LAS bf16x8*)(lds + PG8_SA(b, h) + aoff + m * 2048 + k * 1024); } while (0)
#define PG8_LDB(dst, b, h) do { _Pragma("unroll") for (int n = 0; n < 2; ++n) _Pragma("unroll") for (int k = 0; k < 2; ++k) dst[n][k] = *(const LAS bf16x8*)(lds + PG8_SB(b, h) + boff + n * 2048 + k * 1024); } while (0)
#define PG8_MMA(ai, bj, At, Bt) do { __builtin_amdgcn_s_setprio(1); _Pragma("unroll") for (int m = 0; m < 4; ++m) _Pragma("unroll") for (int n = 0; n < 2; ++n) _Pragma("unroll") for (int k = 0; k < 2; ++k) \
        acc[ai][bj][m][n] = __builtin_amdgcn_mfma_f32_16x16x32_bf16(Bt[n][k], At[m][k], acc[ai][bj][m][n], 0, 0, 0); __builtin_amdgcn_s_setprio(0); } while (0)
#define PG8_WAIT_V(n) asm volatile("s_waitcnt vmcnt(" #n ")" ::: "memory")
#define PG8_WAIT_L(n) asm volatile("s_waitcnt lgkmcnt(" #n ")" ::: "memory")
#define PG8_BAR __builtin_amdgcn_s_barrier()
#define PG8_SCHED __builtin_amdgcn_sched_barrier(0)
    Unit cur, nxt; int ui = 0;
    if (!S.next(0, cur)) return;
    f32x4 acc[2][2][4][2];
#pragma unroll
    for (int a = 0; a < 2; ++a)
#pragma unroll
        for (int b = 0; b < 2; ++b)
#pragma unroll
            for (int m = 0; m < 4; ++m)
#pragma unroll
                for (int n = 0; n < 2; ++n) acc[a][b][m][n] = (f32x4){0.f, 0.f, 0.f, 0.f};
    bf16x8 At[4][2], B0[2][2], B1[2][2];
    const char* cA = (const char*)gA + (size_t)cur.pm * tstep; const char* cB = (const char*)gBt + (size_t)cur.pn * tstep;
    PG8_STAGE(PG8_SB(0, 0), cB, voffA); PG8_STAGE(PG8_SA(0, 0), cA, voffA); PG8_STAGE(PG8_SB(0, 1), cB + hstep, voffA); PG8_STAGE(PG8_SA(0, 1), cA + hstep, voffA);
    if (wr == 1) PG8_BAR;
    PG8_WAIT_V(4); PG8_BAR;
    PG8_STAGE(PG8_SB(1, 0), cB + kstep, voffA); PG8_STAGE(PG8_SA(1, 0), cA + kstep, voffA); PG8_STAGE(PG8_SB(1, 1), cB + hstep + kstep, voffA);
    PG8_WAIT_V(6); PG8_BAR;
    for (;;) {
        const bool has_next = S.next(ui + 1, nxt);
        const char* nA = has_next ? (const char*)gA + (size_t)nxt.pm * tstep : cA; const char* nB = has_next ? (const char*)gBt + (size_t)nxt.pn * tstep : cB;
        for (int t = 0; t < nt; t += 2) {
            const bool last = (t == nt - 2);
            const char* a1 = cA + (size_t)(t + 1) * kstep;
            const char* a2 = last ? nA : cA + (size_t)(t + 2) * kstep; const char* b2 = last ? nB : cB + (size_t)(t + 2) * kstep;
            const char* a3 = a2 + kstep; const char* b3 = b2 + kstep;
            PG8_LDB(B0, 0, 0); PG8_SCHED; PG8_LDA(At, 0, 0); PG8_STAGE(PG8_SA(1, 1), a1 + hstep, voffA);
            PG8_WAIT_L(8); PG8_BAR; PG8_WAIT_L(0); PG8_MMA(0, 0, At, B0); PG8_BAR; PG8_SCHED;
            PG8_LDB(B1, 0, 1); PG8_STAGE(PG8_SB(0, 0), b2, voffA);
            PG8_BAR; PG8_WAIT_L(0); PG8_MMA(0, 1, At, B1); PG8_BAR;
            PG8_LDA(At, 0, 1); PG8_STAGE(PG8_SA(0, 0), a2, voffA);
            PG8_BAR; PG8_WAIT_L(0); PG8_MMA(1, 0, At, B0); PG8_BAR; PG8_SCHED;
            PG8_STAGE(PG8_SB(0, 1), b2 + hstep, voffA);
            PG8_WAIT_V(6); PG8_BAR; PG8_MMA(1, 1, At, B1); PG8_BAR;
            PG8_LDB(B0, 1, 0); PG8_SCHED; PG8_LDA(At, 1, 0); PG8_STAGE(PG8_SA(0, 1), a2 + hstep, voffA);
            PG8_WAIT_L(8); PG8_BAR; PG8_WAIT_L(0); PG8_MMA(0, 0, At, B0); PG8_BAR; PG8_SCHED;
            PG8_LDB(B1, 1, 1); PG8_STAGE(PG8_SB(1, 0), b3, voffA);
            PG8_BAR; PG8_WAIT_L(0); PG8_MMA(0, 1, At, B1); PG8_BAR;
            PG8_LDA(At, 1, 1); PG8_STAGE(PG8_SA(1, 0), a3, voffA);
            PG8_BAR; PG8_WAIT_L(0); PG8_MMA(1, 0, At, B0); PG8_BAR; PG8_SCHED;
            PG8_STAGE(PG8_SB(1, 1), b3 + hstep, voffA);
            PG8_WAIT_V(6); PG8_BAR; PG8_MMA(1, 1, At, B1); PG8_BAR;
        }
        {
            const int row0 = cur.pm * BM + wr * 64 + fr, col0 = cur.pn * BM + wc * 32 + 4 * fq;
            float sc[2][4];
#pragma unroll
            for (int ai = 0; ai < 2; ++ai)
#pragma unroll
                for (int m = 0; m < 4; ++m) sc[ai][m] = f.begin(row0 + ai * HALF + m * 16);
#pragma unroll
            for (int ai = 0; ai < 2; ++ai)
#pragma unroll
                for (int m = 0; m < 4; ++m) {
                    const int row = row0 + ai * HALF + m * 16;
                    f32x4 hv[2][2];
#pragma unroll
                    for (int bj = 0; bj < 2; ++bj)
#pragma unroll
                        for (int n = 0; n < 2; ++n) hv[bj][n] = f.pre(row, col0 + bj * HALF + n * 16);
                    float ssq = 0.f;
#pragma unroll
                    for (int bj = 0; bj < 2; ++bj)
#pragma unroll
                        for (int n = 0; n < 2; ++n) ssq += f(row, col0 + bj * HALF + n * 16, acc[ai][bj][m][n], hv[bj][n], sc[ai][m]);
                    f.end(row, ssq, 0);
                }
        }
        if (!has_next) break;
#pragma unroll
        for (int a = 0; a < 2; ++a)
#pragma unroll
            for (int b = 0; b < 2; ++b)
#pragma unroll
                for (int m = 0; m < 4; ++m)
#pragma unroll
                    for (int n = 0; n < 2; ++n) acc[a][b][m][n] = (f32x4){0.f, 0.f, 0.f, 0.f};
        cur = nxt; cA = nA; cB = nB; ++ui;
    }
    PG8_WAIT_V(0);
    if (wr == 0) PG8_BAR;
    PG8_BAR;
#undef PG8_SA
#undef PG8_SB
#undef PG8_STAGE
#undef PG8_LDA
#undef PG8_LDB
#undef PG8_MMA
#undef PG8_WAIT_V
#undef PG8_WAIT_L
#undef PG8_BAR
#undef PG8_SCHED
}
}

__device__ __forceinline__ void wave_tile_mma(const bf16_t* __restrict__ A, int lda, const bf16_t* __restrict__ Bt, int ldb, int k0, int k1, f32x4 (&acc)[4][4], int fr, int fq) {
    const bf16_t* ap = A + (size_t)fr * lda + fq * 8;
    const bf16_t* bp = Bt + (size_t)fr * ldb + fq * 8;
#pragma unroll 2
    for (int k = k0; k < k1; k += 32) {
        bf16x8 a[4], b[4];
#pragma unroll
        for (int i = 0; i < 4; ++i) { a[i] = *(const bf16x8*)(ap + (size_t)i * 16 * lda + k); b[i] = *(const bf16x8*)(bp + (size_t)i * 16 * ldb + k); }
#pragma unroll
        for (int mi = 0; mi < 4; ++mi)
#pragma unroll
            for (int ni = 0; ni < 4; ++ni) acc[mi][ni] = __builtin_amdgcn_mfma_f32_16x16x32_bf16(b[ni], a[mi], acc[mi][ni], 0, 0, 0);
    }
}
__device__ __forceinline__ void zero_acc(f32x4 (&acc)[4][4]) {
#pragma unroll
    for (int i = 0; i < 4; ++i)
#pragma unroll
        for (int j = 0; j < 4; ++j) acc[i][j] = (f32x4){0.f, 0.f, 0.f, 0.f};
}

template <class F>
__device__ __forceinline__ void gemm_rem_phase(LAS unsigned char* lds, const bf16_t* A, const bf16_t* Bt, int N, int K, const F& f) {
    const int tid = threadIdx.x, wid = __builtin_amdgcn_readfirstlane(tid >> 6), lane = tid & 63, fr = lane & 15, fq = lane >> 4;
    const int ntiles = N / 64, kw = K / 8;
    for (int tile = (int)gridDim.x - 1 - (int)blockIdx.x; tile < ntiles; tile += gridDim.x) {
        const int n0 = tile * 64;
        f32x4 acc[4][4]; zero_acc(acc);
        wave_tile_mma(A + (size_t)MBIG * K, K, Bt + (size_t)n0 * K, K, wid * kw, (wid + 1) * kw, acc, fr, fq);
        LAS float* P = (LAS float*)lds + wid * 4096;
#pragma unroll
        for (int mi = 0; mi < 4; ++mi)
#pragma unroll
            for (int ni = 0; ni < 4; ++ni) *(LAS f32x4*)(P + (mi * 16 + fr) * 64 + ni * 16 + fq * 4) = acc[mi][ni];
        __syncthreads();
#pragma unroll
        for (int i = 0; i < 2; ++i) {
            const int idx = tid + i * 512, r = idx >> 4, c4 = (idx & 15) * 4;
            f32x4 s = (f32x4){0.f, 0.f, 0.f, 0.f};
#pragma unroll
            for (int w = 0; w < 8; ++w) s += *(const LAS f32x4*)((LAS float*)lds + w * 4096 + r * 64 + c4);
            const float sc = f.begin(MBIG + r);
            const f32x4 hv = f.pre(MBIG + r, n0 + c4);
            const float ssq = f(MBIG + r, n0 + c4, s, hv, sc);
            f.end(MBIG + r, ssq, 1);
        }
        __syncthreads();
    }
}

__device__ __forceinline__ float rstd_of(const float* SS, int row) { return rsqrtf(SS[row] * (1.0f / D) + 1e-6f); }
struct EpStoreBf16 { bf16_t* O; int ld;
    __device__ __forceinline__ float begin(int) const { return 1.f; }
    __device__ __forceinline__ f32x4 pre(int, int) const { return (f32x4){0.f, 0.f, 0.f, 0.f}; }
    __device__ __forceinline__ float operator()(int row, int col, f32x4 v, f32x4, float) const { u32x2 w; w.x = pk2(v[0], v[1]); w.y = pk2(v[2], v[3]); *(u32x2*)(O + (size_t)row * ld + col) = w; return 0.f; }
    __device__ __forceinline__ void end(int, float, int) const {} };
struct EpScaleStoreBf16 { bf16_t* O; int ld; const float* SS;
    __device__ __forceinline__ float begin(int row) const { return rstd_of(SS, row); }
    __device__ __forceinline__ f32x4 pre(int, int) const { return (f32x4){0.f, 0.f, 0.f, 0.f}; }
    __device__ __forceinline__ float operator()(int row, int col, f32x4 v, f32x4, float s) const { v = v * s; u32x2 w; w.x = pk2(v[0], v[1]); w.y = pk2(v[2], v[3]); *(u32x2*)(O + (size_t)row * ld + col) = w; return 0.f; }
    __device__ __forceinline__ void end(int, float, int) const {} };
struct EpScaleStoreF32 { float* O; int ld; const float* SS;
    __device__ __forceinline__ float begin(int row) const { return rstd_of(SS, row); }
    __device__ __forceinline__ f32x4 pre(int, int) const { return (f32x4){0.f, 0.f, 0.f, 0.f}; }
    __device__ __forceinline__ float operator()(int row, int col, f32x4 v, f32x4, float s) const { *(f32x4*)(O + (size_t)row * ld + col) = v * s; return 0.f; }
    __device__ __forceinline__ void end(int, float, int) const {} };
struct EpAddF32 { float* H; int ld;
    __device__ __forceinline__ float begin(int) const { return 1.f; }
    __device__ __forceinline__ f32x4 pre(int row, int col) const { return *(const f32x4*)(H + (size_t)row * ld + col); }
    __device__ __forceinline__ float operator()(int row, int col, f32x4 v, f32x4 h, float) const { *(f32x4*)(H + (size_t)row * ld + col) = h + v; return 0.f; }
    __device__ __forceinline__ void end(int, float, int) const {} };
struct EpResid { float* H; bf16_t* HB; float* SS;
    __device__ __forceinline__ float begin(int) const { return 1.f; }
    __device__ __forceinline__ f32x4 pre(int row, int col) const { return *(const f32x4*)(H + (size_t)row * D + col); }
    __device__ __forceinline__ float operator()(int row, int col, f32x4 v, f32x4 h0, float) const {
        const f32x4 h = h0 + v; *(f32x4*)(H + (size_t)row * D + col) = h;
        u32x2 w; w.x = pk2(h[0], h[1]); w.y = pk2(h[2], h[3]); *(u32x2*)(HB + (size_t)row * D + col) = w;
        return (h[0] * h[0] + h[1] * h[1]) + (h[2] * h[2] + h[3] * h[3]); }
    __device__ __forceinline__ void end(int row, float ssq, int kind) const {
        const int lane = threadIdx.x & 63;
        if (kind == 0) { ssq += __shfl_xor(ssq, 16); ssq += __shfl_xor(ssq, 32); if (lane < 16) atomicAdd(SS + row, ssq); }
        else { ssq = sum16(ssq); if ((lane & 15) == 0) atomicAdd(SS + row, ssq); } } };

template <class F>
__device__ __forceinline__ void gemm_full(LAS unsigned char* lds, const bf16_t* A, const bf16_t* Bt, int N, int K, const F& f) {
    pg8::StaticOrder S; S.init(MBIG, N, (int)gridDim.x, (int)blockIdx.x);
    pg8::gemm_phase(lds, A, Bt, K, S, f);
    gemm_rem_phase(lds, A, Bt, N, K, f);
}

__device__ __forceinline__ void convert_tile(const float* __restrict__ src, bf16_t* __restrict__ dst, int K, int N, const float* __restrict__ gain, int t, LAS float* tile) {
    const int tid = threadIdx.x;
    const int tk = K / 64;
    const int k0 = (t % tk) * 64, n0 = (t / tk) * 64;
#pragma unroll
    for (int i = 0; i < 2; ++i) {
        const int idx = tid + i * 512, k = idx >> 4, n4 = (idx & 15) * 4;
        f32x4 v = (f32x4){0.f, 0.f, 0.f, 0.f};
        if (n0 + n4 < N) v = *(const f32x4*)(src + (size_t)(k0 + k) * N + n0 + n4);
        if (gain) v = v * gain[k0 + k];
        tile[k * 65 + n4 + 0] = v[0]; tile[k * 65 + n4 + 1] = v[1]; tile[k * 65 + n4 + 2] = v[2]; tile[k * 65 + n4 + 3] = v[3];
    }
    __syncthreads();
    {
        const int n = tid >> 3, ks = (tid & 7) * 8;
        u32x4 w;
        w.x = pk2(tile[(ks + 0) * 65 + n], tile[(ks + 1) * 65 + n]); w.y = pk2(tile[(ks + 2) * 65 + n], tile[(ks + 3) * 65 + n]);
        w.z = pk2(tile[(ks + 4) * 65 + n], tile[(ks + 5) * 65 + n]); w.w = pk2(tile[(ks + 6) * 65 + n], tile[(ks + 7) * 65 + n]);
        *(u32x4*)(dst + (size_t)(n0 + n) * K + k0 + ks) = w;
    }
    __syncthreads();
}
__device__ void convert_wt(const float* __restrict__ src, bf16_t* __restrict__ dst, int K, int N, int Npad, const float* __restrict__ gain, LAS unsigned char* lds) {
    const int ntiles = (K / 64) * (Npad / 64);
    for (int t = blockIdx.x; t < ntiles; t += gridDim.x) convert_tile(src, dst, K, N, gain, t, (LAS float*)lds);
}
__device__ void convert_steal(const float* __restrict__ src, bf16_t* __restrict__ dst, int K, int N, int Npad, const float* __restrict__ gain, unsigned* ctr, LAS unsigned char* lds) {
    const int ntiles = (K / 64) * (Npad / 64);
    volatile LAS unsigned* slot = (volatile LAS unsigned*)(lds + 131072 + 8);
    for (;;) {
        if (threadIdx.x == 0) *slot = __hip_atomic_fetch_add(ctr, 4u, __ATOMIC_RELAXED, __HIP_MEMORY_SCOPE_AGENT);
        __syncthreads();
        const int t0 = (int)*slot;
        __syncthreads();
        if (t0 >= ntiles) break;
#pragma unroll 1
        for (int t = t0; t < t0 + 4 && t < ntiles; ++t) convert_tile(src, dst, K, N, gain, t, (LAS float*)lds);
    }
}

template <int MODE>
__device__ void rms_phase(const float* __restrict__ h_in, float* __restrict__ h_out, const float* __restrict__ x, const float* __restrict__ meta,
                          const float* __restrict__ gain, bf16_t* __restrict__ hn, float* __restrict__ out) {
    const int lane = threadIdx.x & 63, gw = blockIdx.x * 8 + (threadIdx.x >> 6), nw = gridDim.x * 8;
    for (int row = gw; row < M; row += nw) {
        const int b = row / L, t = row - b * L;
        if (MODE == 2 && t < NMETA) continue;
        const float* src;
        if (MODE == 1) src = (t < NMETA) ? meta + (size_t)t * D : x + ((size_t)b * SEQ + (t - NMETA)) * D;
        else src = h_in + (size_t)row * D;
        f32x4 v[8]; float ss = 0.f;
#pragma unroll
        for (int i = 0; i < 8; ++i) { v[i] = *(const f32x4*)(src + (lane + i * 64) * 4); ss += v[i][0] * v[i][0] + v[i][1] * v[i][1] + v[i][2] * v[i][2] + v[i][3] * v[i][3]; }
        ss = wave_sum(ss);
        const float r = rsqrtf(ss * (1.0f / D) + 1e-6f);
#pragma unroll
        for (int i = 0; i < 8; ++i) {
            const int c = (lane + i * 64) * 4;
            const f32x4 g = *(const f32x4*)(gain + c);
            const f32x4 o = v[i] * r * g;
            if (MODE == 1) *(f32x4*)(h_out + (size_t)row * D + c) = v[i];
            if (MODE == 2) *(f32x4*)(out + ((size_t)b * SEQ + (t - NMETA)) * D + c) = o;
            else { u32x2 w; w.x = pk2(o[0], o[1]); w.y = pk2(o[2], o[3]); *(u32x2*)(hn + (size_t)row * D + c) = w; }
        }
    }
}

__device__ void mixer_ab_phase(const bf16_t* __restrict__ z1, const float* __restrict__ conf_dw, const float* __restrict__ conf_b, const float* __restrict__ ln_g,
                               const float* __restrict__ ln_b, const float* __restrict__ sc_dw, bf16_t* __restrict__ cat, LAS unsigned char* lds) {
    const int tid = threadIdx.x, wid = __builtin_amdgcn_readfirstlane(tid >> 6), lane = tid & 63;
    LAS unsigned* S32 = (LAS unsigned*)lds;
    LAS float* C = (LAS float*)lds;
    for (int tile = blockIdx.x; tile < NBATCH * 65; tile += gridDim.x) {
        const int b = tile / 65, t0 = (tile % 65) * 32;
        const int nt = (L - t0) < 32 ? (L - t0) : 32;
        for (int r = 0; r < 62; ++r) {
            const int t = t0 - 30 + r; unsigned w = 0u;
            if (t >= 0 && t < L) {
                const bf16_t* zr = z1 + (size_t)(b * L + t) * NAB;
                const unsigned a = *(const unsigned*)(zr + 2 * tid), g = *(const unsigned*)(zr + 1024 + 2 * tid);
                w = pk2(lo_f(a) * sigm(lo_f(g)), hi_f(a) * sigm(hi_f(g)));
            }
            S32[r * 512 + tid] = w;
        }
        __syncthreads();
        f32x2 acc[32];
#pragma unroll
        for (int t = 0; t < 32; ++t) acc[t] = (f32x2){0.f, 0.f};
#pragma unroll 1
        for (int j = 0; j < 31; ++j) {
            const f32x2 w = *(const f32x2*)(conf_dw + j * 1024 + 2 * tid);
#pragma unroll
            for (int t = 0; t < 32; ++t) { const unsigned xw = S32[(t + j) * 512 + tid]; acc[t] += (f32x2){lo_f(xw), hi_f(xw)} * w; }
        }
        const f32x2 bias = *(const f32x2*)(conf_b + 2 * tid);
        __syncthreads();
#pragma unroll
        for (int t = 0; t < 32; ++t) *(LAS f32x2*)(C + t * 1024 + 2 * tid) = acc[t] + bias;
        __syncthreads();
        for (int q = 0; q < 4; ++q) {
            const int tt = wid * 4 + q;
            if (tt < nt) {
                f32x4 v[4]; float s = 0.f;
#pragma unroll
                for (int i = 0; i < 4; ++i) { v[i] = *(const LAS f32x4*)(C + tt * 1024 + (lane + i * 64) * 4); s += (v[i][0] + v[i][1]) + (v[i][2] + v[i][3]); }
                const float mean = wave_sum(s) * (1.0f / 1024.0f);
                float qv = 0.f;
#pragma unroll
                for (int i = 0; i < 4; ++i) { const f32x4 d = v[i] - mean; qv += d[0] * d[0] + d[1] * d[1] + d[2] * d[2] + d[3] * d[3]; }
                const float rstd = rsqrtf(wave_sum(qv) * (1.0f / 1024.0f) + 1e-5f);
                bf16_t* orow = cat + (size_t)(b * L + t0 + tt) * D;
#pragma unroll
                for (int i = 0; i < 4; ++i) {
                    const int c = (lane + i * 64) * 4;
                    const f32x4 g = *(const f32x4*)(ln_g + c), bb = *(const f32x4*)(ln_b + c);
                    const f32x4 y = (v[i] - mean) * rstd * g + bb;
                    u32x2 w; w.x = pk2(silu(y[0]), silu(y[1])); w.y = pk2(silu(y[2]), silu(y[3]));
                    *(u32x2*)(orow + c) = w;
                }
            }
        }
        __syncthreads();
    }
    const int gtid = blockIdx.x * NTHREADS + tid, nth = gridDim.x * NTHREADS;
    for (int idx = gtid; idx < M * 128; idx += nth) {
        const int row = idx >> 7, c = (idx & 127) * 8, t = row % L;
        float acc[8];
#pragma unroll
        for (int e = 0; e < 8; ++e) acc[e] = 0.f;
#pragma unroll
        for (int j = 0; j < 3; ++j) {
            if (t - 2 + j >= 0) {
                const bf16_t* zr = z1 + (size_t)(row - 2 + j) * NAB;
                const u32x4 sc = *(const u32x4*)(zr + 3072 + c), sx = *(const u32x4*)(zr + 4096 + c);
                const f32x4 w0 = *(const f32x4*)(sc_dw + j * 1024 + c), w1 = *(const f32x4*)(sc_dw + j * 1024 + c + 4);
                acc[0] += lo_f(sc.x) * lo_f(sx.x) * w0[0]; acc[1] += hi_f(sc.x) * hi_f(sx.x) * w0[1];
                acc[2] += lo_f(sc.y) * lo_f(sx.y) * w0[2]; acc[3] += hi_f(sc.y) * hi_f(sx.y) * w0[3];
                acc[4] += lo_f(sc.z) * lo_f(sx.z) * w1[0]; acc[5] += hi_f(sc.z) * hi_f(sx.z) * w1[1];
                acc[6] += lo_f(sc.w) * lo_f(sx.w) * w1[2]; acc[7] += hi_f(sc.w) * hi_f(sx.w) * w1[3];
            }
        }
        const u32x4 sb = *(const u32x4*)(z1 + (size_t)row * NAB + 2048 + c);
        u32x4 o;
        o.x = pk2(lo_f(sb.x) * acc[0], hi_f(sb.x) * acc[1]); o.y = pk2(lo_f(sb.y) * acc[2], hi_f(sb.y) * acc[3]);
        o.z = pk2(lo_f(sb.z) * acc[4], hi_f(sb.z) * acc[5]); o.w = pk2(lo_f(sb.w) * acc[6], hi_f(sb.w) * acc[7]);
        *(u32x4*)(cat + (size_t)row * D + 1024 + c) = o;
    }
}

__device__ void ffn_gate_phase(const bf16_t* __restrict__ u, const float* __restrict__ dw  , bf16_t* __restrict__ g) {
    const int gtid = blockIdx.x * NTHREADS + threadIdx.x, nth = gridDim.x * NTHREADS;
    constexpr int NC8 = DFF / 8, NRUN = L / 16;
    for (int idx = gtid; idx < NBATCH * NRUN * NC8; idx += nth) {
        const int c = (idx % NC8) * 8, run = (idx / NC8) % NRUN, b = idx / (NC8 * NRUN), t0 = run * 16;
        float wv[3][8], wg[3][8];
#pragma unroll
        for (int j = 0; j < 3; ++j) {
            const f32x4 a0 = *(const f32x4*)(dw + j * NUP + c), a1 = *(const f32x4*)(dw + j * NUP + c + 4);
            const f32x4 g0 = *(const f32x4*)(dw + j * NUP + DFF + c), g1 = *(const f32x4*)(dw + j * NUP + DFF + c + 4);
#pragma unroll
            for (int e = 0; e < 4; ++e) { wv[j][e] = a0[e]; wv[j][4 + e] = a1[e]; wg[j][e] = g0[e]; wg[j][4 + e] = g1[e]; }
        }
        u32x4 v2 = (u32x4){0u, 0u, 0u, 0u}, v1 = v2, g2 = v2, g1 = v2;
        if (t0 >= 2) {
            const bf16_t* r2 = u + (size_t)(b * L + t0 - 2) * NUP; const bf16_t* r1 = r2 + NUP;
            v2 = *(const u32x4*)(r2 + c); g2 = *(const u32x4*)(r2 + DFF + c); v1 = *(const u32x4*)(r1 + c); g1 = *(const u32x4*)(r1 + DFF + c);
        }
#pragma unroll 4
        for (int i = 0; i < 16; ++i) {
            const size_t row = (size_t)(b * L + t0 + i);
            const u32x4 v0 = *(const u32x4*)(u + row * NUP + c), g0 = *(const u32x4*)(u + row * NUP + DFF + c);
            float val[8], gat[8];
#define TAP(e, W2, W1, W0, sel) \
            val[e] = sel(v2.W2) * wv[0][e] + sel(v1.W1) * wv[1][e] + sel(v0.W0) * wv[2][e]; gat[e] = sel(g2.W2) * wg[0][e] + sel(g1.W1) * wg[1][e] + sel(g0.W0) * wg[2][e];
            TAP(0, x, x, x, lo_f) TAP(1, x, x, x, hi_f) TAP(2, y, y, y, lo_f) TAP(3, y, y, y, hi_f)
            TAP(4, z, z, z, lo_f) TAP(5, z, z, z, hi_f) TAP(6, w, w, w, lo_f) TAP(7, w, w, w, hi_f)
#undef TAP
            u32x4 o;
            o.x = pk2(silu(gat[0]) * val[0], silu(gat[1]) * val[1]); o.y = pk2(silu(gat[2]) * val[2], silu(gat[3]) * val[3]);
            o.z = pk2(silu(gat[4]) * val[4], silu(gat[5]) * val[5]); o.w = pk2(silu(gat[6]) * val[6], silu(gat[7]) * val[7]);
            *(u32x4*)(g + row * DFF + c) = o;
            v2 = v1; g2 = g1; v1 = v0; g1 = g0;
        }
    }
}

struct CD {
    const float *z2, *gla_w2, *gla_b, *gla_norm_g, *rw_mu, *rw_w0, *rw_a0, *rw_kk, *rw_ka, *rw_rk, *rw_ln_g, *rw_ln_b;
    float *R, *KR, *VR, *G, *Y, *CDEC, *BONUS, *DECAY, *A, *KK, *O;
    bf16_t *LW, *LA, *LG, *GATE, *QDEC, *KDEC, *K2T, *VT, *W2T, *A2T, *G2T, *CST, *SPT, *P, *CAT;
};

__device__ void prep1_phase(const CD& p, LAS unsigned char* lds) {
    const int tid = threadIdx.x, wid = __builtin_amdgcn_readfirstlane(tid >> 6), lane = tid & 63;
    LAS float* tot = (LAS float*)lds;
    for (int item = blockIdx.x; item < NGI; item += gridDim.x) {
        const int bh = item / NCH, n = item - bh * NCH, b = bh >> 2, h = bh & 3;
        const int pg = wid >> 1, d = (wid & 1) * 64 + lane;
        float w2r[16];
#pragma unroll
        for (int r = 0; r < 16; ++r) w2r[r] = p.gla_w2[r * 512 + h * 128 + d];
        const float bias = p.gla_b[h * 128 + d];
        float la[16]; float run = 0.f;
#pragma unroll
        for (int i = 0; i < 16; ++i) {
            const int t = n * 64 + pg * 16 + i - 48;
            float v = 0.f;
            if (t >= 0 && t < L) {
                const float* gl = p.z2 + (size_t)(b * L + t) * NCDP + 3072;
                float xx = bias;
#pragma unroll
                for (int r = 0; r < 16; ++r) xx += gl[r] * w2r[r];
                v = logsig(xx) * (1.0f / 16.0f);
            }
            run += v; la[i] = run;
        }
        tot[pg * 128 + d] = run;
        __syncthreads();
        float off = 0.f, last = 0.f;
#pragma unroll
        for (int g4 = 0; g4 < 4; ++g4) { const float tv = tot[g4 * 128 + d]; if (g4 < pg) off += tv; last += tv; }
        unsigned k2p[8];
#pragma unroll
        for (int i = 0; i < 16; ++i) {
            const int pp = pg * 16 + i, t = n * 64 + pp - 48;
            const float cum = off + la[i];
            float q = 0.f, k = 0.f;
            if (t >= 0 && t < L) { const float* zr = p.z2 + (size_t)(b * L + t) * NCDP; q = zr[h * 128 + d] * 0.08838834764831845f; k = zr[512 + h * 128 + d]; }
            const float qd = q * expf(cum), kd = k * expf(-cum), k2 = k * expf(last - cum);
            p.QDEC[((size_t)item * 64 + pp) * 128 + d] = (bf16_t)f2bf(qd);
            p.KDEC[((size_t)item * 64 + pp) * 128 + d] = (bf16_t)f2bf(kd);
            if (i & 1) k2p[i >> 1] |= f2bf(k2) << 16; else k2p[i >> 1] = f2bf(k2);
        }
        {
            bf16_t* dst = p.K2T + ((size_t)item * 128 + d) * 64 + pg * 16;
            *(u32x4*)(dst) = (u32x4){k2p[0], k2p[1], k2p[2], k2p[3]};
            *(u32x4*)(dst + 8) = (u32x4){k2p[4], k2p[5], k2p[6], k2p[7]};
        }
        if (pg == 0) p.CDEC[item * 128 + d] = expf(last);
        {
            const int v = tid & 255, ph = tid >> 8;
            unsigned vp[16];
#pragma unroll
            for (int i = 0; i < 32; ++i) {
                const int t = n * 64 + ph * 32 + i - 48;
                float xv = 0.f;
                if (t >= 0 && t < L) xv = p.z2[(size_t)(b * L + t) * NCDP + 1024 + h * 256 + v];
                if (i & 1) vp[i >> 1] |= f2bf(xv) << 16; else vp[i >> 1] = f2bf(xv);
            }
            bf16_t* dst = p.VT + ((size_t)item * 256 + v) * 64 + ph * 32;
#pragma unroll
            for (int s = 0; s < 4; ++s) *(u32x4*)(dst + s * 8) = (u32x4){vp[s * 4 + 0], vp[s * 4 + 1], vp[s * 4 + 2], vp[s * 4 + 3]};
        }
        __syncthreads();
    }
    const int gtid = blockIdx.x * NTHREADS + tid, nth = gridDim.x * NTHREADS;
    for (int idx = gtid; idx < M * 256; idx += nth) {
        const int row = idx >> 8, c = (idx & 255) * 4;
        const f32x4 go = *(const f32x4*)(p.z2 + (size_t)row * NCDP + 2048 + c), ng = *(const f32x4*)(p.gla_norm_g + c);
        u32x2 w; w.x = pk2(silu(go[0]) * ng[0], silu(go[1]) * ng[1]); w.y = pk2(silu(go[2]) * ng[2], silu(go[3]) * ng[3]);
        *(u32x2*)(p.GATE + (size_t)row * 1024 + c) = w;
    }
    for (int idx = gtid; idx < M * 832; idx += nth) {
        const int row = idx / 832, c4 = (idx - row * 832) * 4, t = row % L;
        const f32x4 z = *(const f32x4*)(p.z2 + (size_t)row * NCDP + 3088 + c4);
        f32x4 zp = (f32x4){0.f, 0.f, 0.f, 0.f};
        if (t > 0) zp = *(const f32x4*)(p.z2 + (size_t)(row - 1) * NCDP + 3088 + c4);
        const f32x4 mu = *(const f32x4*)(p.rw_mu + c4);
        const f32x4 zr = z + (zp - z) * mu;
        if (c4 < 1024) *(f32x4*)(p.R + (size_t)row * 1024 + c4) = zr;
        else if (c4 < 2048) *(f32x4*)(p.KR + (size_t)row * 1024 + c4 - 1024) = zr;
        else if (c4 < 3072) *(f32x4*)(p.VR + (size_t)row * 1024 + c4 - 2048) = zr;
        else if (c4 < 3136) { u32x2 w; w.x = pk2(tanhf(zr[0]), tanhf(zr[1])); w.y = pk2(tanhf(zr[2]), tanhf(zr[3])); *(u32x2*)(p.LW + (size_t)row * 64 + c4 - 3072) = w; }
        else if (c4 < 3200) { u32x2 w; w.x = pk2(zr[0], zr[1]); w.y = pk2(zr[2], zr[3]); *(u32x2*)(p.LA + (size_t)row * 64 + c4 - 3136) = w; }
        else { u32x2 w; w.x = pk2(sigm(zr[0]), sigm(zr[1])); w.y = pk2(sigm(zr[2]), sigm(zr[3])); *(u32x2*)(p.LG + (size_t)row * 128 + c4 - 3200) = w; }
    }
}

__device__ void small_gemm_phase(const CD& p) {
    const int lane = threadIdx.x & 63, fr = lane & 15, fq = lane >> 4;
    const int gw = blockIdx.x * 8 + (threadIdx.x >> 6), nw = gridDim.x * 8;
    constexpr int TL = (M / 64) * 16;
    constexpr int T0 = 3 * TL, T1 = T0 + NGI, T2 = T1 + NGI * 8;
    for (int tix = gw; tix < T2; tix += nw) {
        f32x4 acc[4][4]; zero_acc(acc);
        if (tix < T0) {
            const int which = tix / TL, r = tix - which * TL, m0 = (r >> 4) * 64, n0 = (r & 15) * 64;
            if (which == 0) {
                wave_tile_mma(p.LW + (size_t)m0 * 64, 64, p.W2T + (size_t)n0 * 64, 64, 0, 64, acc, fr, fq);
#pragma unroll
                for (int mi = 0; mi < 4; ++mi)
#pragma unroll
                    for (int ni = 0; ni < 4; ++ni) {
                        const int row = m0 + mi * 16 + fr, col = n0 + ni * 16 + fq * 4;
                        const f32x4 w0 = *(const f32x4*)(p.rw_w0 + col); f32x4 o;
#pragma unroll
                        for (int e = 0; e < 4; ++e) o[e] = expf(-expf(logsig(w0[e] + acc[mi][ni][e]) - 0.5f));
                        *(f32x4*)(p.DECAY + (size_t)row * 1024 + col) = o;
                    }
            } else if (which == 1) {
                wave_tile_mma(p.LA + (size_t)m0 * 64, 64, p.A2T + (size_t)n0 * 64, 64, 0, 64, acc, fr, fq);
#pragma unroll
                for (int mi = 0; mi < 4; ++mi)
#pragma unroll
                    for (int ni = 0; ni < 4; ++ni) {
                        const int row = m0 + mi * 16 + fr, col = n0 + ni * 16 + fq * 4;
                        const f32x4 a0 = *(const f32x4*)(p.rw_a0 + col); f32x4 o;
#pragma unroll
                        for (int e = 0; e < 4; ++e) o[e] = sigm(a0[e] + acc[mi][ni][e]);
                        *(f32x4*)(p.A + (size_t)row * 1024 + col) = o;
                    }
            } else {
                wave_tile_mma(p.LG + (size_t)m0 * 128, 128, p.G2T + (size_t)n0 * 128, 128, 0, 128, acc, fr, fq);
#pragma unroll
                for (int mi = 0; mi < 4; ++mi)
#pragma unroll
                    for (int ni = 0; ni < 4; ++ni) {
                        const int row = m0 + mi * 16 + fr, col = n0 + ni * 16 + fq * 4;
                        *(f32x4*)(p.G + (size_t)row * 1024 + col) = acc[mi][ni];
                    }
            }
        } else if (tix < T1) {
            const int item = tix - T0;
            wave_tile_mma(p.QDEC + (size_t)item * 8192, 128, p.KDEC + (size_t)item * 8192, 128, 0, 128, acc, fr, fq);
#pragma unroll
            for (int mi = 0; mi < 4; ++mi)
#pragma unroll
                for (int ni = 0; ni < 4; ++ni) {
                    const int pp = mi * 16 + fr, s0 = ni * 16 + fq * 4;
                    f32x4 v = acc[mi][ni];
#pragma unroll
                    for (int e = 0; e < 4; ++e) if (s0 + e > pp) v[e] = 0.f;
                    u32x2 w; w.x = pk2(v[0], v[1]); w.y = pk2(v[2], v[3]);
                    *(u32x2*)(p.P + (size_t)item * 4096 + pp * 64 + s0) = w;
                }
        } else {
            const int r = tix - T1, item = r >> 3, vt = (r >> 1) & 3, dt = r & 1;
            wave_tile_mma(p.VT + ((size_t)item * 256 + vt * 64) * 64, 64, p.K2T + ((size_t)item * 128 + dt * 64) * 64, 64, 0, 64, acc, fr, fq);
#pragma unroll
            for (int mi = 0; mi < 4; ++mi)
#pragma unroll
                for (int ni = 0; ni < 4; ++ni) {
                    const int v = vt * 64 + mi * 16 + fr, d0 = dt * 64 + ni * 16 + fq * 4;
                    u32x2 w; w.x = pk2(acc[mi][ni][0], acc[mi][ni][1]); w.y = pk2(acc[mi][ni][2], acc[mi][ni][3]);
                    *(u32x2*)(p.CST + ((size_t)item * 256 + v) * 128 + d0) = w;
                }
        }
    }
}

__device__ void prep2_phase(const CD& p) {
    const int lane = threadIdx.x & 63;
    const int gw = blockIdx.x * 8 + (threadIdx.x >> 6), nw = gridDim.x * 8;
    for (int it = gw; it < M * 4; it += nw) {
        const int row = it >> 2, h = (it & 3) * 4 + (lane >> 4), c = h * 64 + (lane & 15) * 4;
        const size_t o = (size_t)row * 1024 + c;
        const f32x4 kr = *(const f32x4*)(p.KR + o), a = *(const f32x4*)(p.A + o), r = *(const f32x4*)(p.R + o);
        f32x4 kk = kr * *(const f32x4*)(p.rw_kk + c);
        const float ss = sum16(kk[0] * kk[0] + kk[1] * kk[1] + kk[2] * kk[2] + kk[3] * kk[3]);
        kk = kk * (1.0f / fmaxf(sqrtf(ss), 1e-12f));
        const f32x4 k = kr * (1.0f + (a - 1.0f) * *(const f32x4*)(p.rw_ka + c));
        const f32x4 rk = r * k * *(const f32x4*)(p.rw_rk + c);
        const float bs = sum16((rk[0] + rk[1]) + (rk[2] + rk[3]));
        *(f32x4*)(p.KK + o) = kk; *(f32x4*)(p.A + o) = kk * a; *(f32x4*)(p.KR + o) = k;
        if ((lane & 15) == 0) p.BONUS[row * 16 + h] = bs;
    }
    const int gtid = blockIdx.x * NTHREADS + threadIdx.x, nth = gridDim.x * NTHREADS;
    for (int e = gtid; e < 16 * 256 * 32; e += nth) {
        const int d4 = (e & 31) * 4, v = (e >> 5) & 255, bh = e >> 13;
        f32x4 S = (f32x4){0.f, 0.f, 0.f, 0.f};
#pragma unroll 3
        for (int n = 0; n < NCH; ++n) {
            const int item = bh * NCH + n;
            const size_t o = ((size_t)item * 256 + v) * 128 + d4;
            u32x2 w; w.x = pk2(S[0], S[1]); w.y = pk2(S[2], S[3]);
            *(u32x2*)(p.SPT + o) = w;
            const f32x4 dec = *(const f32x4*)(p.CDEC + item * 128 + d4);
            const u32x2 cs = *(const u32x2*)(p.CST + o);
            S = S * dec + (f32x4){lo_f(cs.x), hi_f(cs.x), lo_f(cs.y), hi_f(cs.y)};
        }
    }
}

__device__ void gla_out_phase(const CD& p) {
    const int lane = threadIdx.x & 63, fr = lane & 15, fq = lane >> 4;
    const int gw = blockIdx.x * 8 + (threadIdx.x >> 6), nw = gridDim.x * 8;
    for (int tix = gw; tix < NGI * 4; tix += nw) {
        const int item = tix >> 2, vt = tix & 3, bh = item / NCH, n = item - bh * NCH, b = bh >> 2, h = bh & 3;
        f32x4 acc[4][4]; zero_acc(acc);
        wave_tile_mma(p.P + (size_t)item * 4096, 64, p.VT + ((size_t)item * 256 + vt * 64) * 64, 64, 0, 64, acc, fr, fq);
        wave_tile_mma(p.QDEC + (size_t)item * 8192, 128, p.SPT + ((size_t)item * 256 + vt * 64) * 128, 128, 0, 128, acc, fr, fq);
#pragma unroll
        for (int mi = 0; mi < 4; ++mi) {
            const int t = n * 64 + mi * 16 + fr - 48;
            if (t >= 0 && t < L) {
#pragma unroll
                for (int ni = 0; ni < 4; ++ni) *(f32x4*)(p.O + (size_t)(b * L + t) * 1024 + h * 256 + vt * 64 + ni * 16 + fq * 4) = acc[mi][ni];
            }
        }
    }
}

__device__ __forceinline__ float oct_sum(float x) {
    x += __int_as_float(__builtin_amdgcn_update_dpp(0, __float_as_int(x), 0xB1, 0xF, 0xF, false));
    x += __int_as_float(__builtin_amdgcn_update_dpp(0, __float_as_int(x), 0x4E, 0xF, 0xF, false));
    x += __int_as_float(__builtin_amdgcn_update_dpp(0, __float_as_int(x), 0x141, 0xF, 0xF, false));
    return x;
}
struct StepOps { f32x4 r[2], w[2], k[2], kk[2], b[2]; float v; };
__device__ __forceinline__ void ld_ops(StepOps& o, const LAS float* bp, int s, int j, int vidx) {
    const LAS float* sp = bp + s * 64 + j * 8;
    o.r[0] = *(const LAS f32x4*)(sp); o.r[1] = *(const LAS f32x4*)(sp + 4);
    o.w[0] = *(const LAS f32x4*)(sp + 2048); o.w[1] = *(const LAS f32x4*)(sp + 2048 + 4);
    o.k[0] = *(const LAS f32x4*)(sp + 4096); o.k[1] = *(const LAS f32x4*)(sp + 4096 + 4);
    o.kk[0] = *(const LAS f32x4*)(sp + 6144); o.kk[1] = *(const LAS f32x4*)(sp + 6144 + 4);
    o.b[0] = *(const LAS f32x4*)(sp + 8192); o.b[1] = *(const LAS f32x4*)(sp + 8192 + 4);
    o.v = bp[10240 + s * 64 + vidx];
}
__device__ __forceinline__ float scan_step(f32x2 (&S)[4], const StepOps& o) {
    f32x2 sa2 = S[0] * o.kk[0].lo + S[1] * o.kk[0].hi;
    sa2 += S[2] * o.kk[1].lo + S[3] * o.kk[1].hi;
    const f32x2 vv = (f32x2){o.v, o.v};
    const f32x2 t0 = vv * o.k[0].lo, t1 = vv * o.k[0].hi, t2 = vv * o.k[1].lo, t3 = vv * o.k[1].hi;
    const float sa = -oct_sum(sa2[0] + sa2[1]);
    const f32x2 sv = (f32x2){sa, sa};
    S[0] = S[0] * o.w[0].lo + (sv * o.b[0].lo + t0);
    S[1] = S[1] * o.w[0].hi + (sv * o.b[0].hi + t1);
    S[2] = S[2] * o.w[1].lo + (sv * o.b[1].lo + t2);
    S[3] = S[3] * o.w[1].hi + (sv * o.b[1].hi + t3);
    f32x2 y2 = S[0] * o.r[0].lo + S[1] * o.r[0].hi;
    y2 += S[2] * o.r[1].lo + S[3] * o.r[1].hi;
    return oct_sum(y2[0] + y2[1]);
}
__device__ void rwkv_scan_phase(const CD& p, LAS unsigned char* lds) {
    const int tid = threadIdx.x, wid = __builtin_amdgcn_readfirstlane(tid >> 6), lane = tid & 63;
    LAS float* buf = (LAS float*)lds;
    constexpr int NCHUNK = (L + 31) / 32;
    for (int item = blockIdx.x; item < 256; item += gridDim.x) {
        const int bh = item >> 2, q = item & 3, b = bh >> 4, h = bh & 15;
        const int rr = tid >> 4, c4 = (tid & 15) * 4;
        const size_t gbase = (size_t)(b * L) * 1024 + h * 64 + c4;
        f32x4 st0, st1, st2, st3, st4, st5;
#define SCAN_LOADS(tn) do { const size_t _o = gbase + (size_t)(tn) * 1024; \
        st0 = *(const f32x4*)(p.R + _o); st1 = *(const f32x4*)(p.DECAY + _o); st2 = *(const f32x4*)(p.KR + _o); \
        st3 = *(const f32x4*)(p.KK + _o); st4 = *(const f32x4*)(p.A + _o); st5 = *(const f32x4*)(p.VR + _o); } while (0)
#define SCAN_STORES(bb) do { LAS float* _d = buf + (bb) * 12288 + rr * 64 + c4; \
        *(LAS f32x4*)(_d) = st0; *(LAS f32x4*)(_d + 2048) = st1; *(LAS f32x4*)(_d + 4096) = st2; \
        *(LAS f32x4*)(_d + 6144) = st3; *(LAS f32x4*)(_d + 8192) = st4; *(LAS f32x4*)(_d + 10240) = st5; } while (0)
        SCAN_LOADS(rr);
        SCAN_STORES(0);
        __syncthreads();
        f32x2 S[4];
#pragma unroll
        for (int i = 0; i < 4; ++i) S[i] = (f32x2){0.f, 0.f};
        const int srow = lane >> 3, j = lane & 7, vidx = q * 16 + wid * 8 + srow;
        int cb = 0;
        for (int c = 0; c < NCHUNK; ++c) {
            const int t0 = c * 32;
            const bool more = (c + 1 < NCHUNK);
            if (more) {
                const int tn = t0 + 32 + rr;
                if (tn < L) SCAN_LOADS(tn);
                else { st0 = (f32x4){0.f, 0.f, 0.f, 0.f}; st1 = st0; st2 = st0; st3 = st0; st4 = st0; st5 = st0; }
            }
            if (wid < 2) {
                const LAS float* bp = buf + cb * 12288;
                const int ns = (L - t0) < 32 ? (L - t0) : 32;
                float* yp = p.Y + (size_t)(b * L + t0) * 1024 + h * 64 + vidx;
                StepOps A, B;
                ld_ops(A, bp, 0, j, vidx);
                for (int s = 0; s < ns; s += 2) {
                    ld_ops(B, bp, s + 1, j, vidx);
                    const float ya = scan_step(S, A);
                    if (j == 0) yp[(size_t)s * 1024] = ya;
                    if (s + 2 < ns) ld_ops(A, bp, s + 2, j, vidx);
                    const float yb = scan_step(S, B);
                    if (j == 0) yp[(size_t)(s + 1) * 1024] = yb;
                }
            }
            if (more) SCAN_STORES(cb ^ 1);
            __syncthreads();
            cb ^= 1;
        }
#undef SCAN_LOADS
#undef SCAN_STORES
    }
}

__device__ void post_phase(const CD& p) {
    const int lane = threadIdx.x & 63;
    const int gw = blockIdx.x * 8 + (threadIdx.x >> 6), nw = gridDim.x * 8;
    for (int it = gw; it < M * 4; it += nw) {
        const int row = it >> 2, h = it & 3;
        const size_t o = (size_t)row * 1024 + h * 256 + lane * 4;
        const f32x4 v = *(const f32x4*)(p.O + o);
        const float ss = wave_sum(v[0] * v[0] + v[1] * v[1] + v[2] * v[2] + v[3] * v[3]);
        const float rs = rsqrtf(ss * (1.0f / 256.0f) + 1e-6f);
        const u32x2 gt = *(const u32x2*)(p.GATE + o);
        u32x2 w; w.x = pk2(v[0] * rs * lo_f(gt.x), v[1] * rs * hi_f(gt.x)); w.y = pk2(v[2] * rs * lo_f(gt.y), v[3] * rs * hi_f(gt.y));
        *(u32x2*)(p.CAT + (size_t)row * D + h * 256 + lane * 4) = w;
    }
    for (int it = gw; it < M * 4; it += nw) {
        const int row = it >> 2, h = (it & 3) * 4 + (lane >> 4), c = h * 64 + (lane & 15) * 4;
        const size_t o = (size_t)row * 1024 + c;
        const f32x4 y = *(const f32x4*)(p.Y + o);
        const float mu = sum16((y[0] + y[1]) + (y[2] + y[3])) * (1.0f / 64.0f);
        const f32x4 dv = y - mu;
        const float var = sum16(dv[0] * dv[0] + dv[1] * dv[1] + dv[2] * dv[2] + dv[3] * dv[3]) * (1.0f / 64.0f);
        const float rstd = rsqrtf(var + 64e-5f);
        const f32x4 yn = dv * rstd * *(const f32x4*)(p.rw_ln_g + c) + *(const f32x4*)(p.rw_ln_b + c);
        const float bonus = p.BONUS[row * 16 + h];
        const f32x4 res = (yn + bonus * *(const f32x4*)(p.VR + o)) * *(const f32x4*)(p.G + o);
        u32x2 w; w.x = pk2(res[0], res[1]); w.y = pk2(res[2], res[3]);
        *(u32x2*)(p.CAT + (size_t)row * D + 1024 + c) = w;
    }
}

struct Params { const float* in[31]; float* out; unsigned char* ws; };

__global__ void __launch_bounds__(NTHREADS, 2) fwd_megakernel(Params prm) {
    extern __shared__ __attribute__((aligned(16))) unsigned char lds_raw[];
    LAS unsigned char* lds = (LAS unsigned char*)lds_raw;
    cg::grid_group grid = cg::this_grid();
    size_t zoff = 0;
    unsigned char* ws = prm.ws;
    {
        unsigned* bw = (unsigned*)(ws + XO_BAR);
        if (blockIdx.x == 0) {
            for (int i = threadIdx.x; i < BAR_WORDS; i += NTHREADS) bw[i] = 0u;
            float* ss = (float*)(ws + XO_SS);
            for (int i = threadIdx.x; i < 3 * M; i += NTHREADS) ss[i] = 0.f;
        }
        if (threadIdx.x < 4) ((LAS unsigned*)(lds + 131072))[threadIdx.x] = 0u;
        __syncthreads();
    }
    XcdBarrier xbar; xbar.bar = (unsigned*)(ws + XO_BAR); xbar.x = 0; xbar.st = (volatile LAS unsigned*)(lds + 131072);
#define SYNC() do { xcd_barrier(xbar); asm volatile("" : "+s"(zoff) :: "memory"); ws = prm.ws + zoff; } while (0)
#define SYNC0() do { grid.sync(); xbar = xcd_barrier_post((unsigned*)(ws + XO_BAR), (volatile LAS unsigned*)(lds + 131072)); asm volatile("" : "+s"(zoff) :: "memory"); ws = prm.ws + zoff; } while (0)
#define WSF(off) ((float*)(ws + (off)))
#define WSB(off) ((bf16_t*)(ws + (off)))
#define CTR(j) ((unsigned*)(ws + XO_BAR) + 3456 + (j))
#define SSQ(j) (WSF(XO_SS) + (j) * M)
#define MKCD(p) CD p; \
        p.z2 = WSF(OFF_Z); p.gla_w2 = prm.in[10]; p.gla_b = prm.in[11]; p.gla_norm_g = prm.in[12]; p.rw_mu = prm.in[13]; p.rw_w0 = prm.in[14]; p.rw_a0 = prm.in[16]; \
        p.rw_kk = prm.in[19]; p.rw_ka = prm.in[20]; p.rw_rk = prm.in[21]; p.rw_ln_g = prm.in[22]; p.rw_ln_b = prm.in[23]; \
        p.R = WSF(XO_R); p.KR = WSF(XO_KR); p.VR = WSF(XO_VR); p.G = WSF(XO_G); p.Y = WSF(XO_Y); \
        p.CDEC = WSF(XO_CDEC); p.BONUS = WSF(XO_BONUS); p.DECAY = WSF(ZO_DECAY); p.A = WSF(ZO_A); p.KK = WSF(ZO_KK); p.O = WSF(ZO_O); \
        p.LW = WSB(XO_LW); p.LA = WSB(XO_LA); p.LG = WSB(XO_LG); p.GATE = WSB(XO_GATE); \
        p.QDEC = WSB(XO_QDEC); p.KDEC = WSB(XO_KDEC); p.K2T = WSB(XO_K2T); p.VT = WSB(XO_VT); \
        p.W2T = WSB(XO_W2T); p.A2T = WSB(XO_A2T); p.G2T = WSB(XO_G2T); \
        p.CST = WSB(ZO_CST); p.SPT = WSB(ZO_SPT); p.P = WSB(ZO_P); p.CAT = WSB(OFF_ACT);

    rms_phase<1>(nullptr, WSF(OFF_H), prm.in[0], prm.in[1], prm.in[25], WSB(OFF_HN), nullptr);
    convert_wt(prm.in[2], WSB(XO_WB), D, NAB, NAB, nullptr, lds);
    convert_wt(prm.in[15], WSB(XO_W2T), 64, 1024, 1024, nullptr, lds);
    convert_wt(prm.in[17], WSB(XO_A2T), 64, 1024, 1024, nullptr, lds);
    convert_wt(prm.in[18], WSB(XO_G2T), 128, 1024, 1024, nullptr, lds);
    SYNC0();
    gemm_full(lds, WSB(OFF_HN), WSB(XO_WB), NAB, D, EpStoreBf16{WSB(OFF_Z), NAB});
    convert_steal(prm.in[8], WSB(XO_WC), D, D, D, nullptr, CTR(0), lds);
    convert_steal(prm.in[27], WSB(OFF_W), D, NUP, NUP, prm.in[26], CTR(1), lds);
    SYNC();
    mixer_ab_phase(WSB(OFF_Z), prm.in[3], prm.in[4], prm.in[5], prm.in[6], prm.in[7], WSB(OFF_ACT), lds);
    SYNC();
    gemm_full(lds, WSB(OFF_ACT), WSB(XO_WC), D, D, EpResid{WSF(OFF_H), WSB(OFF_HN), SSQ(0)});
    SYNC();
    gemm_full(lds, WSB(OFF_HN), WSB(OFF_W), NUP, D, EpScaleStoreBf16{WSB(OFF_Z), NUP, SSQ(0)});
    convert_steal(prm.in[29], WSB(XO_WC), DFF, D, D, nullptr, CTR(2), lds);
    convert_steal(prm.in[9], WSB(XO_WB), D, NCD, NCDP, prm.in[25] + D, CTR(3), lds);
    SYNC();
    ffn_gate_phase(WSB(OFF_Z), prm.in[28], WSB(OFF_ACT));
    SYNC();
    gemm_full(lds, WSB(OFF_ACT), WSB(XO_WC), D, DFF, EpResid{WSF(OFF_H), WSB(OFF_HN), SSQ(1)});
    SYNC();
    gemm_full(lds, WSB(OFF_HN), WSB(XO_WB), NCDP, D, EpScaleStoreF32{WSF(OFF_Z), NCDP, SSQ(1)});
    convert_steal(prm.in[24], WSB(XO_WC), D, D, D, nullptr, CTR(4), lds);
    convert_steal(prm.in[27] + (size_t)D * NUP, WSB(OFF_W), D, NUP, NUP, prm.in[26] + D, CTR(5), lds);
    SYNC();
    { MKCD(p) prep1_phase(p, lds); }
    SYNC();
    { MKCD(p) small_gemm_phase(p); }
    SYNC();
    { MKCD(p) prep2_phase(p); }
    SYNC();
    { MKCD(p) gla_out_phase(p); }
    { MKCD(p) rwkv_scan_phase(p, lds); }
    SYNC();
    { MKCD(p) post_phase(p); }
    SYNC();
    gemm_full(lds, WSB(OFF_ACT), WSB(XO_WC), D, D, EpResid{WSF(OFF_H), WSB(OFF_HN), SSQ(2)});
    SYNC();
    gemm_full(lds, WSB(OFF_HN), WSB(OFF_W), NUP, D, EpScaleStoreBf16{WSB(OFF_Z), NUP, SSQ(2)});
    convert_steal(prm.in[29] + (size_t)DFF * D, WSB(XO_WC), DFF, D, D, nullptr, CTR(6), lds);
    SYNC();
    ffn_gate_phase(WSB(OFF_Z), prm.in[28] + (size_t)3 * NUP, WSB(OFF_ACT));
    SYNC();
    gemm_full(lds, WSB(OFF_ACT), WSB(XO_WC), D, DFF, EpAddF32{WSF(OFF_H), D});
    SYNC();
    rms_phase<2>(WSF(OFF_H), nullptr, nullptr, nullptr, prm.in[30], nullptr, prm.out);
}

extern "C" void kernel_launch(void* const* d_in, const int* in_sizes, int n_in, void* d_out, int out_size, void* d_ws, size_t ws_size, hipStream_t stream) {
    static int grid_blocks = 0;
    if (!grid_blocks) {
        if (n_in != 31 || ws_size < WS_END) { fprintf(stderr, "kernel_launch: expected 31 inputs and >= %zu bytes of workspace (got %d, %zu)\n", (size_t)WS_END, n_in, ws_size); grid_blocks = -1; return; }
        int dev = 0, cus = 0, per_cu = 0;
        hipGetDevice(&dev);
        hipDeviceGetAttribute(&cus, hipDeviceAttributeMultiprocessorCount, dev);
        hipFuncSetAttribute((const void*)fwd_megakernel, hipFuncAttributeMaxDynamicSharedMemorySize, LDS_BYTES);
        hipOccupancyMaxActiveBlocksPerMultiprocessor(&per_cu, (const void*)fwd_megakernel, NTHREADS, LDS_BYTES);
        if (per_cu < 1) per_cu = 1;
        if (per_cu > 1) per_cu = 1;
        (void)hipGetLastError();
        grid_blocks = cus * per_cu;
    }
    if (grid_blocks < 0) return;
    Params p{};
    for (int i = 0; i < 31; ++i) p.in[i] = (const float*)d_in[i];
    p.out = (float*)d_out; p.ws = (unsigned char*)d_ws;
    void* args[] = {&p};
    hipError_t e = hipLaunchCooperativeKernel((const void*)fwd_megakernel, dim3(grid_blocks), dim3(NTHREADS), args, LDS_BYTES, stream);
    if (e != hipSuccess) fprintf(stderr, "cooperative launch failed: %s (grid %d)\n", hipGetErrorString(e), grid_blocks);
}
```

```cpp
#include <hip/hip_runtime.h>
#include <hip/hip_cooperative_groups.h>
#include <cstdio>
namespace cg = cooperative_groups;

#define LAS __attribute__((address_space(3)))
typedef unsigned short bf16_t;
typedef short bf16x8 __attribute__((ext_vector_type(8)));
typedef float f32x4 __attribute__((ext_vector_type(4)));
typedef float f32x2 __attribute__((ext_vector_type(2)));
typedef unsigned u32x4 __attribute__((ext_vector_type(4)));
typedef unsigned u32x2 __attribute__((ext_vector_type(2)));

constexpr int D = 2048, L = 2064, NBATCH = 4, SEQ = 2048, NMETA = 16, M = NBATCH * L  , MBIG = 8192;
constexpr int DFF = 5632, NUP = 2 * DFF, NAB = 5120, NCD = 6416, NCDP = 6656;
constexpr int NCH = 33;
constexpr int NGI = NBATCH * 4 * NCH;
constexpr int LDS_BYTES = 131072 + 16;
constexpr int NTHREADS = 512;

constexpr size_t al256(size_t x) { return (x + 255) & ~(size_t)255; }
constexpr size_t OFF_H = 0;
constexpr size_t OFF_W = OFF_H + al256((size_t)M * D * 4);
constexpr size_t OFF_HN = OFF_W + al256((size_t)NUP * D * 2);
constexpr size_t OFF_Z = OFF_HN + al256((size_t)M * D * 2);
constexpr size_t OFF_ACT = OFF_Z + al256((size_t)M * NCDP * 4);
constexpr size_t OFF_X = OFF_ACT + al256((size_t)M * DFF * 2);
constexpr size_t SZ_M1024F = al256((size_t)M * 1024 * 4);
constexpr size_t XO_R = OFF_X;
constexpr size_t XO_KR = XO_R + SZ_M1024F;
constexpr size_t XO_VR = XO_KR + SZ_M1024F;
constexpr size_t XO_G = XO_VR + SZ_M1024F;
constexpr size_t XO_Y = OFF_HN;
constexpr size_t XO_LW = XO_G + SZ_M1024F;
constexpr size_t XO_LA = XO_LW + al256((size_t)M * 64 * 2);
constexpr size_t XO_LG = XO_LA + al256((size_t)M * 64 * 2);
constexpr size_t XO_GATE = XO_LG + al256((size_t)M * 128 * 2);
constexpr size_t XO_QDEC = XO_GATE + al256((size_t)M * 1024 * 2);
constexpr size_t XO_KDEC = XO_QDEC + al256((size_t)NGI * 64 * 128 * 2);
constexpr size_t XO_K2T = XO_KDEC + al256((size_t)NGI * 64 * 128 * 2);
constexpr size_t XO_VT = XO_K2T + al256((size_t)NGI * 64 * 128 * 2);
constexpr size_t XO_CDEC = XO_VT + al256((size_t)NGI * 256 * 64 * 2);
constexpr size_t XO_BONUS = XO_CDEC + al256((size_t)NGI * 128 * 4);
constexpr size_t XO_W2T = XO_BONUS + al256((size_t)M * 16 * 4);
constexpr size_t XO_A2T = XO_W2T + al256((size_t)1024 * 64 * 2);
constexpr size_t XO_G2T = XO_A2T + al256((size_t)1024 * 64 * 2);
constexpr size_t XO_BAR = XO_G2T + al256((size_t)1024 * 128 * 2);
constexpr int BAR_WORDS = 3456 + 64;
constexpr size_t XO_SS = XO_BAR + al256((size_t)BAR_WORDS * 4);
constexpr size_t XO_WB = XO_SS + al256((size_t)3 * M * 4);
constexpr size_t XO_WC = XO_WB + al256((size_t)NCDP * D * 2);
constexpr size_t WS_END = XO_WC + al256((size_t)D * DFF * 2);
constexpr size_t ZO_DECAY = OFF_Z;
constexpr size_t ZO_A = ZO_DECAY + SZ_M1024F;
constexpr size_t ZO_KK = ZO_A + SZ_M1024F;
constexpr size_t ZO_O = ZO_KK + SZ_M1024F;
constexpr size_t ZO_CST = ZO_O + SZ_M1024F;
constexpr size_t ZO_SPT = ZO_CST + al256((size_t)NGI * 256 * 128 * 2);
constexpr size_t ZO_P = ZO_SPT + al256((size_t)NGI * 256 * 128 * 2);
constexpr size_t ZO_END = ZO_P + al256((size_t)NGI * 64 * 64 * 2);
static_assert(ZO_END <= OFF_ACT, "Z sub-regions overflow");
static_assert(SZ_M1024F <= (size_t)M * D * 2 + 256, "Y must fit in HN");

__device__ __forceinline__ float bf2f(unsigned b) { return __uint_as_float(b << 16); }
__device__ __forceinline__ unsigned f2bf(float f) { unsigned u = __float_as_uint(f); u += 0x7FFFu + ((u >> 16) & 1u); return u >> 16; }
__device__ __forceinline__ unsigned pk2(float lo, float hi) { return f2bf(lo) | (f2bf(hi) << 16); }
__device__ __forceinline__ float lo_f(unsigned w) { return __uint_as_float(w << 16); }
__device__ __forceinline__ float hi_f(unsigned w) { return __uint_as_float(w & 0xffff0000u); }
__device__ __forceinline__ float sigm(float x) { return 1.0f / (1.0f + expf(-x)); }
__device__ __forceinline__ float silu(float x) { return x * sigm(x); }
__device__ __forceinline__ float logsig(float x) { return fminf(x, 0.f) - log1pf(expf(-fabsf(x))); }
__device__ __forceinline__ float wave_sum(float v) {
#pragma unroll
    for (int o = 32; o >= 1; o >>= 1) v += __shfl_xor(v, o);
    return v;
}
__device__ __forceinline__ float sum16(float v) {
#pragma unroll
    for (int o = 8; o >= 1; o >>= 1) v += __shfl_xor(v, o);
    return v;
}
__device__ __forceinline__ float quad_sum(float x) {
    x += __int_as_float(__builtin_amdgcn_update_dpp(0, __float_as_int(x), 0xB1, 0xF, 0xF, false));
    x += __int_as_float(__builtin_amdgcn_update_dpp(0, __float_as_int(x), 0x4E, 0xF, 0xF, false));
    return x;
}


#define XB_TMO      128
#define XB_XCNT(j)  (256  + 64 * (j))
#define XB_XSUB(j)  (1280 + 64 * (j))
#define XB_XGEN(j)  (2304 + 64 * (j))
#define XB_TOP      3328
#define XB_TOPGEN   3392
#define XCD_BAR_WORDS 3456
#define XB_SPIN_CAP (1u << 20)
__device__ __forceinline__ unsigned xb_ld(unsigned* p)              { return __hip_atomic_load(p, __ATOMIC_RELAXED, __HIP_MEMORY_SCOPE_AGENT); }
__device__ __forceinline__ unsigned xb_add(unsigned* p, unsigned v) { return __hip_atomic_fetch_add(p, v, __ATOMIC_RELAXED, __HIP_MEMORY_SCOPE_AGENT); }
__device__ __forceinline__ unsigned xb_xcc_id() { return (unsigned)__builtin_amdgcn_s_getreg((3 << 11) | 20) & 0xFu; }
#define XB_SPIN(cond, bar) do { unsigned _sp = 0; while (cond) { __builtin_amdgcn_s_sleep(1); \
    if ((++_sp & 255u) == 0u) { if (xb_ld(&(bar)[XB_TMO])) break; if (_sp > XB_SPIN_CAP) { atomicAdd(&(bar)[XB_TMO], 1u); break; } } } } while (0)
struct XcdBarrier { unsigned* bar; unsigned x; volatile LAS unsigned* st; };
__device__ __forceinline__ XcdBarrier xcd_barrier_post(unsigned* bar, volatile LAS unsigned* st) {
    XcdBarrier b; b.bar = bar; b.x = xb_xcc_id(); b.st = st;
    if (threadIdx.x == 0) (void)xb_add(&bar[XB_XCNT(b.x)], 1u);
    return b;
}
__device__ __forceinline__ void xcd_barrier_complete(unsigned* bar, unsigned x, unsigned& nloc, unsigned& nx) {
    const unsigned G = gridDim.x * gridDim.y * gridDim.z;
    unsigned sum, cnt, mine, sp = 0u;
    for (;;) {
        sum = 0u; cnt = 0u; mine = 0u;
#pragma unroll
        for (unsigned j = 0; j < 16; ++j) { const unsigned c = xb_ld(&bar[XB_XCNT(j)]); sum += c; cnt += (c > 0u) ? 1u : 0u; mine = (j == x) ? c : mine; }
        if (sum == G) break;
        __builtin_amdgcn_s_sleep(1);
        if ((++sp & 255u) == 0u) { if (xb_ld(&bar[XB_TMO])) break; if (sp > XB_SPIN_CAP) { atomicAdd(&bar[XB_TMO], 1u); break; } }
    }
    nloc = mine > 0u ? mine : 1u; nx = cnt > 0u ? cnt : 1u;
}
__device__ __forceinline__ void xcd_barrier(const XcdBarrier& b) {
    asm volatile("s_waitcnt vmcnt(0)" ::: "memory");
    __syncthreads();
    if (threadIdx.x == 0) {
        unsigned* bar = b.bar;
        __builtin_amdgcn_s_waitcnt(0);
        unsigned nloc = b.st[0], nx = b.st[1];
        if (nloc == 0u) { xcd_barrier_complete(bar, b.x, nloc, nx); b.st[0] = nloc; b.st[1] = nx; }
        const unsigned old = xb_add(&bar[XB_XSUB(b.x)], 1u);
        const unsigned gen = old / nloc;
        if (old + 1u == (gen + 1u) * nloc) {
            __builtin_amdgcn_fence(__ATOMIC_RELEASE, "agent");
            asm volatile("s_waitcnt vmcnt(0)" ::: "memory");
            const unsigned og = xb_add(&bar[XB_TOP], 1u);
            const unsigned tg = og / nx;
            if (og + 1u == (tg + 1u) * nx) xb_add(&bar[XB_TOPGEN], 1u);
            else XB_SPIN(xb_ld(&bar[XB_TOPGEN]) == tg, bar);
            __builtin_amdgcn_fence(__ATOMIC_ACQUIRE, "agent");
            xb_add(&bar[XB_XGEN(b.x)], 1u);
            asm volatile("s_waitcnt vmcnt(0)" ::: "memory");
        } else {
            XB_SPIN(xb_ld(&bar[XB_XGEN(b.x)]) == gen, bar);
            __builtin_amdgcn_fence(__ATOMIC_ACQUIRE, "agent");
            asm volatile("s_waitcnt vmcnt(0)" ::: "memory");
        }
    }
    __syncthreads();
}

namespace pg8 {
constexpr int BM = 256, BK = 64, HALF = 128, HTB = HALF * BK * 2, NXCD = 8, WGM = 8;
__device__ __forceinline__ int lds_byte(int r, int c) { const int st = (r >> 4) * 2 + (c >> 5), rr = r & 15, cc = c & 31, ob = rr * 64 + cc * 2; return st * 1024 + (ob ^ (((ob >> 9) & 1) << 5)); }
__device__ __forceinline__ void stage_rc(int b, int& R, int& C) { const int st = b / 1024, sb = b % 1024, swz = sb ^ (((sb >> 9) & 1) << 5); R = (st >> 1) * 16 + swz / 64; C = (st & 1) * 32 + (swz % 64) / 2; }
struct Unit { int pm, pn; };
struct StaticOrder {
    int nM, nN, nwg, G, c;
    __device__ void init(int Mr, int N, int G_, int c_) { nM = Mr / BM; nN = N / BM; nwg = nM * nN; G = G_; c = c_; }
    __device__ bool next(int i, Unit& u) const {
        const long Lx = (long)i * G + c; if (Lx >= nwg) return false;
        int wgid = (int)Lx; { const int q = nwg / NXCD, r = nwg % NXCD, xcd = wgid % NXCD, off = wgid / NXCD; wgid = (xcd < r ? xcd * (q + 1) : r * (q + 1) + (xcd - r) * q) + off; }
        const int nig = WGM * nN, gid = wgid / nig, fm = gid * WGM, gsz = (nM - fm) < WGM ? (nM - fm) : WGM;
        u.pm = fm + ((wgid % nig) % gsz); u.pn = (wgid % nig) / gsz; return true;
    }
};
template <class F>
__device__ __forceinline__ void gemm_phase(LAS unsigned char* lds, const bf16_t* gA, const bf16_t* gBt, const int K, const StaticOrder& S, const F& f) {
    int tid = threadIdx.x; asm volatile("" : "+v"(tid));
    const int wid = __builtin_amdgcn_readfirstlane(tid >> 6), lane = tid & 63, wr = wid >> 2, wc = wid & 3, fr = lane & 15, fq = lane >> 4;
    const int nt = K / BK;
    unsigned voffA[2];
#pragma unroll
    for (int i = 0; i < 2; ++i) { int R, C; stage_rc(tid * 16 + i * 8192, R, C); voffA[i] = (unsigned)(R * K + C) * 2u; }
    const size_t kstep = (size_t)(BK * 2);
    const size_t hstep = (size_t)HALF * K * 2;
    const size_t tstep = 2 * hstep;
    const unsigned ldsw = (unsigned)wid * 1024u;
    const int aoff = lds_byte(wr * 64 + fr, fq * 8), boff = lds_byte(wc * 32 + fr, fq * 8);
#define PG8_SA(b, h) (((b) * 2 + (h)) * HTB)
#define PG8_SB(b, h) ((4 + (b) * 2 + (h)) * HTB)
#define PG8_STAGE(bufoff, gbase, voff) do { _Pragma("unroll") for (int _i = 0; _i < 2; ++_i) \
        __builtin_amdgcn_global_load_lds((const unsigned*)((const char*)(gbase) + (voff)[_i]), (LAS unsigned*)(lds + (bufoff) + ldsw + _i * 8192), 16, 0, 0); } while (0)
#define PG8_LDA(dst, b, h) do { _Pragma("unroll") for (int m = 0; m < 4; ++m) _Pragma("unroll") for (int k = 0; k < 2; ++k) dst[m][k] = *(const LAS bf16x8*)(lds + PG8_SA(b, h) + aoff + m * 2048 + k * 1024); } while (0)
#define PG8_LDB(dst, b, h) do { _Pragma("unroll") for (int n = 0; n < 2; ++n) _Pragma("unroll") for (int k = 0; k < 2; ++k) dst[n][k] = *(const LAS bf16x8*)(lds + PG8_SB(b, h) + boff + n * 2048 + k * 1024); } while (0)
#define PG8_MMA(ai, bj, At, Bt) do { __builtin_amdgcn_s_setprio(1); _Pragma("unroll") for (int m = 0; m < 4; ++m) _Pragma("unroll") for (int n = 0; n < 2; ++n) _Pragma("unroll") for (int k = 0; k < 2; ++k) \
        acc[ai][bj][m][n] = __builtin_amdgcn_mfma_f32_16x16x32_bf16(Bt[n][k], At[m][k], acc[ai][bj][m][n], 0, 0, 0); __builtin_amdgcn_s_setprio(0); } while (0)
#define PG8_WAIT_V(n) asm volatile("s_waitcnt vmcnt(" #n ")" ::: "memory")
#define PG8_WAIT_L(n) asm volatile("s_waitcnt lgkmcnt(" #n ")" ::: "memory")
#define PG8_BAR __builtin_amdgcn_s_barrier()
#define PG8_SCHED __builtin_amdgcn_sched_barrier(0)
    Unit cur, nxt; int ui = 0;
    if (!S.next(0, cur)) return;
    f32x4 acc[2][2][4][2];
#pragma unroll
    for (int a = 0; a < 2; ++a)
#pragma unroll
        for (int b = 0; b < 2; ++b)
#pragma unroll
            for (int m = 0; m < 4; ++m)
#pragma unroll
                for (int n = 0; n < 2; ++n) acc[a][b][m][n] = (f32x4){0.f, 0.f, 0.f, 0.f};
    bf16x8 At[4][2], B0[2][2], B1[2][2];
    const char* cA = (const char*)gA + (size_t)cur.pm * tstep; const char* cB = (const char*)gBt + (size_t)cur.pn * tstep;
    PG8_STAGE(PG8_SB(0, 0), cB, voffA); PG8_STAGE(PG8_SA(0, 0), cA, voffA); PG8_STAGE(PG8_SB(0, 1), cB + hstep, voffA); PG8_STAGE(PG8_SA(0, 1), cA + hstep, voffA);
    if (wr == 1) PG8_BAR;
    PG8_WAIT_V(4); PG8_BAR;
    PG8_STAGE(PG8_SB(1, 0), cB + kstep, voffA); PG8_STAGE(PG8_SA(1, 0), cA + kstep, voffA); PG8_STAGE(PG8_SB(1, 1), cB + hstep + kstep, voffA);
    PG8_WAIT_V(6); PG8_BAR;
    for (;;) {
        const bool has_next = S.next(ui + 1, nxt);
        const char* nA = has_next ? (const char*)gA + (size_t)nxt.pm * tstep : cA; const char* nB = has_next ? (const char*)gBt + (size_t)nxt.pn * tstep : cB;
        for (int t = 0; t < nt; t += 2) {
            const bool last = (t == nt - 2);
            const char* a1 = cA + (size_t)(t + 1) * kstep;
            const char* a2 = last ? nA : cA + (size_t)(t + 2) * kstep; const char* b2 = last ? nB : cB + (size_t)(t + 2) * kstep;
            const char* a3 = a2 + kstep; const char* b3 = b2 + kstep;
            PG8_LDB(B0, 0, 0); PG8_SCHED; PG8_LDA(At, 0, 0); PG8_STAGE(PG8_SA(1, 1), a1 + hstep, voffA);
            PG8_WAIT_L(8); PG8_BAR; PG8_WAIT_L(0); PG8_MMA(0, 0, At, B0); PG8_BAR; PG8_SCHED;
            PG8_LDB(B1, 0, 1); PG8_STAGE(PG8_SB(0, 0), b2, voffA);
            PG8_BAR; PG8_WAIT_L(0); PG8_MMA(0, 1, At, B1); PG8_BAR;
            PG8_LDA(At, 0, 1); PG8_STAGE(PG8_SA(0, 0), a2, voffA);
            PG8_BAR; PG8_WAIT_L(0); PG8_MMA(1, 0, At, B0); PG8_BAR; PG8_SCHED;
            PG8_STAGE(PG8_SB(0, 1), b2 + hstep, voffA);
            PG8_WAIT_V(6); PG8_BAR; PG8_MMA(1, 1, At, B1); PG8_BAR;
            PG8_LDB(B0, 1, 0); PG8_SCHED; PG8_LDA(At, 1, 0); PG8_STAGE(PG8_SA(0, 1), a2 + hstep, voffA);
            PG8_WAIT_L(8); PG8_BAR; PG8_WAIT_L(0); PG8_MMA(0, 0, At, B0); PG8_BAR; PG8_SCHED;
            PG8_LDB(B1, 1, 1); PG8_STAGE(PG8_SB(1, 0), b3, voffA);
            PG8_BAR; PG8_WAIT_L(0); PG8_MMA(0, 1, At, B1); PG8_BAR;
            PG8_LDA(At, 1, 1); PG8_STAGE(PG8_SA(1, 0), a3, voffA);
            PG8_BAR; PG8_WAIT_L(0); PG8_MMA(1, 0, At, B0); PG8_BAR; PG8_SCHED;
            PG8_STAGE(PG8_SB(1, 1), b3 + hstep, voffA);
            PG8_WAIT_V(6); PG8_BAR; PG8_MMA(1, 1, At, B1); PG8_BAR;
        }
        {
            const int row0 = cur.pm * BM + wr * 64 + fr, col0 = cur.pn * BM + wc * 32 + 4 * fq;
            float sc[2][4];
#pragma unroll
            for (int ai = 0; ai < 2; ++ai)
#pragma unroll
                for (int m = 0; m < 4; ++m) sc[ai][m] = f.begin(row0 + ai * HALF + m * 16);
#pragma unroll
            for (int ai = 0; ai < 2; ++ai)
#pragma unroll
                for (int m = 0; m < 4; ++m) {
                    const int row = row0 + ai * HALF + m * 16;
                    f32x4 hv[2][2];
#pragma unroll
                    for (int bj = 0; bj < 2; ++bj)
#pragma unroll
                        for (int n = 0; n < 2; ++n) hv[bj][n] = f.pre(row, col0 + bj * HALF + n * 16);
                    float ssq = 0.f;
#pragma unroll
                    for (int bj = 0; bj < 2; ++bj)
#pragma unroll
                        for (int n = 0; n < 2; ++n) ssq += f(row, col0 + bj * HALF + n * 16, acc[ai][bj][m][n], hv[bj][n], sc[ai][m]);
                    f.end(row, ssq, 0);
                }
        }
        if (!has_next) break;
#pragma unroll
        for (int a = 0; a < 2; ++a)
#pragma unroll
            for (int b = 0; b < 2; ++b)
#pragma unroll
                for (int m = 0; m < 4; ++m)
#pragma unroll
                    for (int n = 0; n < 2; ++n) acc[a][b][m][n] = (f32x4){0.f, 0.f, 0.f, 0.f};
        cur = nxt; cA = nA; cB = nB; ++ui;
    }
    PG8_WAIT_V(0);
    if (wr == 0) PG8_BAR;
    PG8_BAR;
#undef PG8_SA
#undef PG8_SB
#undef PG8_STAGE
#undef PG8_LDA
#undef PG8_LDB
#undef PG8_MMA
#undef PG8_WAIT_V
#undef PG8_WAIT_L
#undef PG8_BAR
#undef PG8_SCHED
}
}

__device__ __forceinline__ void wave_tile_mma(const bf16_t* __restrict__ A, int lda, const bf16_t* __restrict__ Bt, int ldb, int k0, int k1, f32x4 (&acc)[4][4], int fr, int fq) {
    const bf16_t* ap = A + (size_t)fr * lda + fq * 8;
    const bf16_t* bp = Bt + (size_t)fr * ldb + fq * 8;
#pragma unroll 2
    for (int k = k0; k < k1; k += 32) {
        bf16x8 a[4], b[4];
#pragma unroll
        for (int i = 0; i < 4; ++i) { a[i] = *(const bf16x8*)(ap + (size_t)i * 16 * lda + k); b[i] = *(const bf16x8*)(bp + (size_t)i * 16 * ldb + k); }
#pragma unroll
        for (int mi = 0; mi < 4; ++mi)
#pragma unroll
            for (int ni = 0; ni < 4; ++ni) acc[mi][ni] = __builtin_amdgcn_mfma_f32_16x16x32_bf16(b[ni], a[mi], acc[mi][ni], 0, 0, 0);
    }
}
__device__ __forceinline__ void zero_acc(f32x4 (&acc)[4][4]) {
#pragma unroll
    for (int i = 0; i < 4; ++i)
#pragma unroll
        for (int j = 0; j < 4; ++j) acc[i][j] = (f32x4){0.f, 0.f, 0.f, 0.f};
}

template <class F>
__device__ __forceinline__ void gemm_rem_phase(LAS unsigned char* lds, const bf16_t* A, const bf16_t* Bt, int N, int K, const F& f) {
    const int tid = threadIdx.x, wid = __builtin_amdgcn_readfirstlane(tid >> 6), lane = tid & 63, fr = lane & 15, fq = lane >> 4;
    const int ntiles = N / 64, kw = K / 8;
    for (int tile = (int)gridDim.x - 1 - (int)blockIdx.x; tile < ntiles; tile += gridDim.x) {
        const int n0 = tile * 64;
        f32x4 acc[4][4]; zero_acc(acc);
        wave_tile_mma(A + (size_t)MBIG * K, K, Bt + (size_t)n0 * K, K, wid * kw, (wid + 1) * kw, acc, fr, fq);
        LAS float* P = (LAS float*)lds + wid * 4096;
#pragma unroll
        for (int mi = 0; mi < 4; ++mi)
#pragma unroll
            for (int ni = 0; ni < 4; ++ni) *(LAS f32x4*)(P + (mi * 16 + fr) * 64 + ni * 16 + fq * 4) = acc[mi][ni];
        __syncthreads();
#pragma unroll
        for (int i = 0; i < 2; ++i) {
            const int idx = tid + i * 512, r = idx >> 4, c4 = (idx & 15) * 4;
            f32x4 s = (f32x4){0.f, 0.f, 0.f, 0.f};
#pragma unroll
            for (int w = 0; w < 8; ++w) s += *(const LAS f32x4*)((LAS float*)lds + w * 4096 + r * 64 + c4);
            const float sc = f.begin(MBIG + r);
            const f32x4 hv = f.pre(MBIG + r, n0 + c4);
            const float ssq = f(MBIG + r, n0 + c4, s, hv, sc);
            f.end(MBIG + r, ssq, 1);
        }
        __syncthreads();
    }
}

__device__ __forceinline__ float rstd_of(const float* SS, int row) { return rsqrtf(SS[row] * (1.0f / D) + 1e-6f); }
struct EpStoreBf16 { bf16_t* O; int ld;
    __device__ __forceinline__ float begin(int) const { return 1.f; }
    __device__ __forceinline__ f32x4 pre(int, int) const { return (f32x4){0.f, 0.f, 0.f, 0.f}; }
    __device__ __forceinline__ float operator()(int row, int col, f32x4 v, f32x4, float) const { u32x2 w; w.x = pk2(v[0], v[1]); w.y = pk2(v[2], v[3]); *(u32x2*)(O + (size_t)row * ld + col) = w; return 0.f; }
    __device__ __forceinline__ void end(int, float, int) const {} };
struct EpScaleStoreBf16 { bf16_t* O; int ld; const float* SS;
    __device__ __forceinline__ float begin(int row) const { return rstd_of(SS, row); }
    __device__ __forceinline__ f32x4 pre(int, int) const { return (f32x4){0.f, 0.f, 0.f, 0.f}; }
    __device__ __forceinline__ float operator()(int row, int col, f32x4 v, f32x4, float s) const { v = v * s; u32x2 w; w.x = pk2(v[0], v[1]); w.y = pk2(v[2], v[3]); *(u32x2*)(O + (size_t)row * ld + col) = w; return 0.f; }
    __device__ __forceinline__ void end(int, float, int) const {} };
struct EpScaleStoreF32 { float* O; int ld; const float* SS;
    __device__ __forceinline__ float begin(int row) const { return rstd_of(SS, row); }
    __device__ __forceinline__ f32x4 pre(int, int) const { return (f32x4){0.f, 0.f, 0.f, 0.f}; }
    __device__ __forceinline__ float operator()(int row, int col, f32x4 v, f32x4, float s) const { *(f32x4*)(O + (size_t)row * ld + col) = v * s; return 0.f; }
    __device__ __forceinline__ void end(int, float, int) const {} };
struct EpAddF32 { float* H; int ld;
    __device__ __forceinline__ float begin(int) const { return 1.f; }
    __device__ __forceinline__ f32x4 pre(int row, int col) const { return *(const f32x4*)(H + (size_t)row * ld + col); }
    __device__ __forceinline__ float operator()(int row, int col, f32x4 v, f32x4 h, float) const { *(f32x4*)(H + (size_t)row * ld + col) = h + v; return 0.f; }
    __device__ __forceinline__ void end(int, float, int) const {} };
struct EpResid { float* H; bf16_t* HB; float* SS;
    __device__ __forceinline__ float begin(int) const { return 1.f; }
    __device__ __forceinline__ f32x4 pre(int row, int col) const { return *(const f32x4*)(H + (size_t)row * D + col); }
    __device__ __forceinline__ float operator()(int row, int col, f32x4 v, f32x4 h0, float) const {
        const f32x4 h = h0 + v; *(f32x4*)(H + (size_t)row * D + col) = h;
        u32x2 w; w.x = pk2(h[0], h[1]); w.y = pk2(h[2], h[3]); *(u32x2*)(HB + (size_t)row * D + col) = w;
        return (h[0] * h[0] + h[1] * h[1]) + (h[2] * h[2] + h[3] * h[3]); }
    __device__ __forceinline__ void end(int row, float ssq, int kind) const {
        const int lane = threadIdx.x & 63;
        if (kind == 0) { ssq += __shfl_xor(ssq, 16); ssq += __shfl_xor(ssq, 32); if (lane < 16) atomicAdd(SS + row, ssq); }
        else { ssq = sum16(ssq); if ((lane & 15) == 0) atomicAdd(SS + row, ssq); } } };

template <class F>
__device__ __forceinline__ void gemm_full(LAS unsigned char* lds, const bf16_t* A, const bf16_t* Bt, int N, int K, const F& f) {
    pg8::StaticOrder S; S.init(MBIG, N, (int)gridDim.x, (int)blockIdx.x);
    pg8::gemm_phase(lds, A, Bt, K, S, f);
    gemm_rem_phase(lds, A, Bt, N, K, f);
}

__device__ __forceinline__ void convert_item(const float* __restrict__ src, bf16_t* __restrict__ dst, int K, int N, const float* __restrict__ gain, int item, int lane) {
    const int tk = K / 64;
    const int kk0 = (item % tk) * 64 + (lane & 7) * 8, n4 = (item / tk) * 32 + (lane >> 3) * 4;
    f32x4 v[8];
#pragma unroll
    for (int i = 0; i < 8; ++i) v[i] = (n4 < N) ? *(const f32x4*)(src + (size_t)(kk0 + i) * N + n4) : (f32x4){0.f, 0.f, 0.f, 0.f};
    if (gain) {
        const f32x4 g0 = *(const f32x4*)(gain + kk0), g1 = *(const f32x4*)(gain + kk0 + 4);
#pragma unroll
        for (int i = 0; i < 4; ++i) { v[i] = v[i] * g0[i]; v[4 + i] = v[4 + i] * g1[i]; }
    }
#pragma unroll
    for (int e = 0; e < 4; ++e) {
        u32x4 w; w.x = pk2(v[0][e], v[1][e]); w.y = pk2(v[2][e], v[3][e]); w.z = pk2(v[4][e], v[5][e]); w.w = pk2(v[6][e], v[7][e]);
        *(u32x4*)(dst + (size_t)(n4 + e) * K + kk0) = w;
    }
}
__device__ __forceinline__ void convert_wt(const float* __restrict__ src, bf16_t* __restrict__ dst, int K, int N, int Npad, const float* __restrict__ gain, LAS unsigned char* lds) {
    const int nitems = (K / 64) * (Npad / 32), lane = threadIdx.x & 63;
    for (int it = blockIdx.x * 8 + (threadIdx.x >> 6); it < nitems; it += gridDim.x * 8) convert_item(src, dst, K, N, gain, it, lane);
}
__device__ __forceinline__ void convert_steal(const float* __restrict__ src, bf16_t* __restrict__ dst, int K, int N, int Npad, const float* __restrict__ gain, unsigned* ctr, LAS unsigned char* lds) {
    const int nitems = (K / 64) * (Npad / 32), lane = threadIdx.x & 63, wid = threadIdx.x >> 6;
    volatile LAS unsigned* slot = (volatile LAS unsigned*)(lds + 131072 + 8);
    for (;;) {
        if (threadIdx.x == 0) *slot = __hip_atomic_fetch_add(ctr, 16u, __ATOMIC_RELAXED, __HIP_MEMORY_SCOPE_AGENT);
        __syncthreads();
        const int t0 = (int)*slot;
        __syncthreads();
        if (t0 >= nitems) break;
        if (t0 + wid < nitems) convert_item(src, dst, K, N, gain, t0 + wid, lane);
        if (t0 + 8 + wid < nitems) convert_item(src, dst, K, N, gain, t0 + 8 + wid, lane);
    }
}

template <int MODE>
__device__ __forceinline__ void rms_phase(const float* __restrict__ h_in, float* __restrict__ h_out, const float* __restrict__ x, const float* __restrict__ meta,
                          const float* __restrict__ gain, bf16_t* __restrict__ hn, float* __restrict__ out) {
    const int lane = threadIdx.x & 63, gw = blockIdx.x * 8 + (threadIdx.x >> 6), nw = gridDim.x * 8;
    for (int row = gw; row < M; row += nw) {
        const int b = row / L, t = row - b * L;
        if (MODE == 2 && t < NMETA) continue;
        const float* src;
        if (MODE == 1) src = (t < NMETA) ? meta + (size_t)t * D : x + ((size_t)b * SEQ + (t - NMETA)) * D;
        else src = h_in + (size_t)row * D;
        f32x4 v[8]; float ss = 0.f;
#pragma unroll
        for (int i = 0; i < 8; ++i) { v[i] = *(const f32x4*)(src + (lane + i * 64) * 4); ss += v[i][0] * v[i][0] + v[i][1] * v[i][1] + v[i][2] * v[i][2] + v[i][3] * v[i][3]; }
        ss = wave_sum(ss);
        const float r = rsqrtf(ss * (1.0f / D) + 1e-6f);
#pragma unroll
        for (int i = 0; i < 8; ++i) {
            const int c = (lane + i * 64) * 4;
            const f32x4 g = *(const f32x4*)(gain + c);
            const f32x4 o = v[i] * r * g;
            if (MODE == 1) *(f32x4*)(h_out + (size_t)row * D + c) = v[i];
            if (MODE == 2) *(f32x4*)(out + ((size_t)b * SEQ + (t - NMETA)) * D + c) = o;
            else { u32x2 w; w.x = pk2(o[0], o[1]); w.y = pk2(o[2], o[3]); *(u32x2*)(hn + (size_t)row * D + c) = w; }
        }
    }
}

__device__ __forceinline__ void mixer_ab_phase(const bf16_t* __restrict__ z1, const float* __restrict__ conf_dw, const float* __restrict__ conf_b, const float* __restrict__ ln_g,
                               const float* __restrict__ ln_b, const float* __restrict__ sc_dw, bf16_t* __restrict__ cat, LAS unsigned char* lds) {
    const int tid = threadIdx.x, wid = __builtin_amdgcn_readfirstlane(tid >> 6), lane = tid & 63;
    LAS unsigned* S32 = (LAS unsigned*)lds;
    LAS float* C = (LAS float*)lds;
    for (int tile = blockIdx.x; tile < NBATCH * 65; tile += gridDim.x) {
        const int b = tile / 65, t0 = (tile % 65) * 32;
        const int nt = (L - t0) < 32 ? (L - t0) : 32;
        for (int r = 0; r < 62; ++r) {
            const int t = t0 - 30 + r; unsigned w = 0u;
            if (t >= 0 && t < L) {
                const bf16_t* zr = z1 + (size_t)(b * L + t) * NAB;
                const unsigned a = *(const unsigned*)(zr + 2 * tid), g = *(const unsigned*)(zr + 1024 + 2 * tid);
                w = pk2(lo_f(a) * sigm(lo_f(g)), hi_f(a) * sigm(hi_f(g)));
            }
            S32[r * 512 + tid] = w;
        }
        __syncthreads();
        f32x2 acc[32];
#pragma unroll
        for (int t = 0; t < 32; ++t) acc[t] = (f32x2){0.f, 0.f};
#pragma unroll 1
        for (int j = 0; j < 31; ++j) {
            const f32x2 w = *(const f32x2*)(conf_dw + j * 1024 + 2 * tid);
#pragma unroll
            for (int t = 0; t < 32; ++t) { const unsigned xw = S32[(t + j) * 512 + tid]; acc[t] += (f32x2){lo_f(xw), hi_f(xw)} * w; }
        }
        const f32x2 bias = *(const f32x2*)(conf_b + 2 * tid);
        __syncthreads();
#pragma unroll
        for (int t = 0; t < 32; ++t) *(LAS f32x2*)(C + t * 1024 + 2 * tid) = acc[t] + bias;
        __syncthreads();
        for (int q = 0; q < 4; ++q) {
            const int tt = wid * 4 + q;
            if (tt < nt) {
                f32x4 v[4]; float s = 0.f;
#pragma unroll
                for (int i = 0; i < 4; ++i) { v[i] = *(const LAS f32x4*)(C + tt * 1024 + (lane + i * 64) * 4); s += (v[i][0] + v[i][1]) + (v[i][2] + v[i][3]); }
                const float mean = wave_sum(s) * (1.0f / 1024.0f);
                float qv = 0.f;
#pragma unroll
                for (int i = 0; i < 4; ++i) { const f32x4 d = v[i] - mean; qv += d[0] * d[0] + d[1] * d[1] + d[2] * d[2] + d[3] * d[3]; }
                const float rstd = rsqrtf(wave_sum(qv) * (1.0f / 1024.0f) + 1e-5f);
                bf16_t* orow = cat + (size_t)(b * L + t0 + tt) * D;
#pragma unroll
                for (int i = 0; i < 4; ++i) {
                    const int c = (lane + i * 64) * 4;
                    const f32x4 g = *(const f32x4*)(ln_g + c), bb = *(const f32x4*)(ln_b + c);
                    const f32x4 y = (v[i] - mean) * rstd * g + bb;
                    u32x2 w; w.x = pk2(silu(y[0]), silu(y[1])); w.y = pk2(silu(y[2]), silu(y[3]));
                    *(u32x2*)(orow + c) = w;
                }
            }
        }
        __syncthreads();
    }
    const int gtid = blockIdx.x * NTHREADS + tid, nth = gridDim.x * NTHREADS;
    for (int idx = gtid; idx < M * 128; idx += nth) {
        const int row = idx >> 7, c = (idx & 127) * 8, t = row % L;
        float acc[8];
#pragma unroll
        for (int e = 0; e < 8; ++e) acc[e] = 0.f;
#pragma unroll
        for (int j = 0; j < 3; ++j) {
            if (t - 2 + j >= 0) {
                const bf16_t* zr = z1 + (size_t)(row - 2 + j) * NAB;
                const u32x4 sc = *(const u32x4*)(zr + 3072 + c), sx = *(const u32x4*)(zr + 4096 + c);
                const f32x4 w0 = *(const f32x4*)(sc_dw + j * 1024 + c), w1 = *(const f32x4*)(sc_dw + j * 1024 + c + 4);
                acc[0] += lo_f(sc.x) * lo_f(sx.x) * w0[0]; acc[1] += hi_f(sc.x) * hi_f(sx.x) * w0[1];
                acc[2] += lo_f(sc.y) * lo_f(sx.y) * w0[2]; acc[3] += hi_f(sc.y) * hi_f(sx.y) * w0[3];
                acc[4] += lo_f(sc.z) * lo_f(sx.z) * w1[0]; acc[5] += hi_f(sc.z) * hi_f(sx.z) * w1[1];
                acc[6] += lo_f(sc.w) * lo_f(sx.w) * w1[2]; acc[7] += hi_f(sc.w) * hi_f(sx.w) * w1[3];
            }
        }
        const u32x4 sb = *(const u32x4*)(z1 + (size_t)row * NAB + 2048 + c);
        u32x4 o;
        o.x = pk2(lo_f(sb.x) * acc[0], hi_f(sb.x) * acc[1]); o.y = pk2(lo_f(sb.y) * acc[2], hi_f(sb.y) * acc[3]);
        o.z = pk2(lo_f(sb.z) * acc[4], hi_f(sb.z) * acc[5]); o.w = pk2(lo_f(sb.w) * acc[6], hi_f(sb.w) * acc[7]);
        *(u32x4*)(cat + (size_t)row * D + 1024 + c) = o;
    }
}

__device__ __forceinline__ void ffn_gate_phase(const bf16_t* __restrict__ u, const float* __restrict__ dw  , bf16_t* __restrict__ g) {
    const int gtid = blockIdx.x * NTHREADS + threadIdx.x, nth = gridDim.x * NTHREADS;
    constexpr int NC8 = DFF / 8, NRUN = L / 16;
    for (int idx = gtid; idx < NBATCH * NRUN * NC8; idx += nth) {
        const int c = (idx % NC8) * 8, run = (idx / NC8) % NRUN, b = idx / (NC8 * NRUN), t0 = run * 16;
        float wv[3][8], wg[3][8];
#pragma unroll
        for (int j = 0; j < 3; ++j) {
            const f32x4 a0 = *(const f32x4*)(dw + j * NUP + c), a1 = *(const f32x4*)(dw + j * NUP + c + 4);
            const f32x4 g0 = *(const f32x4*)(dw + j * NUP + DFF + c), g1 = *(const f32x4*)(dw + j * NUP + DFF + c + 4);
#pragma unroll
            for (int e = 0; e < 4; ++e) { wv[j][e] = a0[e]; wv[j][4 + e] = a1[e]; wg[j][e] = g0[e]; wg[j][4 + e] = g1[e]; }
        }
        u32x4 v2 = (u32x4){0u, 0u, 0u, 0u}, v1 = v2, g2 = v2, g1 = v2;
        if (t0 >= 2) {
            const bf16_t* r2 = u + (size_t)(b * L + t0 - 2) * NUP; const bf16_t* r1 = r2 + NUP;
            v2 = *(const u32x4*)(r2 + c); g2 = *(const u32x4*)(r2 + DFF + c); v1 = *(const u32x4*)(r1 + c); g1 = *(const u32x4*)(r1 + DFF + c);
        }
#pragma unroll 4
        for (int i = 0; i < 16; ++i) {
            const size_t row = (size_t)(b * L + t0 + i);
            const u32x4 v0 = *(const u32x4*)(u + row * NUP + c), g0 = *(const u32x4*)(u + row * NUP + DFF + c);
            float val[8], gat[8];
#define TAP(e, W2, W1, W0, sel) \
            val[e] = sel(v2.W2) * wv[0][e] + sel(v1.W1) * wv[1][e] + sel(v0.W0) * wv[2][e]; gat[e] = sel(g2.W2) * wg[0][e] + sel(g1.W1) * wg[1][e] + sel(g0.W0) * wg[2][e];
            TAP(0, x, x, x, lo_f) TAP(1, x, x, x, hi_f) TAP(2, y, y, y, lo_f) TAP(3, y, y, y, hi_f)
            TAP(4, z, z, z, lo_f) TAP(5, z, z, z, hi_f) TAP(6, w, w, w, lo_f) TAP(7, w, w, w, hi_f)
#undef TAP
            u32x4 o;
            o.x = pk2(silu(gat[0]) * val[0], silu(gat[1]) * val[1]); o.y = pk2(silu(gat[2]) * val[2], silu(gat[3]) * val[3]);
            o.z = pk2(silu(gat[4]) * val[4], silu(gat[5]) * val[5]); o.w = pk2(silu(gat[6]) * val[6], silu(gat[7]) * val[7]);
            *(u32x4*)(g + row * DFF + c) = o;
            v2 = v1; g2 = g1; v1 = v0; g1 = g0;
        }
    }
}

struct CD {
    const float *z2, *gla_w2, *gla_b, *gla_norm_g, *rw_mu, *rw_w0, *rw_a0, *rw_kk, *rw_ka, *rw_rk, *rw_ln_g, *rw_ln_b;
    float *R, *KR, *VR, *G, *Y, *CDEC, *BONUS, *DECAY, *A, *KK, *O;
    bf16_t *LW, *LA, *LG, *GATE, *QDEC, *KDEC, *K2T, *VT, *W2T, *A2T, *G2T, *CST, *SPT, *P, *CAT;
};

__device__ __forceinline__ void prep1_phase(const CD& p, LAS unsigned char* lds) {
    const int tid = threadIdx.x, wid = __builtin_amdgcn_readfirstlane(tid >> 6), lane = tid & 63;
    LAS float* tot = (LAS float*)lds;
    for (int item = blockIdx.x; item < NGI; item += gridDim.x) {
        const int bh = item / NCH, n = item - bh * NCH, b = bh >> 2, h = bh & 3;
        const int pg = wid >> 1, d = (wid & 1) * 64 + lane;
        float w2r[16];
#pragma unroll
        for (int r = 0; r < 16; ++r) w2r[r] = p.gla_w2[r * 512 + h * 128 + d];
        const float bias = p.gla_b[h * 128 + d];
        float la[16]; float run = 0.f;
#pragma unroll
        for (int i = 0; i < 16; ++i) {
            const int t = n * 64 + pg * 16 + i - 48;
            float v = 0.f;
            if (t >= 0 && t < L) {
                const float* gl = p.z2 + (size_t)(b * L + t) * NCDP + 3072;
                float xx = bias;
#pragma unroll
                for (int r = 0; r < 16; ++r) xx += gl[r] * w2r[r];
                v = logsig(xx) * (1.0f / 16.0f);
            }
            run += v; la[i] = run;
        }
        tot[pg * 128 + d] = run;
        __syncthreads();
        float off = 0.f, last = 0.f;
#pragma unroll
        for (int g4 = 0; g4 < 4; ++g4) { const float tv = tot[g4 * 128 + d]; if (g4 < pg) off += tv; last += tv; }
        unsigned k2p[8];
#pragma unroll
        for (int i = 0; i < 16; ++i) {
            const int pp = pg * 16 + i, t = n * 64 + pp - 48;
            const float cum = off + la[i];
            float q = 0.f, k = 0.f;
            if (t >= 0 && t < L) { const float* zr = p.z2 + (size_t)(b * L + t) * NCDP; q = zr[h * 128 + d] * 0.08838834764831845f; k = zr[512 + h * 128 + d]; }
            const float qd = q * expf(cum), kd = k * expf(-cum), k2 = k * expf(last - cum);
            p.QDEC[((size_t)item * 64 + pp) * 128 + d] = (bf16_t)f2bf(qd);
            p.KDEC[((size_t)item * 64 + pp) * 128 + d] = (bf16_t)f2bf(kd);
            if (i & 1) k2p[i >> 1] |= f2bf(k2) << 16; else k2p[i >> 1] = f2bf(k2);
        }
        {
            bf16_t* dst = p.K2T + ((size_t)item * 128 + d) * 64 + pg * 16;
            *(u32x4*)(dst) = (u32x4){k2p[0], k2p[1], k2p[2], k2p[3]};
            *(u32x4*)(dst + 8) = (u32x4){k2p[4], k2p[5], k2p[6], k2p[7]};
        }
        if (pg == 0) p.CDEC[item * 128 + d] = expf(last);
        {
            const int v = tid & 255, ph = tid >> 8;
            unsigned vp[16];
#pragma unroll
            for (int i = 0; i < 32; ++i) {
                const int t = n * 64 + ph * 32 + i - 48;
                float xv = 0.f;
                if (t >= 0 && t < L) xv = p.z2[(size_t)(b * L + t) * NCDP + 1024 + h * 256 + v];
                if (i & 1) vp[i >> 1] |= f2bf(xv) << 16; else vp[i >> 1] = f2bf(xv);
            }
            bf16_t* dst = p.VT + ((size_t)item * 256 + v) * 64 + ph * 32;
#pragma unroll
            for (int s = 0; s < 4; ++s) *(u32x4*)(dst + s * 8) = (u32x4){vp[s * 4 + 0], vp[s * 4 + 1], vp[s * 4 + 2], vp[s * 4 + 3]};
        }
        __syncthreads();
    }
    const int gtid = blockIdx.x * NTHREADS + tid, nth = gridDim.x * NTHREADS;
    for (int idx = gtid; idx < M * 256; idx += nth) {
        const int row = idx >> 8, c = (idx & 255) * 4;
        const f32x4 go = *(const f32x4*)(p.z2 + (size_t)row * NCDP + 2048 + c), ng = *(const f32x4*)(p.gla_norm_g + c);
        u32x2 w; w.x = pk2(silu(go[0]) * ng[0], silu(go[1]) * ng[1]); w.y = pk2(silu(go[2]) * ng[2], silu(go[3]) * ng[3]);
        *(u32x2*)(p.GATE + (size_t)row * 1024 + c) = w;
    }
    for (int idx = gtid; idx < M * 832; idx += nth) {
        const int row = idx / 832, c4 = (idx - row * 832) * 4, t = row % L;
        const f32x4 z = *(const f32x4*)(p.z2 + (size_t)row * NCDP + 3088 + c4);
        f32x4 zp = (f32x4){0.f, 0.f, 0.f, 0.f};
        if (t > 0) zp = *(const f32x4*)(p.z2 + (size_t)(row - 1) * NCDP + 3088 + c4);
        const f32x4 mu = *(const f32x4*)(p.rw_mu + c4);
        const f32x4 zr = z + (zp - z) * mu;
        if (c4 < 1024) *(f32x4*)(p.R + (size_t)row * 1024 + c4) = zr;
        else if (c4 < 2048) *(f32x4*)(p.KR + (size_t)row * 1024 + c4 - 1024) = zr;
        else if (c4 < 3072) *(f32x4*)(p.VR + (size_t)row * 1024 + c4 - 2048) = zr;
        else if (c4 < 3136) { u32x2 w; w.x = pk2(tanhf(zr[0]), tanhf(zr[1])); w.y = pk2(tanhf(zr[2]), tanhf(zr[3])); *(u32x2*)(p.LW + (size_t)row * 64 + c4 - 3072) = w; }
        else if (c4 < 3200) { u32x2 w; w.x = pk2(zr[0], zr[1]); w.y = pk2(zr[2], zr[3]); *(u32x2*)(p.LA + (size_t)row * 64 + c4 - 3136) = w; }
        else { u32x2 w; w.x = pk2(sigm(zr[0]), sigm(zr[1])); w.y = pk2(sigm(zr[2]), sigm(zr[3])); *(u32x2*)(p.LG + (size_t)row * 128 + c4 - 3200) = w; }
    }
}

__device__ __forceinline__ void small_gemm_phase(const CD& p) {
    const int lane = threadIdx.x & 63, fr = lane & 15, fq = lane >> 4;
    const int gw = blockIdx.x * 8 + (threadIdx.x >> 6), nw = gridDim.x * 8;
    constexpr int TL = (M / 64) * 16;
    constexpr int T0 = 3 * TL, T1 = T0 + NGI, T2 = T1 + NGI * 8;
    for (int tix = gw; tix < T2; tix += nw) {
        f32x4 acc[4][4]; zero_acc(acc);
        if (tix < T0) {
            const int which = tix / TL, r = tix - which * TL, m0 = (r >> 4) * 64, n0 = (r & 15) * 64;
            if (which == 0) {
                wave_tile_mma(p.LW + (size_t)m0 * 64, 64, p.W2T + (size_t)n0 * 64, 64, 0, 64, acc, fr, fq);
#pragma unroll
                for (int mi = 0; mi < 4; ++mi)
#pragma unroll
                    for (int ni = 0; ni < 4; ++ni) {
                        const int row = m0 + mi * 16 + fr, col = n0 + ni * 16 + fq * 4;
                        const f32x4 w0 = *(const f32x4*)(p.rw_w0 + col); f32x4 o;
#pragma unroll
                        for (int e = 0; e < 4; ++e) o[e] = expf(-expf(logsig(w0[e] + acc[mi][ni][e]) - 0.5f));
                        *(f32x4*)(p.DECAY + (size_t)row * 1024 + col) = o;
                    }
            } else if (which == 1) {
                wave_tile_mma(p.LA + (size_t)m0 * 64, 64, p.A2T + (size_t)n0 * 64, 64, 0, 64, acc, fr, fq);
#pragma unroll
                for (int mi = 0; mi < 4; ++mi)
#pragma unroll
                    for (int ni = 0; ni < 4; ++ni) {
                        const int row = m0 + mi * 16 + fr, col = n0 + ni * 16 + fq * 4;
                        const f32x4 a0 = *(const f32x4*)(p.rw_a0 + col); f32x4 o;
#pragma unroll
                        for (int e = 0; e < 4; ++e) o[e] = sigm(a0[e] + acc[mi][ni][e]);
                        *(f32x4*)(p.A + (size_t)row * 1024 + col) = o;
                    }
            } else {
                wave_tile_mma(p.LG + (size_t)m0 * 128, 128, p.G2T + (size_t)n0 * 128, 128, 0, 128, acc, fr, fq);
#pragma unroll
                for (int mi = 0; mi < 4; ++mi)
#pragma unroll
                    for (int ni = 0; ni < 4; ++ni) {
                        const int row = m0 + mi * 16 + fr, col = n0 + ni * 16 + fq * 4;
                        *(f32x4*)(p.G + (size_t)row * 1024 + col) = acc[mi][ni];
                    }
            }
        } else if (tix < T1) {
            const int item = tix - T0;
            wave_tile_mma(p.QDEC + (size_t)item * 8192, 128, p.KDEC + (size_t)item * 8192, 128, 0, 128, acc, fr, fq);
#pragma unroll
            for (int mi = 0; mi < 4; ++mi)
#pragma unroll
                for (int ni = 0; ni < 4; ++ni) {
                    const int pp = mi * 16 + fr, s0 = ni * 16 + fq * 4;
                    f32x4 v = acc[mi][ni];
#pragma unroll
                    for (int e = 0; e < 4; ++e) if (s0 + e > pp) v[e] = 0.f;
                    u32x2 w; w.x = pk2(v[0], v[1]); w.y = pk2(v[2], v[3]);
                    *(u32x2*)(p.P + (size_t)item * 4096 + pp * 64 + s0) = w;
                }
        } else {
            const int r = tix - T1, item = r >> 3, vt = (r >> 1) & 3, dt = r & 1;
            wave_tile_mma(p.VT + ((size_t)item * 256 + vt * 64) * 64, 64, p.K2T + ((size_t)item * 128 + dt * 64) * 64, 64, 0, 64, acc, fr, fq);
#pragma unroll
            for (int mi = 0; mi < 4; ++mi)
#pragma unroll
                for (int ni = 0; ni < 4; ++ni) {
                    const int v = vt * 64 + mi * 16 + fr, d0 = dt * 64 + ni * 16 + fq * 4;
                    u32x2 w; w.x = pk2(acc[mi][ni][0], acc[mi][ni][1]); w.y = pk2(acc[mi][ni][2], acc[mi][ni][3]);
                    *(u32x2*)(p.CST + ((size_t)item * 256 + v) * 128 + d0) = w;
                }
        }
    }
}

__device__ __forceinline__ void prep2_phase(const CD& p) {
    const int lane = threadIdx.x & 63;
    const int gw = blockIdx.x * 8 + (threadIdx.x >> 6), nw = gridDim.x * 8;
    for (int it = gw; it < M * 4; it += nw) {
        const int row = it >> 2, h = (it & 3) * 4 + (lane >> 4), c = h * 64 + (lane & 15) * 4;
        const size_t o = (size_t)row * 1024 + c;
        const f32x4 kr = *(const f32x4*)(p.KR + o), a = *(const f32x4*)(p.A + o), r = *(const f32x4*)(p.R + o);
        f32x4 kk = kr * *(const f32x4*)(p.rw_kk + c);
        const float ss = sum16(kk[0] * kk[0] + kk[1] * kk[1] + kk[2] * kk[2] + kk[3] * kk[3]);
        kk = kk * (1.0f / fmaxf(sqrtf(ss), 1e-12f));
        const f32x4 k = kr * (1.0f + (a - 1.0f) * *(const f32x4*)(p.rw_ka + c));
        const f32x4 rk = r * k * *(const f32x4*)(p.rw_rk + c);
        const float bs = sum16((rk[0] + rk[1]) + (rk[2] + rk[3]));
        *(f32x4*)(p.KK + o) = kk; *(f32x4*)(p.A + o) = kk * a; *(f32x4*)(p.KR + o) = k;
        if ((lane & 15) == 0) p.BONUS[row * 16 + h] = bs;
    }
    const int gtid = blockIdx.x * NTHREADS + threadIdx.x, nth = gridDim.x * NTHREADS;
    for (int e = gtid; e < 16 * 256 * 32; e += nth) {
        const int d4 = (e & 31) * 4, v = (e >> 5) & 255, bh = e >> 13;
        f32x4 S = (f32x4){0.f, 0.f, 0.f, 0.f};
#pragma unroll 3
        for (int n = 0; n < NCH; ++n) {
            const int item = bh * NCH + n;
            const size_t o = ((size_t)item * 256 + v) * 128 + d4;
            u32x2 w; w.x = pk2(S[0], S[1]); w.y = pk2(S[2], S[3]);
            *(u32x2*)(p.SPT + o) = w;
            const f32x4 dec = *(const f32x4*)(p.CDEC + item * 128 + d4);
            const u32x2 cs = *(const u32x2*)(p.CST + o);
            S = S * dec + (f32x4){lo_f(cs.x), hi_f(cs.x), lo_f(cs.y), hi_f(cs.y)};
        }
    }
}

__device__ __forceinline__ void gla_out_phase(const CD& p) {
    const int lane = threadIdx.x & 63, fr = lane & 15, fq = lane >> 4;
    const int gw = blockIdx.x * 8 + (threadIdx.x >> 6), nw = gridDim.x * 8;
    for (int tix = gw; tix < NGI * 4; tix += nw) {
        const int item = tix >> 2, vt = tix & 3, bh = item / NCH, n = item - bh * NCH, b = bh >> 2, h = bh & 3;
        f32x4 acc[4][4]; zero_acc(acc);
        wave_tile_mma(p.P + (size_t)item * 4096, 64, p.VT + ((size_t)item * 256 + vt * 64) * 64, 64, 0, 64, acc, fr, fq);
        wave_tile_mma(p.QDEC + (size_t)item * 8192, 128, p.SPT + ((size_t)item * 256 + vt * 64) * 128, 128, 0, 128, acc, fr, fq);
#pragma unroll
        for (int mi = 0; mi < 4; ++mi) {
            const int t = n * 64 + mi * 16 + fr - 48;
            if (t >= 0 && t < L) {
#pragma unroll
                for (int ni = 0; ni < 4; ++ni) *(f32x4*)(p.O + (size_t)(b * L + t) * 1024 + h * 256 + vt * 64 + ni * 16 + fq * 4) = acc[mi][ni];
            }
        }
    }
}

__device__ __forceinline__ float oct_sum(float x) {
    x += __int_as_float(__builtin_amdgcn_update_dpp(0, __float_as_int(x), 0xB1, 0xF, 0xF, false));
    x += __int_as_float(__builtin_amdgcn_update_dpp(0, __float_as_int(x), 0x4E, 0xF, 0xF, false));
    x += __int_as_float(__builtin_amdgcn_update_dpp(0, __float_as_int(x), 0x141, 0xF, 0xF, false));
    return x;
}
struct StepOps { f32x4 r[2], w[2], k[2], kk[2], b[2]; float v; };
__device__ __forceinline__ void ld_ops(StepOps& o, const LAS float* bp, int s, int j, int vidx) {
    const LAS float* sp = bp + s * 64 + j * 8;
    o.r[0] = *(const LAS f32x4*)(sp); o.r[1] = *(const LAS f32x4*)(sp + 4);
    o.w[0] = *(const LAS f32x4*)(sp + 2048); o.w[1] = *(const LAS f32x4*)(sp + 2048 + 4);
    o.k[0] = *(const LAS f32x4*)(sp + 4096); o.k[1] = *(const LAS f32x4*)(sp + 4096 + 4);
    o.kk[0] = *(const LAS f32x4*)(sp + 6144); o.kk[1] = *(const LAS f32x4*)(sp + 6144 + 4);
    o.b[0] = *(const LAS f32x4*)(sp + 8192); o.b[1] = *(const LAS f32x4*)(sp + 8192 + 4);
    o.v = bp[10240 + s * 64 + vidx];
}
__device__ __forceinline__ float scan_step(f32x2 (&S)[4], const StepOps& o) {
    f32x2 sa2 = S[0] * o.kk[0].lo + S[1] * o.kk[0].hi;
    sa2 += S[2] * o.kk[1].lo + S[3] * o.kk[1].hi;
    const f32x2 vv = (f32x2){o.v, o.v};
    const f32x2 t0 = vv * o.k[0].lo, t1 = vv * o.k[0].hi, t2 = vv * o.k[1].lo, t3 = vv * o.k[1].hi;
    const float sa = -oct_sum(sa2[0] + sa2[1]);
    const f32x2 sv = (f32x2){sa, sa};
    S[0] = S[0] * o.w[0].lo + (sv * o.b[0].lo + t0);
    S[1] = S[1] * o.w[0].hi + (sv * o.b[0].hi + t1);
    S[2] = S[2] * o.w[1].lo + (sv * o.b[1].lo + t2);
    S[3] = S[3] * o.w[1].hi + (sv * o.b[1].hi + t3);
    f32x2 y2 = S[0] * o.r[0].lo + S[1] * o.r[0].hi;
    y2 += S[2] * o.r[1].lo + S[3] * o.r[1].hi;
    return oct_sum(y2[0] + y2[1]);
}
__device__ __forceinline__ void rwkv_scan_phase(const CD& p, LAS unsigned char* lds) {
    const int tid = threadIdx.x, wid = __builtin_amdgcn_readfirstlane(tid >> 6), lane = tid & 63;
    LAS float* buf = (LAS float*)lds;
    constexpr int NCHUNK = (L + 31) / 32;
    for (int item = blockIdx.x; item < 256; item += gridDim.x) {
        const int bh = item >> 2, q = item & 3, b = bh >> 4, h = bh & 15;
        const int rr = tid >> 4, c4 = (tid & 15) * 4;
        const size_t gbase = (size_t)(b * L) * 1024 + h * 64 + c4;
        f32x4 st0, st1, st2, st3, st4, st5;
#define SCAN_LOADS(tn) do { const size_t _o = gbase + (size_t)(tn) * 1024; \
        st0 = *(const f32x4*)(p.R + _o); st1 = *(const f32x4*)(p.DECAY + _o); st2 = *(const f32x4*)(p.KR + _o); \
        st3 = *(const f32x4*)(p.KK + _o); st4 = *(const f32x4*)(p.A + _o); st5 = *(const f32x4*)(p.VR + _o); } while (0)
#define SCAN_STORES(bb) do { LAS float* _d = buf + (bb) * 12288 + rr * 64 + c4; \
        *(LAS f32x4*)(_d) = st0; *(LAS f32x4*)(_d + 2048) = st1; *(LAS f32x4*)(_d + 4096) = st2; \
        *(LAS f32x4*)(_d + 6144) = st3; *(LAS f32x4*)(_d + 8192) = st4; *(LAS f32x4*)(_d + 10240) = st5; } while (0)
        SCAN_LOADS(rr);
        SCAN_STORES(0);
        __syncthreads();
        f32x2 S[4];
#pragma unroll
        for (int i = 0; i < 4; ++i) S[i] = (f32x2){0.f, 0.f};
        const int srow = lane >> 3, j = lane & 7, vidx = q * 16 + wid * 8 + srow;
        int cb = 0;
        for (int c = 0; c < NCHUNK; ++c) {
            const int t0 = c * 32;
            const bool more = (c + 1 < NCHUNK);
            if (more) {
                const int tn = t0 + 32 + rr;
                if (tn < L) SCAN_LOADS(tn);
                else { st0 = (f32x4){0.f, 0.f, 0.f, 0.f}; st1 = st0; st2 = st0; st3 = st0; st4 = st0; st5 = st0; }
            }
            if (wid < 2) {
                const LAS float* bp = buf + cb * 12288;
                const int ns = (L - t0) < 32 ? (L - t0) : 32;
                float* yp = p.Y + (size_t)(b * L + t0) * 1024 + h * 64 + vidx;
                StepOps A, B;
                ld_ops(A, bp, 0, j, vidx);
                for (int s = 0; s < ns; s += 2) {
                    ld_ops(B, bp, s + 1, j, vidx);
                    const float ya = scan_step(S, A);
                    if (j == 0) yp[(size_t)s * 1024] = ya;
                    if (s + 2 < ns) ld_ops(A, bp, s + 2, j, vidx);
                    const float yb = scan_step(S, B);
                    if (j == 0) yp[(size_t)(s + 1) * 1024] = yb;
                }
            }
            if (more) SCAN_STORES(cb ^ 1);
            __syncthreads();
            cb ^= 1;
        }
#undef SCAN_LOADS
#undef SCAN_STORES
    }
}

__device__ __forceinline__ void post_phase(const CD& p) {
    const int lane = threadIdx.x & 63;
    const int gw = blockIdx.x * 8 + (threadIdx.x >> 6), nw = gridDim.x * 8;
    for (int it = gw; it < M * 4; it += nw) {
        const int row = it >> 2, h = it & 3;
        const size_t o = (size_t)row * 1024 + h * 256 + lane * 4;
        const f32x4 v = *(const f32x4*)(p.O + o);
        const float ss = wave_sum(v[0] * v[0] + v[1] * v[1] + v[2] * v[2] + v[3] * v[3]);
        const float rs = rsqrtf(ss * (1.0f / 256.0f) + 1e-6f);
        const u32x2 gt = *(const u32x2*)(p.GATE + o);
        u32x2 w; w.x = pk2(v[0] * rs * lo_f(gt.x), v[1] * rs * hi_f(gt.x)); w.y = pk2(v[2] * rs * lo_f(gt.y), v[3] * rs * hi_f(gt.y));
        *(u32x2*)(p.CAT + (size_t)row * D + h * 256 + lane * 4) = w;
    }
    for (int it = gw; it < M * 4; it += nw) {
        const int row = it >> 2, h = (it & 3) * 4 + (lane >> 4), c = h * 64 + (lane & 15) * 4;
        const size_t o = (size_t)row * 1024 + c;
        const f32x4 y = *(const f32x4*)(p.Y + o);
        const float mu = sum16((y[0] + y[1]) + (y[2] + y[3])) * (1.0f / 64.0f);
        const f32x4 dv = y - mu;
        const float var = sum16(dv[0] * dv[0] + dv[1] * dv[1] + dv[2] * dv[2] + dv[3] * dv[3]) * (1.0f / 64.0f);
        const float rstd = rsqrtf(var + 64e-5f);
        const f32x4 yn = dv * rstd * *(const f32x4*)(p.rw_ln_g + c) + *(const f32x4*)(p.rw_ln_b + c);
        const float bonus = p.BONUS[row * 16 + h];
        const f32x4 res = (yn + bonus * *(const f32x4*)(p.VR + o)) * *(const f32x4*)(p.G + o);
        u32x2 w; w.x = pk2(res[0], res[1]); w.y = pk2(res[2], res[3]);
        *(u32x2*)(p.CAT + (size_t)row * D + 1024 + c) = w;
    }
}

struct Params { const float* in[31]; float* out; unsigned char* ws; };

__global__ void __launch_bounds__(NTHREADS, 2) fwd_megakernel(Params prm) {
    extern __shared__ __attribute__((aligned(16))) unsigned char lds_raw[];
    LAS unsigned char* lds = (LAS unsigned char*)lds_raw;
    cg::grid_group grid = cg::this_grid();
    size_t zoff = 0;
    unsigned char* ws = prm.ws;
    {
        unsigned* bw = (unsigned*)(ws + XO_BAR);
        if (blockIdx.x == 0) {
            for (int i = threadIdx.x; i < BAR_WORDS; i += NTHREADS) bw[i] = 0u;
            float* ss = (float*)(ws + XO_SS);
            for (int i = threadIdx.x; i < 3 * M; i += NTHREADS) ss[i] = 0.f;
        }
        if (threadIdx.x < 4) ((LAS unsigned*)(lds + 131072))[threadIdx.x] = 0u;
        __syncthreads();
    }
    XcdBarrier xbar; xbar.bar = (unsigned*)(ws + XO_BAR); xbar.x = 0; xbar.st = (volatile LAS unsigned*)(lds + 131072);
#define SYNC() do { xcd_barrier(xbar); asm volatile("" : "+s"(zoff) :: "memory"); ws = prm.ws + zoff; } while (0)
#define SYNC0() do { grid.sync(); xbar = xcd_barrier_post((unsigned*)(ws + XO_BAR), (volatile LAS unsigned*)(lds + 131072)); asm volatile("" : "+s"(zoff) :: "memory"); ws = prm.ws + zoff; } while (0)
#define WSF(off) ((float*)(ws + (off)))
#define WSB(off) ((bf16_t*)(ws + (off)))
#define CTR(j) ((unsigned*)(ws + XO_BAR) + 3456 + (j))
#define SSQ(j) (WSF(XO_SS) + (j) * M)
#define MKCD(p) CD p; \
        p.z2 = WSF(OFF_Z); p.gla_w2 = prm.in[10]; p.gla_b = prm.in[11]; p.gla_norm_g = prm.in[12]; p.rw_mu = prm.in[13]; p.rw_w0 = prm.in[14]; p.rw_a0 = prm.in[16]; \
        p.rw_kk = prm.in[19]; p.rw_ka = prm.in[20]; p.rw_rk = prm.in[21]; p.rw_ln_g = prm.in[22]; p.rw_ln_b = prm.in[23]; \
        p.R = WSF(XO_R); p.KR = WSF(XO_KR); p.VR = WSF(XO_VR); p.G = WSF(XO_G); p.Y = WSF(XO_Y); \
        p.CDEC = WSF(XO_CDEC); p.BONUS = WSF(XO_BONUS); p.DECAY = WSF(ZO_DECAY); p.A = WSF(ZO_A); p.KK = WSF(ZO_KK); p.O = WSF(ZO_O); \
        p.LW = WSB(XO_LW); p.LA = WSB(XO_LA); p.LG = WSB(XO_LG); p.GATE = WSB(XO_GATE); \
        p.QDEC = WSB(XO_QDEC); p.KDEC = WSB(XO_KDEC); p.K2T = WSB(XO_K2T); p.VT = WSB(XO_VT); \
        p.W2T = WSB(XO_W2T); p.A2T = WSB(XO_A2T); p.G2T = WSB(XO_G2T); \
        p.CST = WSB(ZO_CST); p.SPT = WSB(ZO_SPT); p.P = WSB(ZO_P); p.CAT = WSB(OFF_ACT);

    rms_phase<1>(nullptr, WSF(OFF_H), prm.in[0], prm.in[1], prm.in[25], WSB(OFF_HN), nullptr);
    convert_wt(prm.in[2], WSB(XO_WB), D, NAB, NAB, nullptr, lds);
    convert_wt(prm.in[15], WSB(XO_W2T), 64, 1024, 1024, nullptr, lds);
    convert_wt(prm.in[17], WSB(XO_A2T), 64, 1024, 1024, nullptr, lds);
    convert_wt(prm.in[18], WSB(XO_G2T), 128, 1024, 1024, nullptr, lds);
    SYNC0();
    gemm_full(lds, WSB(OFF_HN), WSB(XO_WB), NAB, D, EpStoreBf16{WSB(OFF_Z), NAB});
    convert_steal(prm.in[8], WSB(XO_WC), D, D, D, nullptr, CTR(0), lds);
    convert_steal(prm.in[27], WSB(OFF_W), D, NUP, NUP, prm.in[26], CTR(1), lds);
    SYNC();
    mixer_ab_phase(WSB(OFF_Z), prm.in[3], prm.in[4], prm.in[5], prm.in[6], prm.in[7], WSB(OFF_ACT), lds);
    SYNC();
    gemm_full(lds, WSB(OFF_ACT), WSB(XO_WC), D, D, EpResid{WSF(OFF_H), WSB(OFF_HN), SSQ(0)});
    SYNC();
    gemm_full(lds, WSB(OFF_HN), WSB(OFF_W), NUP, D, EpScaleStoreBf16{WSB(OFF_Z), NUP, SSQ(0)});
    convert_steal(prm.in[29], WSB(XO_WC), DFF, D, D, nullptr, CTR(2), lds);
    convert_steal(prm.in[9], WSB(XO_WB), D, NCD, NCDP, prm.in[25] + D, CTR(3), lds);
    SYNC();
    ffn_gate_phase(WSB(OFF_Z), prm.in[28], WSB(OFF_ACT));
    SYNC();
    gemm_full(lds, WSB(OFF_ACT), WSB(XO_WC), D, DFF, EpResid{WSF(OFF_H), WSB(OFF_HN), SSQ(1)});
    SYNC();
    gemm_full(lds, WSB(OFF_HN), WSB(XO_WB), NCDP, D, EpScaleStoreF32{WSF(OFF_Z), NCDP, SSQ(1)});
    convert_steal(prm.in[24], WSB(XO_WC), D, D, D, nullptr, CTR(4), lds);
    convert_steal(prm.in[27] + (size_t)D * NUP, WSB(OFF_W), D, NUP, NUP, prm.in[26] + D, CTR(5), lds);
    SYNC();
    { MKCD(p) prep1_phase(p, lds); }
    SYNC();
    { MKCD(p) small_gemm_phase(p); }
    SYNC();
    { MKCD(p) prep2_phase(p); }
    SYNC();
    { MKCD(p) gla_out_phase(p); }
    { MKCD(p) rwkv_scan_phase(p, lds); }
    SYNC();
    { MKCD(p) post_phase(p); }
    SYNC();
    gemm_full(lds, WSB(OFF_ACT), WSB(XO_WC), D, D, EpResid{WSF(OFF_H), WSB(OFF_HN), SSQ(2)});
    SYNC();
    gemm_full(lds, WSB(OFF_HN), WSB(OFF_W), NUP, D, EpScaleStoreBf16{WSB(OFF_Z), NUP, SSQ(2)});
    convert_steal(prm.in[29] + (size_t)DFF * D, WSB(XO_WC), DFF, D, D, nullptr, CTR(6), lds);
    SYNC();
    ffn_gate_phase(WSB(OFF_Z), prm.in[28] + (size_t)3 * NUP, WSB(OFF_ACT));
    SYNC();
    gemm_full(lds, WSB(OFF_ACT), WSB(XO_WC), D, DFF, EpAddF32{WSF(OFF_H), D});
    SYNC();
    rms_phase<2>(WSF(OFF_H), nullptr, nullptr, nullptr, prm.in[30], nullptr, prm.out);
}

extern "C" void kernel_launch(void* const* d_in, const int* in_sizes, int n_in, void* d_out, int out_size, void* d_ws, size_t ws_size, hipStream_t stream) {
    static int grid_blocks = 0;
    if (!grid_blocks) {
        if (n_in != 31 || ws_size < WS_END) { fprintf(stderr, "kernel_launch: expected 31 inputs and >= %zu bytes of workspace (got %d, %zu)\n", (size_t)WS_END, n_in, ws_size); grid_blocks = -1; return; }
        int dev = 0, cus = 0, per_cu = 0;
        hipGetDevice(&dev);
        hipDeviceGetAttribute(&cus, hipDeviceAttributeMultiprocessorCount, dev);
        hipFuncSetAttribute((const void*)fwd_megakernel, hipFuncAttributeMaxDynamicSharedMemorySize, LDS_BYTES);
        hipOccupancyMaxActiveBlocksPerMultiprocessor(&per_cu, (const void*)fwd_megakernel, NTHREADS, LDS_BYTES);
        if (per_cu < 1) per_cu = 1;
        if (per_cu > 1) per_cu = 1;
        (void)hipGetLastError();
        grid_blocks = cus * per_cu;
    }
    if (grid_blocks < 0) return;
    Params p{};
    for (int i = 0; i < 31; ++i) p.in[i] = (const float*)d_in[i];
    p.out = (float*)d_out; p.ws = (unsigned char*)d_ws;
    void* args[] = {&p};
    hipError_t e = hipLaunchCooperativeKernel((const void*)fwd_megakernel, dim3(grid_blocks), dim3(NTHREADS), args, LDS_BYTES, stream);
    if (e != hipSuccess) fprintf(stderr, "cooperative launch failed: %s (grid %d)\n", hipGetErrorString(e), grid_blocks);
}
```

```cpp
#include <hip/hip_runtime.h>
#include <hip/hip_cooperative_groups.h>
#include <cstdio>
namespace cg = cooperative_groups;

#define LAS __attribute__((address_space(3)))
typedef unsigned short bf16_t;
typedef short bf16x8 __attribute__((ext_vector_type(8)));
typedef float f32x4 __attribute__((ext_vector_type(4)));
typedef float f32x2 __attribute__((ext_vector_type(2)));
typedef unsigned u32x4 __attribute__((ext_vector_type(4)));
typedef unsigned u32x2 __attribute__((ext_vector_type(2)));

constexpr int D = 2048, L = 2064, NBATCH = 4, SEQ = 2048, NMETA = 16, M = NBATCH * L  , MBIG = 8192;
constexpr int DFF = 5632, NUP = 2 * DFF, NAB = 5120, NCD = 6416, NCDP = 6656;
constexpr int NCH = 33;
constexpr int NGI = NBATCH * 4 * NCH;
constexpr int LDS_ST_OFF = 139264;
constexpr int LDS_BYTES = LDS_ST_OFF + 16;
constexpr int NTHREADS = 512;

constexpr size_t al256(size_t x) { return (x + 255) & ~(size_t)255; }
constexpr size_t OFF_H = 0;
constexpr size_t OFF_W = OFF_H + al256((size_t)M * D * 4);
constexpr size_t OFF_HN = OFF_W + al256((size_t)NUP * D * 2);
constexpr size_t OFF_Z = OFF_HN + al256((size_t)M * D * 2);
constexpr size_t OFF_ACT = OFF_Z + al256((size_t)M * NCDP * 4);
constexpr size_t OFF_X = OFF_ACT + al256((size_t)M * DFF * 2);
constexpr size_t SZ_M1024F = al256((size_t)M * 1024 * 4);
constexpr size_t XO_R = OFF_X;
constexpr size_t XO_KR = XO_R + SZ_M1024F;
constexpr size_t XO_VR = XO_KR + SZ_M1024F;
constexpr size_t XO_G = XO_VR + SZ_M1024F;
constexpr size_t XO_Y = OFF_HN;
constexpr size_t XO_LW = XO_G + SZ_M1024F;
constexpr size_t XO_LA = XO_LW + al256((size_t)M * 64 * 2);
constexpr size_t XO_LG = XO_LA + al256((size_t)M * 64 * 2);
constexpr size_t XO_GATE = XO_LG + al256((size_t)M * 128 * 2);
constexpr size_t XO_QDEC = XO_GATE + al256((size_t)M * 1024 * 2);
constexpr size_t XO_KDEC = XO_QDEC + al256((size_t)NGI * 64 * 128 * 2);
constexpr size_t XO_K2T = XO_KDEC + al256((size_t)NGI * 64 * 128 * 2);
constexpr size_t XO_VT = XO_K2T + al256((size_t)NGI * 64 * 128 * 2);
constexpr size_t XO_CDEC = XO_VT + al256((size_t)NGI * 256 * 64 * 2);
constexpr size_t XO_BONUS = XO_CDEC + al256((size_t)NGI * 128 * 4);
constexpr size_t XO_W2T = XO_BONUS + al256((size_t)M * 16 * 4);
constexpr size_t XO_A2T = XO_W2T + al256((size_t)1024 * 64 * 2);
constexpr size_t XO_G2T = XO_A2T + al256((size_t)1024 * 64 * 2);
constexpr size_t XO_BAR = XO_G2T + al256((size_t)1024 * 128 * 2);
constexpr int BAR_WORDS = 3456 + 64;
constexpr size_t XO_SS = XO_BAR + al256((size_t)BAR_WORDS * 4);
constexpr size_t XO_WB = XO_SS + al256((size_t)3 * M * 4);
constexpr size_t XO_WC = XO_WB + al256((size_t)NCDP * D * 2);
constexpr size_t WS_END = XO_WC + al256((size_t)D * DFF * 2);
constexpr size_t ZO_DECAY = OFF_Z;
constexpr size_t ZO_A = ZO_DECAY + SZ_M1024F;
constexpr size_t ZO_KK = ZO_A + SZ_M1024F;
constexpr size_t ZO_O = ZO_KK + SZ_M1024F;
constexpr size_t ZO_CST = ZO_O + SZ_M1024F;
constexpr size_t ZO_SPT = ZO_CST + al256((size_t)NGI * 256 * 128 * 2);
constexpr size_t ZO_P = ZO_SPT + al256((size_t)NGI * 256 * 128 * 2);
constexpr size_t ZO_END = ZO_P + al256((size_t)NGI * 64 * 64 * 2);
constexpr size_t ZO_PSI = ZO_END;
constexpr size_t ZO_PHI = ZO_PSI + al256((size_t)256 * 4096 * 4);
static_assert(ZO_PHI + al256((size_t)256 * 4096 * 4) <= OFF_ACT, "Z sub-regions overflow");
static_assert(SZ_M1024F <= (size_t)M * D * 2 + 256, "Y must fit in HN");

__device__ __forceinline__ float bf2f(unsigned b) { return __uint_as_float(b << 16); }
__device__ __forceinline__ unsigned f2bf(float f) { unsigned u = __float_as_uint(f); u += 0x7FFFu + ((u >> 16) & 1u); return u >> 16; }
typedef __bf16 bf16x2_t __attribute__((ext_vector_type(2)));
__device__ __forceinline__ unsigned pk2(float lo, float hi) { const f32x2 v = (f32x2){lo, hi}; const bf16x2_t b = __builtin_convertvector(v, bf16x2_t); return __builtin_bit_cast(unsigned, b); }
__device__ __forceinline__ float lo_f(unsigned w) { return __uint_as_float(w << 16); }
__device__ __forceinline__ float hi_f(unsigned w) { return __uint_as_float(w & 0xffff0000u); }
__device__ __forceinline__ float sigm(float x) { return 1.0f / (1.0f + expf(-x)); }
__device__ __forceinline__ float silu(float x) { return x * sigm(x); }
__device__ __forceinline__ float fsigm(float x) { return __builtin_amdgcn_rcpf(1.0f + __builtin_amdgcn_exp2f(x * -1.4426950408889634f)); }
__device__ __forceinline__ float fsilu(float x) { return x * fsigm(x); }
__device__ __forceinline__ float logsig(float x) { return fminf(x, 0.f) - log1pf(expf(-fabsf(x))); }
__device__ __forceinline__ float wave_sum(float v) {
#pragma unroll
    for (int o = 32; o >= 1; o >>= 1) v += __shfl_xor(v, o);
    return v;
}
__device__ __forceinline__ float sum16(float v) {
#pragma unroll
    for (int o = 8; o >= 1; o >>= 1) v += __shfl_xor(v, o);
    return v;
}
__device__ __forceinline__ float quad_sum(float x) {
    x += __int_as_float(__builtin_amdgcn_update_dpp(0, __float_as_int(x), 0xB1, 0xF, 0xF, false));
    x += __int_as_float(__builtin_amdgcn_update_dpp(0, __float_as_int(x), 0x4E, 0xF, 0xF, false));
    return x;
}


#define XB_TMO      128
#define XB_XCNT(j)  (256  + 64 * (j))
#define XB_XSUB(j)  (1280 + 64 * (j))
#define XB_XGEN(j)  (2304 + 64 * (j))
#define XB_TOP      3328
#define XB_TOPGEN   3392
#define XCD_BAR_WORDS 3456
#define XB_SPIN_CAP (1u << 20)
__device__ __forceinline__ unsigned xb_ld(unsigned* p)              { return __hip_atomic_load(p, __ATOMIC_RELAXED, __HIP_MEMORY_SCOPE_AGENT); }
__device__ __forceinline__ unsigned xb_add(unsigned* p, unsigned v) { return __hip_atomic_fetch_add(p, v, __ATOMIC_RELAXED, __HIP_MEMORY_SCOPE_AGENT); }
__device__ __forceinline__ unsigned xb_xcc_id() { return (unsigned)__builtin_amdgcn_s_getreg((3 << 11) | 20) & 0xFu; }
#define XB_SPIN(cond, bar) do { unsigned _sp = 0; while (cond) { __builtin_amdgcn_s_sleep(1); \
    if ((++_sp & 255u) == 0u) { if (xb_ld(&(bar)[XB_TMO])) break; if (_sp > XB_SPIN_CAP) { atomicAdd(&(bar)[XB_TMO], 1u); break; } } } } while (0)
struct XcdBarrier { unsigned* bar; unsigned x; volatile LAS unsigned* st; };
__device__ __forceinline__ XcdBarrier xcd_barrier_post(unsigned* bar, volatile LAS unsigned* st) {
    XcdBarrier b; b.bar = bar; b.x = xb_xcc_id(); b.st = st;
    if (threadIdx.x == 0) (void)xb_add(&bar[XB_XCNT(b.x)], 1u);
    return b;
}
__device__ __forceinline__ void xcd_barrier_complete(unsigned* bar, unsigned x, unsigned& nloc, unsigned& nx) {
    const unsigned G = gridDim.x * gridDim.y * gridDim.z;
    unsigned sum, cnt, mine, sp = 0u;
    for (;;) {
        sum = 0u; cnt = 0u; mine = 0u;
#pragma unroll
        for (unsigned j = 0; j < 16; ++j) { const unsigned c = xb_ld(&bar[XB_XCNT(j)]); sum += c; cnt += (c > 0u) ? 1u : 0u; mine = (j == x) ? c : mine; }
        if (sum == G) break;
        __builtin_amdgcn_s_sleep(1);
        if ((++sp & 255u) == 0u) { if (xb_ld(&bar[XB_TMO])) break; if (sp > XB_SPIN_CAP) { atomicAdd(&bar[XB_TMO], 1u); break; } }
    }
    nloc = mine > 0u ? mine : 1u; nx = cnt > 0u ? cnt : 1u;
}
__device__ __forceinline__ void xcd_barrier(const XcdBarrier& b) {
    asm volatile("s_waitcnt vmcnt(0)" ::: "memory");
    __syncthreads();
    if (threadIdx.x == 0) {
        unsigned* bar = b.bar;
        __builtin_amdgcn_s_waitcnt(0);
        unsigned nloc = b.st[0], nx = b.st[1];
        if (nloc == 0u) { xcd_barrier_complete(bar, b.x, nloc, nx); b.st[0] = nloc; b.st[1] = nx; }
        const unsigned old = xb_add(&bar[XB_XSUB(b.x)], 1u);
        const unsigned gen = old / nloc;
        if (old + 1u == (gen + 1u) * nloc) {
            __builtin_amdgcn_fence(__ATOMIC_RELEASE, "agent");
            asm volatile("s_waitcnt vmcnt(0)" ::: "memory");
            const unsigned og = xb_add(&bar[XB_TOP], 1u);
            const unsigned tg = og / nx;
            if (og + 1u == (tg + 1u) * nx) xb_add(&bar[XB_TOPGEN], 1u);
            else XB_SPIN(xb_ld(&bar[XB_TOPGEN]) == tg, bar);
            __builtin_amdgcn_fence(__ATOMIC_ACQUIRE, "agent");
            xb_add(&bar[XB_XGEN(b.x)], 1u);
            asm volatile("s_waitcnt vmcnt(0)" ::: "memory");
        } else {
            XB_SPIN(xb_ld(&bar[XB_XGEN(b.x)]) == gen, bar);
            __builtin_amdgcn_fence(__ATOMIC_ACQUIRE, "agent");
            asm volatile("s_waitcnt vmcnt(0)" ::: "memory");
        }
    }
    __syncthreads();
}

namespace pg8 {
constexpr int BM = 256, BK = 64, HALF = 128, HTB = HALF * BK * 2, NXCD = 8, WGM = 4;
__device__ __forceinline__ int lds_byte(int r, int c) { const int st = (r >> 4) * 2 + (c >> 5), rr = r & 15, cc = c & 31, ob = rr * 64 + cc * 2; return st * 1024 + (ob ^ (((ob >> 9) & 1) << 5)); }
__device__ __forceinline__ void stage_rc(int b, int& R, int& C) { const int st = b / 1024, sb = b % 1024, swz = sb ^ (((sb >> 9) & 1) << 5); R = (st >> 1) * 16 + swz / 64; C = (st & 1) * 32 + (swz % 64) / 2; }
struct Unit { int pm, pn; };
struct StaticOrder {
    int nM, nN, nwg, G, c;
    __device__ void init(int Mr, int N, int G_, int c_) { nM = Mr / BM; nN = N / BM; nwg = nM * nN; G = G_; c = c_; }
    __device__ bool next(int i, Unit& u) const {
        const long Lx = (long)i * G + c; if (Lx >= nwg) return false;
        int wgid = (int)Lx; { const int q = nwg / NXCD, r = nwg % NXCD, xcd = wgid % NXCD, off = wgid / NXCD; wgid = (xcd < r ? xcd * (q + 1) : r * (q + 1) + (xcd - r) * q) + off; }
        const int nig = WGM * nN, gid = wgid / nig, fm = gid * WGM, gsz = (nM - fm) < WGM ? (nM - fm) : WGM;
        u.pm = fm + ((wgid % nig) % gsz); u.pn = (wgid % nig) / gsz; return true;
    }
};
template <class F>
__device__ __forceinline__ void gemm_phase(LAS unsigned char* lds, const bf16_t* gA, const bf16_t* gBt, const int K, const StaticOrder& S, const F& f) {
    int tid = threadIdx.x; asm volatile("" : "+v"(tid));
    const int wid = __builtin_amdgcn_readfirstlane(tid >> 6), lane = tid & 63, wr = wid >> 2, wc = wid & 3, fr = lane & 15, fq = lane >> 4;
    const int nt = K / BK;
    unsigned voffA[2];
#pragma unroll
    for (int i = 0; i < 2; ++i) { int R, C; stage_rc(tid * 16 + i * 8192, R, C); voffA[i] = (unsigned)(R * K + C) * 2u; }
    const size_t kstep = (size_t)(BK * 2);
    const size_t hstep = (size_t)HALF * K * 2;
    const size_t tstep = 2 * hstep;
    const unsigned ldsw = (unsigned)wid * 1024u;
    const int aoff = lds_byte(wr * 64 + fr, fq * 8), boff = lds_byte(wc * 32 + fr, fq * 8);
#define PG8_SA(b, h) (((b) * 2 + (h)) * HTB)
#define PG8_SB(b, h) ((4 + (b) * 2 + (h)) * HTB)
#define PG8_STAGE(bufoff, gbase, voff) do { _Pragma("unroll") for (int _i = 0; _i < 2; ++_i) \
        __builtin_amdgcn_global_load_lds((const unsigned*)((const char*)(gbase) + (voff)[_i]), (LAS unsigned*)(lds + (bufoff) + ldsw + _i * 8192), 16, 0, 0); } while (0)
#define PG8_LDA(dst, b, h) do { _Pragma("unroll") for (int m = 0; m < 4; ++m) _Pragma("unroll") for (int k = 0; k < 2; ++k) dst[m][k] = *(const LAS bf16x8*)(lds + PG8_SA(b, h) + aoff + m * 2048 + k * 1024); } while (0)
#define PG8_LDB(dst, b, h) do { _Pragma("unroll") for (int n = 0; n < 2; ++n) _Pragma("unroll") for (int k = 0; k < 2; ++k) dst[n][k] = *(const LAS bf16x8*)(lds + PG8_SB(b, h) + boff + n * 2048 + k * 1024); } while (0)
#define PG8_MMA(ai, bj, At, Bt) do { __builtin_amdgcn_s_setprio(1); _Pragma("unroll") for (int m = 0; m < 4; ++m) _Pragma("unroll") for (int n = 0; n < 2; ++n) _Pragma("unroll") for (int k = 0; k < 2; ++k) \
        acc[ai][bj][m][n] = __builtin_amdgcn_mfma_f32_16x16x32_bf16(Bt[n][k], At[m][k], acc[ai][bj][m][n], 0, 0, 0); __builtin_amdgcn_s_setprio(0); } while (0)
#define PG8_WAIT_V(n) asm volatile("s_waitcnt vmcnt(" #n ")" ::: "memory")
#define PG8_WAIT_L(n) asm volatile("s_waitcnt lgkmcnt(" #n ")" ::: "memory")
#define PG8_BAR __builtin_amdgcn_s_barrier()
#define PG8_SCHED __builtin_amdgcn_sched_barrier(0)
    Unit cur, nxt; int ui = 0;
    if (!S.next(0, cur)) return;
    f32x4 acc[2][2][4][2];
#pragma unroll
    for (int a = 0; a < 2; ++a)
#pragma unroll
        for (int b = 0; b < 2; ++b)
#pragma unroll
            for (int m = 0; m < 4; ++m)
#pragma unroll
                for (int n = 0; n < 2; ++n) acc[a][b][m][n] = (f32x4){0.f, 0.f, 0.f, 0.f};
    bf16x8 At[4][2], B0[2][2], B1[2][2];
    const char* cA = (const char*)gA + (size_t)cur.pm * tstep; const char* cB = (const char*)gBt + (size_t)cur.pn * tstep;
    PG8_STAGE(PG8_SB(0, 0), cB, voffA); PG8_STAGE(PG8_SA(0, 0), cA, voffA); PG8_STAGE(PG8_SB(0, 1), cB + hstep, voffA); PG8_STAGE(PG8_SA(0, 1), cA + hstep, voffA);
    if (wr == 1) PG8_BAR;
    PG8_WAIT_V(4); PG8_BAR;
    PG8_STAGE(PG8_SB(1, 0), cB + kstep, voffA); PG8_STAGE(PG8_SA(1, 0), cA + kstep, voffA); PG8_STAGE(PG8_SB(1, 1), cB + hstep + kstep, voffA);
    PG8_WAIT_V(6); PG8_BAR;
    for (;;) {
        const bool has_next = S.next(ui + 1, nxt);
        const char* nA = has_next ? (const char*)gA + (size_t)nxt.pm * tstep : cA; const char* nB = has_next ? (const char*)gBt + (size_t)nxt.pn * tstep : cB;
        for (int t = 0; t < nt; t += 2) {
            const bool last = (t == nt - 2);
            const char* a1 = cA + (size_t)(t + 1) * kstep;
            const char* a2 = last ? nA : cA + (size_t)(t + 2) * kstep; const char* b2 = last ? nB : cB + (size_t)(t + 2) * kstep;
            const char* a3 = a2 + kstep; const char* b3 = b2 + kstep;
            PG8_LDB(B0, 0, 0); PG8_SCHED; PG8_LDA(At, 0, 0); PG8_STAGE(PG8_SA(1, 1), a1 + hstep, voffA);
            PG8_WAIT_L(8); PG8_BAR; PG8_WAIT_L(0); PG8_MMA(0, 0, At, B0); PG8_BAR; PG8_SCHED;
            PG8_LDB(B1, 0, 1); PG8_STAGE(PG8_SB(0, 0), b2, voffA);
            PG8_BAR; PG8_WAIT_L(0); PG8_MMA(0, 1, At, B1); PG8_BAR;
            PG8_LDA(At, 0, 1); PG8_STAGE(PG8_SA(0, 0), a2, voffA);
            PG8_BAR; PG8_WAIT_L(0); PG8_MMA(1, 0, At, B0); PG8_BAR; PG8_SCHED;
            PG8_STAGE(PG8_SB(0, 1), b2 + hstep, voffA);
            PG8_WAIT_V(6); PG8_BAR; PG8_MMA(1, 1, At, B1); PG8_BAR;
            PG8_LDB(B0, 1, 0); PG8_SCHED; PG8_LDA(At, 1, 0); PG8_STAGE(PG8_SA(0, 1), a2 + hstep, voffA);
            PG8_WAIT_L(8); PG8_BAR; PG8_WAIT_L(0); PG8_MMA(0, 0, At, B0); PG8_BAR; PG8_SCHED;
            PG8_LDB(B1, 1, 1); PG8_STAGE(PG8_SB(1, 0), b3, voffA);
            PG8_BAR; PG8_WAIT_L(0); PG8_MMA(0, 1, At, B1); PG8_BAR;
            PG8_LDA(At, 1, 1); PG8_STAGE(PG8_SA(1, 0), a3, voffA);
            PG8_BAR; PG8_WAIT_L(0); PG8_MMA(1, 0, At, B0); PG8_BAR; PG8_SCHED;
            PG8_STAGE(PG8_SB(1, 1), b3 + hstep, voffA);
            PG8_WAIT_V(6); PG8_BAR; PG8_MMA(1, 1, At, B1); PG8_BAR;
        }
        if constexpr (F::GATE) { f.tile(acc, cur.pm, cur.pn, wr, wc, fr, fq); }
        else {
            const int row0 = cur.pm * BM + wr * 64 + fr, col0 = cur.pn * BM + wc * 32 + 4 * fq;
            float sc[2][4];
#pragma unroll
            for (int ai = 0; ai < 2; ++ai)
#pragma unroll
                for (int m = 0; m < 4; ++m) sc[ai][m] = f.begin(row0 + ai * HALF + m * 16);
#pragma unroll
            for (int ai = 0; ai < 2; ++ai) {
                f32x4 hv[4][2][2];
#pragma unroll
                for (int m = 0; m < 4; ++m)
#pragma unroll
                    for (int bj = 0; bj < 2; ++bj)
#pragma unroll
                        for (int n = 0; n < 2; ++n) hv[m][bj][n] = f.pre(row0 + ai * HALF + m * 16, col0 + bj * HALF + n * 16);
#pragma unroll
                for (int m = 0; m < 4; ++m) {
                    const int row = row0 + ai * HALF + m * 16;
                    float ssq = 0.f;
#pragma unroll
                    for (int bj = 0; bj < 2; ++bj)
#pragma unroll
                        for (int n = 0; n < 2; ++n) ssq += f(row, col0 + bj * HALF + n * 16, acc[ai][bj][m][n], hv[m][bj][n], sc[ai][m]);
                    f.end(row, ssq, 0);
                }
            }
        }
        if (!has_next) break;
#pragma unroll
        for (int a = 0; a < 2; ++a)
#pragma unroll
            for (int b = 0; b < 2; ++b)
#pragma unroll
                for (int m = 0; m < 4; ++m)
#pragma unroll
                    for (int n = 0; n < 2; ++n) acc[a][b][m][n] = (f32x4){0.f, 0.f, 0.f, 0.f};
        cur = nxt; cA = nA; cB = nB; ++ui;
    }
    PG8_WAIT_V(0);
    if (wr == 0) PG8_BAR;
    PG8_BAR;
#undef PG8_SA
#undef PG8_SB
#undef PG8_STAGE
#undef PG8_LDA
#undef PG8_LDB
#undef PG8_MMA
#undef PG8_WAIT_V
#undef PG8_WAIT_L
#undef PG8_BAR
#undef PG8_SCHED
}
}

template <int UNR>
__device__ __forceinline__ void wave_tile_mma(const bf16_t* __restrict__ A, int lda, const bf16_t* __restrict__ Bt, int ldb, int k0, int k1, f32x4 (&acc)[4][4], int fr, int fq) {
    const bf16_t* ap = A + (size_t)fr * lda + fq * 8;
    const bf16_t* bp = Bt + (size_t)fr * ldb + fq * 8;
    int k = k0;
#pragma unroll 1
    for (; k + 32 * UNR <= k1; k += 32 * UNR) {
        bf16x8 a[UNR][4], b[UNR][4];
#pragma unroll
        for (int u = 0; u < UNR; ++u)
#pragma unroll
            for (int i = 0; i < 4; ++i) { a[u][i] = *(const bf16x8*)(ap + (size_t)i * 16 * lda + k + 32 * u); b[u][i] = *(const bf16x8*)(bp + (size_t)i * 16 * ldb + k + 32 * u); }
#pragma unroll
        for (int u = 0; u < UNR; ++u)
#pragma unroll
            for (int mi = 0; mi < 4; ++mi)
#pragma unroll
                for (int ni = 0; ni < 4; ++ni) acc[mi][ni] = __builtin_amdgcn_mfma_f32_16x16x32_bf16(b[u][ni], a[u][mi], acc[mi][ni], 0, 0, 0);
    }
#pragma unroll 1
    for (; k < k1; k += 32) {
        bf16x8 a[4], b[4];
#pragma unroll
        for (int i = 0; i < 4; ++i) { a[i] = *(const bf16x8*)(ap + (size_t)i * 16 * lda + k); b[i] = *(const bf16x8*)(bp + (size_t)i * 16 * ldb + k); }
#pragma unroll
        for (int mi = 0; mi < 4; ++mi)
#pragma unroll
            for (int ni = 0; ni < 4; ++ni) acc[mi][ni] = __builtin_amdgcn_mfma_f32_16x16x32_bf16(b[ni], a[mi], acc[mi][ni], 0, 0, 0);
    }
}
__device__ __forceinline__ void zero_acc(f32x4 (&acc)[4][4]) {
#pragma unroll
    for (int i = 0; i < 4; ++i)
#pragma unroll
        for (int j = 0; j < 4; ++j) acc[i][j] = (f32x4){0.f, 0.f, 0.f, 0.f};
}

template <class F>
__device__ __forceinline__ void gemm_rem_phase(LAS unsigned char* lds, const bf16_t* A, const bf16_t* Bt, int N, int K, const F& f) {
    const int tid = threadIdx.x, wid = __builtin_amdgcn_readfirstlane(tid >> 6), lane = tid & 63, fr = lane & 15, fq = lane >> 4;
    const int ntiles = N / 64, kw = K / 8;
    for (int tile = (int)gridDim.x - 1 - (int)blockIdx.x; tile < ntiles; tile += gridDim.x) {
        const int n0 = tile * 64;
        f32x4 acc[4][4]; zero_acc(acc);
        wave_tile_mma<4>(A + (size_t)MBIG * K, K, Bt + (size_t)n0 * K, K, wid * kw, (wid + 1) * kw, acc, fr, fq);
        LAS float* P = (LAS float*)lds + wid * 4096;
#pragma unroll
        for (int mi = 0; mi < 4; ++mi)
#pragma unroll
            for (int ni = 0; ni < 4; ++ni) *(LAS f32x4*)(P + ((mi * 4 + ni) * 64 + lane) * 4) = acc[mi][ni];
        __syncthreads();
#pragma unroll
        for (int i = 0; i < 2; ++i) {
            const int fg = wid + 8 * i, r = (fg >> 2) * 16 + fr, c4 = (fg & 3) * 16 + fq * 4;
            f32x4 s = (f32x4){0.f, 0.f, 0.f, 0.f};
#pragma unroll
            for (int w = 0; w < 8; ++w) s += *(const LAS f32x4*)((LAS float*)lds + w * 4096 + (fg * 64 + lane) * 4);
            const float sc = f.begin(MBIG + r);
            const f32x4 hv = f.pre(MBIG + r, n0 + c4);
            const float ssq = f(MBIG + r, n0 + c4, s, hv, sc);
            f.end(MBIG + r, ssq, 0);
        }
        __syncthreads();
    }
}

__device__ __forceinline__ float rstd_of(const float* SS, int row) { return rsqrtf(SS[row] * (1.0f / D) + 1e-6f); }
struct EpStoreBf16 { static constexpr bool GATE = false; bf16_t* O; int ld;
    __device__ __forceinline__ float begin(int) const { return 1.f; }
    __device__ __forceinline__ f32x4 pre(int, int) const { return (f32x4){0.f, 0.f, 0.f, 0.f}; }
    __device__ __forceinline__ float operator()(int row, int col, f32x4 v, f32x4, float) const { if (row < M) { u32x2 w; w.x = pk2(v[0], v[1]); w.y = pk2(v[2], v[3]); *(u32x2*)(O + (size_t)row * ld + col) = w; } return 0.f; }
    __device__ __forceinline__ void end(int, float, int) const {} };
struct EpScaleStoreBf16 { static constexpr bool GATE = false; bf16_t* O; int ld; const float* SS;
    __device__ __forceinline__ float begin(int row) const { return rstd_of(SS, row < M ? row : M - 1); }
    __device__ __forceinline__ f32x4 pre(int, int) const { return (f32x4){0.f, 0.f, 0.f, 0.f}; }
    __device__ __forceinline__ float operator()(int row, int col, f32x4 v, f32x4, float s) const { if (row < M) { v = v * s; u32x2 w; w.x = pk2(v[0], v[1]); w.y = pk2(v[2], v[3]); *(u32x2*)(O + (size_t)row * ld + col) = w; } return 0.f; }
    __device__ __forceinline__ void end(int, float, int) const {} };
struct EpScaleStoreF32 { static constexpr bool GATE = false; float* O; int ld; const float* SS;
    __device__ __forceinline__ float begin(int row) const { return rstd_of(SS, row < M ? row : M - 1); }
    __device__ __forceinline__ f32x4 pre(int, int) const { return (f32x4){0.f, 0.f, 0.f, 0.f}; }
    __device__ __forceinline__ float operator()(int row, int col, f32x4 v, f32x4, float s) const { if (row < M) *(f32x4*)(O + (size_t)row * ld + col) = v * s; return 0.f; }
    __device__ __forceinline__ void end(int, float, int) const {} };
struct EpAddF32 { static constexpr bool GATE = false; float* H; int ld;
    __device__ __forceinline__ float begin(int) const { return 1.f; }
    __device__ __forceinline__ f32x4 pre(int row, int col) const { return *(const f32x4*)(H + (size_t)row * ld + col); }
    __device__ __forceinline__ float operator()(int row, int col, f32x4 v, f32x4 h, float) const { *(f32x4*)(H + (size_t)row * ld + col) = h + v; return 0.f; }
    __device__ __forceinline__ void end(int, float, int) const {} };
struct EpResid { static constexpr bool GATE = false; float* H; bf16_t* HB; float* SS;
    __device__ __forceinline__ float begin(int) const { return 1.f; }
    __device__ __forceinline__ f32x4 pre(int row, int col) const { return *(const f32x4*)(H + (size_t)row * D + col); }
    __device__ __forceinline__ float operator()(int row, int col, f32x4 v, f32x4 h0, float) const {
        const f32x4 h = h0 + v; *(f32x4*)(H + (size_t)row * D + col) = h;
        u32x2 w; w.x = pk2(h[0], h[1]); w.y = pk2(h[2], h[3]); *(u32x2*)(HB + (size_t)row * D + col) = w;
        return (h[0] * h[0] + h[1] * h[1]) + (h[2] * h[2] + h[3] * h[3]); }
    __device__ __forceinline__ void end(int row, float ssq, int kind) const {
        const int lane = threadIdx.x & 63;
        if (kind == 0) { ssq += __shfl_xor(ssq, 16); ssq += __shfl_xor(ssq, 32); if (lane < 16) atomicAdd(SS + row, ssq); }
        else { ssq = sum16(ssq); if ((lane & 15) == 0) atomicAdd(SS + row, ssq); } } };

__device__ __forceinline__ f32x4 dpp_ror(f32x4 v, const int which) {
    f32x4 o;
#pragma unroll
    for (int e = 0; e < 4; ++e) o[e] = which == 1 ? __int_as_float(__builtin_amdgcn_update_dpp(0, __float_as_int(v[e]), 0x121, 0xF, 0xF, false))
                                                  : __int_as_float(__builtin_amdgcn_update_dpp(0, __float_as_int(v[e]), 0x122, 0xF, 0xF, false));
    return o;
}
struct EpGate { static constexpr bool GATE = true; bf16_t* G; bf16_t* U; const float* SS; const float* dw;
    __device__ __forceinline__ float begin(int) const { return 1.f; }
    __device__ __forceinline__ f32x4 pre(int, int) const { return (f32x4){0.f, 0.f, 0.f, 0.f}; }
    __device__ __forceinline__ float operator()(int, int, f32x4, f32x4, float) const { return 0.f; }
    __device__ __forceinline__ void end(int, float, int) const {}
    __device__ __forceinline__ void tile(f32x4 (&acc)[2][2][4][2], int pm, int pn, int wr, int wc, int fr, int fq) const {
        const int rowb = pm * 256 + wr * 64 + fr;
        f32x4 wva[2][3], wga[2][3];
#pragma unroll
        for (int n = 0; n < 2; ++n)
#pragma unroll
            for (int j = 0; j < 3; ++j) { const int chh = pn * 128 + wc * 32 + n * 16 + 4 * fq; wva[n][j] = *(const f32x4*)(dw + j * NUP + chh); wga[n][j] = *(const f32x4*)(dw + j * NUP + DFF + chh); }
#pragma unroll
        for (int ai = 0; ai < 2; ++ai)
#pragma unroll
            for (int m = 0; m < 4; ++m) {
                const int row = rowb + ai * 128 + m * 16;
                const float s = rstd_of(SS, row < M ? row : M - 1);
#pragma unroll
                for (int bj = 0; bj < 2; ++bj)
#pragma unroll
                    for (int n = 0; n < 2; ++n) acc[ai][bj][m][n] = acc[ai][bj][m][n] * s;
            }
#pragma unroll
        for (int n = 0; n < 2; ++n) {
            const int ch = pn * 128 + wc * 32 + n * 16 + 4 * fq;
            const int ucol = pn * 256 + wc * 32 + n * 16 + 4 * fq;
            f32x4 wv[3], wg[3];
#pragma unroll
            for (int j = 0; j < 3; ++j) { wv[j] = wva[n][j]; wg[j] = wga[n][j]; }
#pragma unroll
            for (int ai = 0; ai < 2; ++ai)
#pragma unroll
                for (int m = 0; m < 4; ++m) {
                    const int row = rowb + ai * 128 + m * 16;
                    const f32x4 cv = acc[ai][0][m][n], cg = acc[ai][1][m][n];
                    const f32x4 zv = (f32x4){0.f, 0.f, 0.f, 0.f};
                    const f32x4 pv = m > 0 ? acc[ai][0][m > 0 ? m - 1 : 0][n] : zv, pg = m > 0 ? acc[ai][1][m > 0 ? m - 1 : 0][n] : zv;
                    f32x4 v1 = dpp_ror(fr == 15 ? pv : cv, 1), v2 = dpp_ror(fr >= 14 ? pv : cv, 2);
                    f32x4 g1 = dpp_ror(fr == 15 ? pg : cg, 1), g2 = dpp_ror(fr >= 14 ? pg : cg, 2);
                    const int t = row % L;
                    if (t == 0) { v1 = zv; g1 = zv; }
                    if (t <= 1) { v2 = zv; g2 = zv; }
                    const f32x4 val = v2 * wv[0] + v1 * wv[1] + cv * wv[2], gat = g2 * wg[0] + g1 * wg[1] + cg * wg[2];
                    const bool edge_lo = (m == 0 && fr < 2), edge_hi = (m == 3 && fr >= 14);
                    if (row < M) {
                        if (!edge_lo) {
                            u32x2 w; w.x = pk2(fsilu(gat[0]) * val[0], fsilu(gat[1]) * val[1]); w.y = pk2(fsilu(gat[2]) * val[2], fsilu(gat[3]) * val[3]);
                            *(u32x2*)(G + (size_t)row * DFF + ch) = w;
                        }
                        if (edge_lo || edge_hi) {
                            u32x2 a, b; a.x = pk2(cv[0], cv[1]); a.y = pk2(cv[2], cv[3]); b.x = pk2(cg[0], cg[1]); b.y = pk2(cg[2], cg[3]);
                            *(u32x2*)(U + (size_t)row * NUP + ucol) = a; *(u32x2*)(U + (size_t)row * NUP + ucol + 128) = b;
                        }
                    }
                }
        }
    }
};
__device__ __forceinline__ void gate_fixup_phase(const bf16_t* __restrict__ U, const float* __restrict__ dw, bf16_t* __restrict__ G) {
    const int gtid = blockIdx.x * NTHREADS + threadIdx.x, nth = gridDim.x * NTHREADS;
    constexpr int NC4 = DFF / 4, NBLK = M / 64;
    for (int idx = gtid; idx < NBLK * 2 * NC4; idx += nth) {
        const int c4 = idx % NC4, rr = (idx / NC4) & 1, blk = idx / (2 * NC4);
        const int row = blk * 64 + rr, t = row % L, ch = c4 * 4;
        const int ucol = (ch >> 7) * 256 + (ch & 127);
        f32x4 val = (f32x4){0.f, 0.f, 0.f, 0.f}, gat = val;
#pragma unroll
        for (int j = 0; j < 3; ++j) {
            if (t - 2 + j >= 0) {
                const bf16_t* ur = U + (size_t)(row - 2 + j) * NUP + ucol;
                const u32x2 a = *(const u32x2*)(ur), b = *(const u32x2*)(ur + 128);
                const f32x4 wv = *(const f32x4*)(dw + j * NUP + ch), wg = *(const f32x4*)(dw + j * NUP + DFF + ch);
                val += (f32x4){lo_f(a.x), hi_f(a.x), lo_f(a.y), hi_f(a.y)} * wv; gat += (f32x4){lo_f(b.x), hi_f(b.x), lo_f(b.y), hi_f(b.y)} * wg;
            }
        }
        u32x2 w; w.x = pk2(fsilu(gat[0]) * val[0], fsilu(gat[1]) * val[1]); w.y = pk2(fsilu(gat[2]) * val[2], fsilu(gat[3]) * val[3]);
        *(u32x2*)(G + (size_t)row * DFF + ch) = w;
    }
}

struct EpResid0 { static constexpr bool GATE = false; const float* x; const float* meta; float* H; bf16_t* HB; float* SS;
    __device__ __forceinline__ float begin(int) const { return 1.f; }
    __device__ __forceinline__ f32x4 pre(int row, int col) const { const int b = row / L, t = row - b * L;
        return *(const f32x4*)((t < NMETA ? meta + (size_t)t * D : x + ((size_t)b * SEQ + (t - NMETA)) * D) + col); }
    __device__ __forceinline__ float operator()(int row, int col, f32x4 v, f32x4 h0, float) const {
        const f32x4 h = h0 + v; *(f32x4*)(H + (size_t)row * D + col) = h;
        u32x2 w; w.x = pk2(h[0], h[1]); w.y = pk2(h[2], h[3]); *(u32x2*)(HB + (size_t)row * D + col) = w;
        return (h[0] * h[0] + h[1] * h[1]) + (h[2] * h[2] + h[3] * h[3]); }
    __device__ __forceinline__ void end(int row, float ssq, int kind) const {
        const int lane = threadIdx.x & 63;
        if (kind == 0) { ssq += __shfl_xor(ssq, 16); ssq += __shfl_xor(ssq, 32); if (lane < 16) atomicAdd(SS + row, ssq); }
        else { ssq = sum16(ssq); if ((lane & 15) == 0) atomicAdd(SS + row, ssq); } } };

template <class F>
__device__ __forceinline__ void gemm_full(LAS unsigned char* lds, const bf16_t* A, const bf16_t* Bt, int N, int K, const F& f) {
    pg8::StaticOrder S; S.init(MBIG, N, (int)gridDim.x, (int)blockIdx.x);
    pg8::gemm_phase(lds, A, Bt, K, S, f);
    gemm_rem_phase(lds, A, Bt, N, K, f);
}

__device__ __forceinline__ void convert_item(const float* __restrict__ src, bf16_t* __restrict__ dst, int K, int N, const float* __restrict__ gain, int item, int lane) {
    const int tk = K / 64;
    const int kk0 = (item % tk) * 64 + (lane & 7) * 8, n4 = (item / tk) * 32 + (lane >> 3) * 4;
    f32x4 v[8];
#pragma unroll
    for (int i = 0; i < 8; ++i) v[i] = (n4 < N) ? *(const f32x4*)(src + (size_t)(kk0 + i) * N + n4) : (f32x4){0.f, 0.f, 0.f, 0.f};
    if (gain) {
        const f32x4 g0 = *(const f32x4*)(gain + kk0), g1 = *(const f32x4*)(gain + kk0 + 4);
#pragma unroll
        for (int i = 0; i < 4; ++i) { v[i] = v[i] * g0[i]; v[4 + i] = v[4 + i] * g1[i]; }
    }
#pragma unroll
    for (int e = 0; e < 4; ++e) {
        u32x4 w; w.x = pk2(v[0][e], v[1][e]); w.y = pk2(v[2][e], v[3][e]); w.z = pk2(v[4][e], v[5][e]); w.w = pk2(v[6][e], v[7][e]);
        *(u32x4*)(dst + (size_t)(n4 + e) * K + kk0) = w;
    }
}
__device__ __forceinline__ void convert_wt(const float* __restrict__ src, bf16_t* __restrict__ dst, int K, int N, int Npad, const float* __restrict__ gain, LAS unsigned char* lds) {
    const int nitems = (K / 64) * (Npad / 32), lane = threadIdx.x & 63;
    for (int it = blockIdx.x * 8 + (threadIdx.x >> 6); it < nitems; it += gridDim.x * 8) convert_item(src, dst, K, N, gain, it, lane);
}
__device__ __forceinline__ int up_src_col(int n) { return ((n & 128) ? DFF : 0) + ((n >> 8) << 7) + (n & 127); }
template <bool PERMUP>
__device__ __forceinline__ void convert_item2(const float* __restrict__ src, bf16_t* __restrict__ dst, int K, int N, const float* __restrict__ gain, int itemA, int itemB, bool hasB, int lane) {
    const int tk = K / 64;
    int kk0[2], n4[2];
    kk0[0] = (itemA % tk) * 64 + (lane & 7) * 8; n4[0] = (itemA / tk) * 32 + (lane >> 3) * 4;
    const int ib = hasB ? itemB : itemA;
    kk0[1] = (ib % tk) * 64 + (lane & 7) * 8; n4[1] = (ib / tk) * 32 + (lane >> 3) * 4;
    f32x4 v[2][8];
#pragma unroll
    for (int u = 0; u < 2; ++u)
#pragma unroll
        for (int i = 0; i < 8; ++i) v[u][i] = (n4[u] < N) ? *(const f32x4*)(src + (size_t)(kk0[u] + i) * N + (PERMUP ? up_src_col(n4[u]) : n4[u])) : (f32x4){0.f, 0.f, 0.f, 0.f};
#pragma unroll
    for (int u = 0; u < 2; ++u) {
        if (u == 1 && !hasB) break;
        if (gain) {
            const f32x4 g0 = *(const f32x4*)(gain + kk0[u]), g1 = *(const f32x4*)(gain + kk0[u] + 4);
#pragma unroll
            for (int i = 0; i < 4; ++i) { v[u][i] = v[u][i] * g0[i]; v[u][4 + i] = v[u][4 + i] * g1[i]; }
        }
#pragma unroll
        for (int e = 0; e < 4; ++e) {
            u32x4 w; w.x = pk2(v[u][0][e], v[u][1][e]); w.y = pk2(v[u][2][e], v[u][3][e]); w.z = pk2(v[u][4][e], v[u][5][e]); w.w = pk2(v[u][6][e], v[u][7][e]);
            *(u32x4*)(dst + (size_t)(n4[u] + e) * K + kk0[u]) = w;
        }
    }
}
template <bool PERMUP = false>
__device__ __forceinline__ void convert_steal(const float* __restrict__ src, bf16_t* __restrict__ dst, int K, int N, int Npad, const float* __restrict__ gain, unsigned* ctr, LAS unsigned char* lds) {
    const int nitems = (K / 64) * (Npad / 32), lane = threadIdx.x & 63, wid = threadIdx.x >> 6;
    volatile LAS unsigned* slot = (volatile LAS unsigned*)(lds + LDS_ST_OFF + 8);
    if (threadIdx.x == 0) *slot = __hip_atomic_fetch_add(ctr, 64u, __ATOMIC_RELAXED, __HIP_MEMORY_SCOPE_AGENT);
    __syncthreads();
    int t0 = (int)*slot;
    __syncthreads();
    while (t0 < nitems) {
        unsigned nxt = 0u;
        if (threadIdx.x == 0) nxt = __hip_atomic_fetch_add(ctr, 64u, __ATOMIC_RELAXED, __HIP_MEMORY_SCOPE_AGENT);
#pragma unroll 1
        for (int q = 0; q < 8; q += 2) {
            const int ia = t0 + wid + 8 * q, ib = ia + 8;
            if (ia < nitems) convert_item2<PERMUP>(src, dst, K, N, gain, ia, ib, ib < nitems, lane);
        }
        if (threadIdx.x == 0) *slot = nxt;
        __syncthreads();
        t0 = (int)*slot;
        __syncthreads();
    }
}

template <int MODE>
__device__ __forceinline__ void rms_phase(const float* __restrict__ h_in, float* __restrict__ h_out, const float* __restrict__ x, const float* __restrict__ meta,
                          const float* __restrict__ gain, bf16_t* __restrict__ hn, float* __restrict__ out) {
    const int lane = threadIdx.x & 63, gw = blockIdx.x * 8 + (threadIdx.x >> 6), nw = gridDim.x * 8;
    for (int row = gw; row < M; row += nw) {
        const int b = row / L, t = row - b * L;
        if (MODE == 2 && t < NMETA) continue;
        const float* src;
        if (MODE == 1) src = (t < NMETA) ? meta + (size_t)t * D : x + ((size_t)b * SEQ + (t - NMETA)) * D;
        else src = h_in + (size_t)row * D;
        f32x4 v[8]; float ss = 0.f;
#pragma unroll
        for (int i = 0; i < 8; ++i) { v[i] = *(const f32x4*)(src + (lane + i * 64) * 4); ss += v[i][0] * v[i][0] + v[i][1] * v[i][1] + v[i][2] * v[i][2] + v[i][3] * v[i][3]; }
        ss = wave_sum(ss);
        const float r = rsqrtf(ss * (1.0f / D) + 1e-6f);
#pragma unroll
        for (int i = 0; i < 8; ++i) {
            const int c = (lane + i * 64) * 4;
            const f32x4 g = *(const f32x4*)(gain + c);
            const f32x4 o = v[i] * r * g;
            if (MODE == 2) *(f32x4*)(out + ((size_t)b * SEQ + (t - NMETA)) * D + c) = o;
            else { u32x2 w; w.x = pk2(o[0], o[1]); w.y = pk2(o[2], o[3]); *(u32x2*)(hn + (size_t)row * D + c) = w; }
        }
    }
}

__device__ __forceinline__ void mixer_ab_phase(const bf16_t* __restrict__ z1, const float* __restrict__ conf_dw, const float* __restrict__ conf_b, const float* __restrict__ ln_g,
                               const float* __restrict__ ln_b, const float* __restrict__ sc_dw, bf16_t* __restrict__ cat, LAS unsigned char* lds) {
    const int tid = threadIdx.x, wid = __builtin_amdgcn_readfirstlane(tid >> 6), lane = tid & 63;
    constexpr int TT = 33, TPB = (L + TT - 1) / TT;
    LAS unsigned* S32 = (LAS unsigned*)lds;
    LAS float* C = (LAS float*)lds;
    for (int tile = blockIdx.x; tile < NBATCH * TPB; tile += gridDim.x) {
        const int b = tile / TPB, t0 = (tile % TPB) * TT;
        const int nt = (L - t0) < TT ? (L - t0) : TT;
        static_assert((TT + 30) % 7 == 0, "staging loop is unrolled by 7");
#pragma unroll 1
        for (int r0 = 0; r0 < TT + 30; r0 += 7) {
            unsigned av[7], gv[7];
#pragma unroll
            for (int u = 0; u < 7; ++u) {
                const int t = t0 - 30 + r0 + u, tc = t < 0 ? 0 : (t >= L ? L - 1 : t);
                const bf16_t* zr = z1 + (size_t)(b * L + tc) * NAB;
                av[u] = *(const unsigned*)(zr + 2 * tid); gv[u] = *(const unsigned*)(zr + 1024 + 2 * tid);
            }
#pragma unroll
            for (int u = 0; u < 7; ++u) {
                const int t = t0 - 30 + r0 + u;
                unsigned w = pk2(lo_f(av[u]) * fsigm(lo_f(gv[u])), hi_f(av[u]) * fsigm(hi_f(gv[u])));
                if (t < 0 || t >= L) w = 0u;
                S32[(r0 + u) * 512 + tid] = w;
            }
        }
        __syncthreads();
        f32x2 acc[TT];
#pragma unroll
        for (int t = 0; t < TT; ++t) acc[t] = (f32x2){0.f, 0.f};
        f32x2 wnext = *(const f32x2*)(conf_dw + 2 * tid);
#pragma unroll 1
        for (int j = 0; j < 31; ++j) {
            const f32x2 w = wnext;
            wnext = *(const f32x2*)(conf_dw + (j < 30 ? j + 1 : j) * 1024 + 2 * tid);
#pragma unroll
            for (int t = 0; t < TT; ++t) { const unsigned xw = S32[(t + j) * 512 + tid]; acc[t] += (f32x2){lo_f(xw), hi_f(xw)} * w; }
        }
        const f32x2 bias = *(const f32x2*)(conf_b + 2 * tid);
        __syncthreads();
#pragma unroll
        for (int t = 0; t < TT; ++t) *(LAS f32x2*)(C + t * 1024 + 2 * tid) = acc[t] + bias;
        __syncthreads();
        for (int q = 0; q < 5; ++q) {
            const int tt = wid + 8 * q;
            if (tt < nt) {
                f32x4 v[4]; float s = 0.f;
#pragma unroll
                for (int i = 0; i < 4; ++i) { v[i] = *(const LAS f32x4*)(C + tt * 1024 + (lane + i * 64) * 4); s += (v[i][0] + v[i][1]) + (v[i][2] + v[i][3]); }
                const float mean = wave_sum(s) * (1.0f / 1024.0f);
                float qv = 0.f;
#pragma unroll
                for (int i = 0; i < 4; ++i) { const f32x4 d = v[i] - mean; qv += d[0] * d[0] + d[1] * d[1] + d[2] * d[2] + d[3] * d[3]; }
                const float rstd = rsqrtf(wave_sum(qv) * (1.0f / 1024.0f) + 1e-5f);
                bf16_t* orow = cat + (size_t)(b * L + t0 + tt) * D;
#pragma unroll
                for (int i = 0; i < 4; ++i) {
                    const int c = (lane + i * 64) * 4;
                    const f32x4 g = *(const f32x4*)(ln_g + c), bb = *(const f32x4*)(ln_b + c);
                    const f32x4 y = (v[i] - mean) * rstd * g + bb;
                    u32x2 w; w.x = pk2(fsilu(y[0]), fsilu(y[1])); w.y = pk2(fsilu(y[2]), fsilu(y[3]));
                    *(u32x2*)(orow + c) = w;
                }
            }
        }
        __syncthreads();
    }
    const int gtid = blockIdx.x * NTHREADS + tid, nth = gridDim.x * NTHREADS;
    for (int idx = gtid; idx < M * 128; idx += nth) {
        const int row = idx >> 7, c = (idx & 127) * 8, t = row % L;
        float acc[8];
#pragma unroll
        for (int e = 0; e < 8; ++e) acc[e] = 0.f;
#pragma unroll
        for (int j = 0; j < 3; ++j) {
            if (t - 2 + j >= 0) {
                const bf16_t* zr = z1 + (size_t)(row - 2 + j) * NAB;
                const u32x4 sc = *(const u32x4*)(zr + 3072 + c), sx = *(const u32x4*)(zr + 4096 + c);
                const f32x4 w0 = *(const f32x4*)(sc_dw + j * 1024 + c), w1 = *(const f32x4*)(sc_dw + j * 1024 + c + 4);
                acc[0] += lo_f(sc.x) * lo_f(sx.x) * w0[0]; acc[1] += hi_f(sc.x) * hi_f(sx.x) * w0[1];
                acc[2] += lo_f(sc.y) * lo_f(sx.y) * w0[2]; acc[3] += hi_f(sc.y) * hi_f(sx.y) * w0[3];
                acc[4] += lo_f(sc.z) * lo_f(sx.z) * w1[0]; acc[5] += hi_f(sc.z) * hi_f(sx.z) * w1[1];
                acc[6] += lo_f(sc.w) * lo_f(sx.w) * w1[2]; acc[7] += hi_f(sc.w) * hi_f(sx.w) * w1[3];
            }
        }
        const u32x4 sb = *(const u32x4*)(z1 + (size_t)row * NAB + 2048 + c);
        u32x4 o;
        o.x = pk2(lo_f(sb.x) * acc[0], hi_f(sb.x) * acc[1]); o.y = pk2(lo_f(sb.y) * acc[2], hi_f(sb.y) * acc[3]);
        o.z = pk2(lo_f(sb.z) * acc[4], hi_f(sb.z) * acc[5]); o.w = pk2(lo_f(sb.w) * acc[6], hi_f(sb.w) * acc[7]);
        *(u32x4*)(cat + (size_t)row * D + 1024 + c) = o;
    }
}

__device__ __forceinline__ void ffn_gate_phase(const bf16_t* __restrict__ u, const float* __restrict__ dw  , bf16_t* __restrict__ g) {
    const int gtid = blockIdx.x * NTHREADS + threadIdx.x, nth = gridDim.x * NTHREADS;
    constexpr int NC8 = DFF / 8, NRUN = L / 16;
    for (int idx = gtid; idx < NBATCH * NRUN * NC8; idx += nth) {
        const int c = (idx % NC8) * 8, run = (idx / NC8) % NRUN, b = idx / (NC8 * NRUN), t0 = run * 16;
        float wv[3][8], wg[3][8];
#pragma unroll
        for (int j = 0; j < 3; ++j) {
            const f32x4 a0 = *(const f32x4*)(dw + j * NUP + c), a1 = *(const f32x4*)(dw + j * NUP + c + 4);
            const f32x4 g0 = *(const f32x4*)(dw + j * NUP + DFF + c), g1 = *(const f32x4*)(dw + j * NUP + DFF + c + 4);
#pragma unroll
            for (int e = 0; e < 4; ++e) { wv[j][e] = a0[e]; wv[j][4 + e] = a1[e]; wg[j][e] = g0[e]; wg[j][4 + e] = g1[e]; }
        }
        u32x4 v2 = (u32x4){0u, 0u, 0u, 0u}, v1 = v2, g2 = v2, g1 = v2;
        if (t0 >= 2) {
            const bf16_t* r2 = u + (size_t)(b * L + t0 - 2) * NUP; const bf16_t* r1 = r2 + NUP;
            v2 = *(const u32x4*)(r2 + c); g2 = *(const u32x4*)(r2 + DFF + c); v1 = *(const u32x4*)(r1 + c); g1 = *(const u32x4*)(r1 + DFF + c);
        }
#pragma unroll 4
        for (int i = 0; i < 16; ++i) {
            const size_t row = (size_t)(b * L + t0 + i);
            const u32x4 v0 = *(const u32x4*)(u + row * NUP + c), g0 = *(const u32x4*)(u + row * NUP + DFF + c);
            float val[8], gat[8];
#define TAP(e, W2, W1, W0, sel) \
            val[e] = sel(v2.W2) * wv[0][e] + sel(v1.W1) * wv[1][e] + sel(v0.W0) * wv[2][e]; gat[e] = sel(g2.W2) * wg[0][e] + sel(g1.W1) * wg[1][e] + sel(g0.W0) * wg[2][e];
            TAP(0, x, x, x, lo_f) TAP(1, x, x, x, hi_f) TAP(2, y, y, y, lo_f) TAP(3, y, y, y, hi_f)
            TAP(4, z, z, z, lo_f) TAP(5, z, z, z, hi_f) TAP(6, w, w, w, lo_f) TAP(7, w, w, w, hi_f)
#undef TAP
            u32x4 o;
            o.x = pk2(fsilu(gat[0]) * val[0], fsilu(gat[1]) * val[1]); o.y = pk2(fsilu(gat[2]) * val[2], fsilu(gat[3]) * val[3]);
            o.z = pk2(fsilu(gat[4]) * val[4], fsilu(gat[5]) * val[5]); o.w = pk2(fsilu(gat[6]) * val[6], fsilu(gat[7]) * val[7]);
            *(u32x4*)(g + row * DFF + c) = o;
            v2 = v1; g2 = g1; v1 = v0; g1 = g0;
        }
    }
}

struct CD {
    const float *z2, *gla_w2, *gla_b, *gla_norm_g, *rw_mu, *rw_w0, *rw_a0, *rw_kk, *rw_ka, *rw_rk, *rw_ln_g, *rw_ln_b;
    float *R, *KR, *VR, *G, *Y, *CDEC, *BONUS, *DECAY, *A, *KK, *O;
    bf16_t *LW, *LA, *LG, *GATE, *QDEC, *KDEC, *K2T, *VT, *W2T, *A2T, *G2T, *CST, *SPT, *P, *CAT;
};

__device__ __forceinline__ void prep1_phase(const CD& p, LAS unsigned char* lds) {
    const int tid = threadIdx.x, wid = __builtin_amdgcn_readfirstlane(tid >> 6), lane = tid & 63;
    LAS float* tot = (LAS float*)lds;
    for (int item = blockIdx.x; item < NGI; item += gridDim.x) {
        const int bh = item / NCH, n = item - bh * NCH, b = bh >> 2, h = bh & 3;
        const int pg = wid >> 1, d = (wid & 1) * 64 + lane;
        float w2r[16];
#pragma unroll
        for (int r = 0; r < 16; ++r) w2r[r] = p.gla_w2[r * 512 + h * 128 + d];
        const float bias = p.gla_b[h * 128 + d];
        float la[16]; float run = 0.f;
#pragma unroll
        for (int i = 0; i < 16; ++i) {
            const int t = n * 64 + pg * 16 + i - 48;
            float v = 0.f;
            if (t >= 0 && t < L) {
                const float* gl = p.z2 + (size_t)(b * L + t) * NCDP + 3072;
                float xx = bias;
#pragma unroll
                for (int r = 0; r < 16; ++r) xx += gl[r] * w2r[r];
                v = logsig(xx) * (1.0f / 16.0f);
            }
            run += v; la[i] = run;
        }
        tot[pg * 128 + d] = run;
        __syncthreads();
        float off = 0.f, last = 0.f;
#pragma unroll
        for (int g4 = 0; g4 < 4; ++g4) { const float tv = tot[g4 * 128 + d]; if (g4 < pg) off += tv; last += tv; }
        unsigned k2p[8];
#pragma unroll
        for (int i = 0; i < 16; ++i) {
            const int pp = pg * 16 + i, t = n * 64 + pp - 48;
            const float cum = off + la[i];
            float q = 0.f, k = 0.f;
            if (t >= 0 && t < L) { const float* zr = p.z2 + (size_t)(b * L + t) * NCDP; q = zr[h * 128 + d] * 0.08838834764831845f; k = zr[512 + h * 128 + d]; }
            const float qd = q * expf(cum), kd = k * expf(-cum), k2 = k * expf(last - cum);
            p.QDEC[((size_t)item * 64 + pp) * 128 + d] = (bf16_t)f2bf(qd);
            p.KDEC[((size_t)item * 64 + pp) * 128 + d] = (bf16_t)f2bf(kd);
            if (i & 1) k2p[i >> 1] |= f2bf(k2) << 16; else k2p[i >> 1] = f2bf(k2);
        }
        {
            bf16_t* dst = p.K2T + ((size_t)item * 128 + d) * 64 + pg * 16;
            *(u32x4*)(dst) = (u32x4){k2p[0], k2p[1], k2p[2], k2p[3]};
            *(u32x4*)(dst + 8) = (u32x4){k2p[4], k2p[5], k2p[6], k2p[7]};
        }
        if (pg == 0) p.CDEC[item * 128 + d] = expf(last);
        {
            const int v = tid & 255, ph = tid >> 8;
            unsigned vp[16];
#pragma unroll
            for (int i = 0; i < 32; ++i) {
                const int t = n * 64 + ph * 32 + i - 48;
                float xv = 0.f;
                if (t >= 0 && t < L) xv = p.z2[(size_t)(b * L + t) * NCDP + 1024 + h * 256 + v];
                if (i & 1) vp[i >> 1] |= f2bf(xv) << 16; else vp[i >> 1] = f2bf(xv);
            }
            bf16_t* dst = p.VT + ((size_t)item * 256 + v) * 64 + ph * 32;
#pragma unroll
            for (int s = 0; s < 4; ++s) *(u32x4*)(dst + s * 8) = (u32x4){vp[s * 4 + 0], vp[s * 4 + 1], vp[s * 4 + 2], vp[s * 4 + 3]};
        }
        __syncthreads();
    }
    const int gtid = blockIdx.x * NTHREADS + tid, nth = gridDim.x * NTHREADS;
    for (int base = gtid; base < M * 256; base += nth * 4) {
        f32x4 go[4], ng[4];
#pragma unroll
        for (int u = 0; u < 4; ++u) {
            const int idx = base + u * nth, ic = idx < M * 256 ? idx : 0, row = ic >> 8, c = (ic & 255) * 4;
            go[u] = *(const f32x4*)(p.z2 + (size_t)row * NCDP + 2048 + c); ng[u] = *(const f32x4*)(p.gla_norm_g + c);
        }
#pragma unroll
        for (int u = 0; u < 4; ++u) {
            const int idx = base + u * nth;
            if (idx < M * 256) {
                const int row = idx >> 8, c = (idx & 255) * 4;
                u32x2 w; w.x = pk2(fsilu(go[u][0]) * ng[u][0], fsilu(go[u][1]) * ng[u][1]); w.y = pk2(fsilu(go[u][2]) * ng[u][2], fsilu(go[u][3]) * ng[u][3]);
                *(u32x2*)(p.GATE + (size_t)row * 1024 + c) = w;
            }
        }
    }
    for (int base = gtid; base < M * 832; base += nth * 4) {
        f32x4 zv[4], zpv[4], muv[4];
#pragma unroll
        for (int u = 0; u < 4; ++u) {
            const int idx = base + u * nth, ic = idx < M * 832 ? idx : 0, row = ic / 832, c4 = (ic - row * 832) * 4, t = row % L;
            zv[u] = *(const f32x4*)(p.z2 + (size_t)row * NCDP + 3088 + c4);
            zpv[u] = *(const f32x4*)(p.z2 + (size_t)(t > 0 ? row - 1 : row) * NCDP + 3088 + c4);
            if (t == 0) zpv[u] = (f32x4){0.f, 0.f, 0.f, 0.f};
            muv[u] = *(const f32x4*)(p.rw_mu + c4);
        }
#pragma unroll
        for (int u = 0; u < 4; ++u) {
        const int idx = base + u * nth;
        if (idx >= M * 832) continue;
        const int row = idx / 832, c4 = (idx - row * 832) * 4;
        const f32x4 zr = zv[u] + (zpv[u] - zv[u]) * muv[u];
        if (c4 < 1024) *(f32x4*)(p.R + (size_t)row * 1024 + c4) = zr;
        else if (c4 < 2048) *(f32x4*)(p.KR + (size_t)row * 1024 + c4 - 1024) = zr;
        else if (c4 < 3072) *(f32x4*)(p.VR + (size_t)row * 1024 + c4 - 2048) = zr;
        else if (c4 < 3136) { u32x2 w; w.x = pk2(tanhf(zr[0]), tanhf(zr[1])); w.y = pk2(tanhf(zr[2]), tanhf(zr[3])); *(u32x2*)(p.LW + (size_t)row * 64 + c4 - 3072) = w; }
        else if (c4 < 3200) { u32x2 w; w.x = pk2(zr[0], zr[1]); w.y = pk2(zr[2], zr[3]); *(u32x2*)(p.LA + (size_t)row * 64 + c4 - 3136) = w; }
        else { u32x2 w; w.x = pk2(sigm(zr[0]), sigm(zr[1])); w.y = pk2(sigm(zr[2]), sigm(zr[3])); *(u32x2*)(p.LG + (size_t)row * 128 + c4 - 3200) = w; }
        }
    }
}

__device__ __forceinline__ void small_gemm_phase(const CD& p) {
    const int lane = threadIdx.x & 63, fr = lane & 15, fq = lane >> 4;
    const int gw = blockIdx.x * 8 + (threadIdx.x >> 6), nw = gridDim.x * 8;
    constexpr int TL = (M / 64) * 16;
    constexpr int T0 = 3 * TL, T1 = T0 + NGI, T2 = T1 + NGI * 8;
    for (int tix = gw; tix < T2; tix += nw) {
        f32x4 acc[4][4]; zero_acc(acc);
        if (tix < T0) {
            const int which = tix / TL, r = tix - which * TL, m0 = (r >> 4) * 64, n0 = (r & 15) * 64;
            if (which == 0) {
                f32x4 w0v[4];
#pragma unroll
                for (int ni = 0; ni < 4; ++ni) w0v[ni] = *(const f32x4*)(p.rw_w0 + n0 + ni * 16 + fq * 4);
                wave_tile_mma<2>(p.LW + (size_t)m0 * 64, 64, p.W2T + (size_t)n0 * 64, 64, 0, 64, acc, fr, fq);
#pragma unroll
                for (int mi = 0; mi < 4; ++mi)
#pragma unroll
                    for (int ni = 0; ni < 4; ++ni) {
                        const int row = m0 + mi * 16 + fr, col = n0 + ni * 16 + fq * 4;
                        const f32x4 w0 = w0v[ni]; f32x4 o;
#pragma unroll
                        for (int e = 0; e < 4; ++e) o[e] = expf(-0.6065306597126334f * sigm(w0[e] + acc[mi][ni][e]));
                        *(f32x4*)(p.DECAY + (size_t)row * 1024 + col) = o;
                    }
            } else if (which == 1) {
                f32x4 a0v[4];
#pragma unroll
                for (int ni = 0; ni < 4; ++ni) a0v[ni] = *(const f32x4*)(p.rw_a0 + n0 + ni * 16 + fq * 4);
                wave_tile_mma<2>(p.LA + (size_t)m0 * 64, 64, p.A2T + (size_t)n0 * 64, 64, 0, 64, acc, fr, fq);
#pragma unroll
                for (int mi = 0; mi < 4; ++mi)
#pragma unroll
                    for (int ni = 0; ni < 4; ++ni) {
                        const int row = m0 + mi * 16 + fr, col = n0 + ni * 16 + fq * 4;
                        const f32x4 a0 = a0v[ni]; f32x4 o;
#pragma unroll
                        for (int e = 0; e < 4; ++e) o[e] = fsigm(a0[e] + acc[mi][ni][e]);
                        *(f32x4*)(p.A + (size_t)row * 1024 + col) = o;
                    }
            } else {
                wave_tile_mma<4>(p.LG + (size_t)m0 * 128, 128, p.G2T + (size_t)n0 * 128, 128, 0, 128, acc, fr, fq);
#pragma unroll
                for (int mi = 0; mi < 4; ++mi)
#pragma unroll
                    for (int ni = 0; ni < 4; ++ni) {
                        const int row = m0 + mi * 16 + fr, col = n0 + ni * 16 + fq * 4;
                        *(f32x4*)(p.G + (size_t)row * 1024 + col) = acc[mi][ni];
                    }
            }
        } else if (tix < T1) {
            const int item = tix - T0;
            wave_tile_mma<4>(p.QDEC + (size_t)item * 8192, 128, p.KDEC + (size_t)item * 8192, 128, 0, 128, acc, fr, fq);
#pragma unroll
            for (int mi = 0; mi < 4; ++mi)
#pragma unroll
                for (int ni = 0; ni < 4; ++ni) {
                    const int pp = mi * 16 + fr, s0 = ni * 16 + fq * 4;
                    f32x4 v = acc[mi][ni];
#pragma unroll
                    for (int e = 0; e < 4; ++e) if (s0 + e > pp) v[e] = 0.f;
                    u32x2 w; w.x = pk2(v[0], v[1]); w.y = pk2(v[2], v[3]);
                    *(u32x2*)(p.P + (size_t)item * 4096 + pp * 64 + s0) = w;
                }
        } else {
            const int r = tix - T1, item = r >> 3, vt = (r >> 1) & 3, dt = r & 1;
            wave_tile_mma<2>(p.VT + ((size_t)item * 256 + vt * 64) * 64, 64, p.K2T + ((size_t)item * 128 + dt * 64) * 64, 64, 0, 64, acc, fr, fq);
#pragma unroll
            for (int mi = 0; mi < 4; ++mi)
#pragma unroll
                for (int ni = 0; ni < 4; ++ni) {
                    const int v = vt * 64 + mi * 16 + fr, d0 = dt * 64 + ni * 16 + fq * 4;
                    u32x2 w; w.x = pk2(acc[mi][ni][0], acc[mi][ni][1]); w.y = pk2(acc[mi][ni][2], acc[mi][ni][3]);
                    *(u32x2*)(p.CST + ((size_t)item * 256 + v) * 128 + d0) = w;
                }
        }
    }
}

__device__ __forceinline__ void prep2_phase(const CD& p) {
    const int gtid = blockIdx.x * NTHREADS + threadIdx.x, nth = gridDim.x * NTHREADS;
    for (int e = gtid; e < 16 * 256 * 32; e += nth) {
        const int d4 = (e & 31) * 4, v = (e >> 5) & 255, bh = e >> 13;
        f32x4 S = (f32x4){0.f, 0.f, 0.f, 0.f};
        const size_t o0 = ((size_t)(bh * NCH) * 256 + v) * 128 + d4;
        f32x4 decs[3]; u32x2 css[3];
#pragma unroll 1
        for (int n0 = 0; n0 < NCH; n0 += 3) {
#pragma unroll
            for (int u = 0; u < 3; ++u) { decs[u] = *(const f32x4*)(p.CDEC + (bh * NCH + n0 + u) * 128 + d4); css[u] = *(const u32x2*)(p.CST + o0 + (size_t)(n0 + u) * 32768); }
#pragma unroll
            for (int u = 0; u < 3; ++u) {
                u32x2 w; w.x = pk2(S[0], S[1]); w.y = pk2(S[2], S[3]);
                *(u32x2*)(p.SPT + o0 + (size_t)(n0 + u) * 32768) = w;
                S = S * decs[u] + (f32x4){lo_f(css[u].x), hi_f(css[u].x), lo_f(css[u].y), hi_f(css[u].y)};
            }
        }
    }
}

__device__ __forceinline__ void gla_out_phase(const CD& p) {
    const int lane = threadIdx.x & 63, fr = lane & 15, fq = lane >> 4;
    const int gw = blockIdx.x * 8 + (threadIdx.x >> 6), nw = gridDim.x * 8;
    for (int tix = gw; tix < NGI * 4; tix += nw) {
        const int item = tix >> 2, vt = tix & 3, bh = item / NCH, n = item - bh * NCH, b = bh >> 2, h = bh & 3;
        f32x4 acc[4][4]; zero_acc(acc);
        wave_tile_mma<2>(p.P + (size_t)item * 4096, 64, p.VT + ((size_t)item * 256 + vt * 64) * 64, 64, 0, 64, acc, fr, fq);
        wave_tile_mma<4>(p.QDEC + (size_t)item * 8192, 128, p.SPT + ((size_t)item * 256 + vt * 64) * 128, 128, 0, 128, acc, fr, fq);
#pragma unroll
        for (int mi = 0; mi < 4; ++mi) {
            const int t = n * 64 + mi * 16 + fr - 48;
            if (t >= 0 && t < L) {
#pragma unroll
                for (int ni = 0; ni < 4; ++ni) *(f32x4*)(p.O + (size_t)(b * L + t) * 1024 + h * 256 + vt * 64 + ni * 16 + fq * 4) = acc[mi][ni];
            }
        }
    }
}

__device__ __forceinline__ float oct_sum(float x) {
    x += __int_as_float(__builtin_amdgcn_update_dpp(0, __float_as_int(x), 0xB1, 0xF, 0xF, false));
    x += __int_as_float(__builtin_amdgcn_update_dpp(0, __float_as_int(x), 0x4E, 0xF, 0xF, false));
    x += __int_as_float(__builtin_amdgcn_update_dpp(0, __float_as_int(x), 0x141, 0xF, 0xF, false));
    return x;
}
struct StepOps { f32x4 r[2], w[2], k[2], kk[2], b[2]; float v; };
template <bool WITH_R>
__device__ __forceinline__ void ld_ops(StepOps& o, const LAS float* bp, int s, int j, int vidx) {
    const LAS float* sp = bp + s * 64 + j * 8;
    if (WITH_R) { o.r[0] = *(const LAS f32x4*)(sp); o.r[1] = *(const LAS f32x4*)(sp + 4); }
    o.w[0] = *(const LAS f32x4*)(sp + 2048); o.w[1] = *(const LAS f32x4*)(sp + 2048 + 4);
    o.k[0] = *(const LAS f32x4*)(sp + 4096); o.k[1] = *(const LAS f32x4*)(sp + 4096 + 4);
    o.kk[0] = *(const LAS f32x4*)(sp + 6144); o.kk[1] = *(const LAS f32x4*)(sp + 6144 + 4);
    o.b[0] = *(const LAS f32x4*)(sp + 8192); o.b[1] = *(const LAS f32x4*)(sp + 8192 + 4);
    o.v = bp[10240 + s * 64 + vidx];
}
template <bool WITH_V>
__device__ __forceinline__ void scan_update(f32x2 (&S)[4], const StepOps& o) {
    f32x2 sa2 = S[0] * o.kk[0].lo + S[1] * o.kk[0].hi;
    sa2 += S[2] * o.kk[1].lo + S[3] * o.kk[1].hi;
    const float sa = -oct_sum(sa2[0] + sa2[1]);
    const f32x2 sv = (f32x2){sa, sa};
    if (WITH_V) {
        const f32x2 vv = (f32x2){o.v, o.v};
        S[0] = S[0] * o.w[0].lo + (sv * o.b[0].lo + vv * o.k[0].lo);
        S[1] = S[1] * o.w[0].hi + (sv * o.b[0].hi + vv * o.k[0].hi);
        S[2] = S[2] * o.w[1].lo + (sv * o.b[1].lo + vv * o.k[1].lo);
        S[3] = S[3] * o.w[1].hi + (sv * o.b[1].hi + vv * o.k[1].hi);
    } else {
        S[0] = S[0] * o.w[0].lo + sv * o.b[0].lo;
        S[1] = S[1] * o.w[0].hi + sv * o.b[0].hi;
        S[2] = S[2] * o.w[1].lo + sv * o.b[1].lo;
        S[3] = S[3] * o.w[1].hi + sv * o.b[1].hi;
    }
}
__device__ __forceinline__ float scan_y(const f32x2 (&S)[4], const StepOps& o) {
    f32x2 y2 = S[0] * o.r[0].lo + S[1] * o.r[0].hi;
    y2 += S[2] * o.r[1].lo + S[3] * o.r[1].hi;
    return oct_sum(y2[0] + y2[1]);
}
template <int MODE>
__device__ __forceinline__ void rwkv_scan_pass(const CD& p, float* __restrict__ PSI, float* __restrict__ PHI, LAS unsigned char* lds) {
    constexpr int CL = L / 4, NSUB = (CL + 31) / 32;
    const int tid = threadIdx.x, wid = __builtin_amdgcn_readfirstlane(tid >> 6), lane = tid & 63;
    LAS float* buf = (LAS float*)lds;
    LAS float* Sm = (LAS float*)(lds + 98304);
    LAS float* Pm = (LAS float*)(lds + 114688);
    for (int item = blockIdx.x; item < 256; item += gridDim.x) {
        const int bh = item >> 2, c = item & 3, b = bh >> 4, h = bh & 15;
        const int rr = tid >> 4, c4 = (tid & 15) * 4;
        const size_t gbase = (size_t)(b * L + c * CL) * 1024 + h * 64 + c4;
        f32x4 st0, st1, st2, st4, st5;
        const f32x4 pkk = *(const f32x4*)(p.rw_kk + h * 64 + c4), pka = *(const f32x4*)(p.rw_ka + h * 64 + c4), prk = *(const f32x4*)(p.rw_rk + h * 64 + c4);
#define SCAN_LOADS(tn) do { const size_t _o = gbase + (size_t)(tn) * 1024; \
        if (MODE == 3) st0 = *(const f32x4*)(p.R + _o); st1 = *(const f32x4*)(p.DECAY + _o); st2 = *(const f32x4*)(p.KR + _o); \
        st4 = *(const f32x4*)(p.A + _o); st5 = *(const f32x4*)(p.VR + _o); } while (0)
#define SCAN_STORES(bb, tl) do { LAS float* _d = buf + (bb) * 12288 + rr * 64 + c4; \
        f32x4 _kk = st2 * pkk; const float _ss = sum16(_kk[0] * _kk[0] + _kk[1] * _kk[1] + _kk[2] * _kk[2] + _kk[3] * _kk[3]); \
        _kk = _kk * (1.0f / fmaxf(sqrtf(_ss), 1e-12f)); \
        const f32x4 _k = st2 * (1.0f + (st4 - 1.0f) * pka); \
        if (MODE == 3) { const f32x4 _rk = st0 * _k * prk; const float _bs = sum16((_rk[0] + _rk[1]) + (_rk[2] + _rk[3])); \
            if ((tid & 15) == 0 && (tl) < CL) p.BONUS[(size_t)(b * L + c * CL + (tl)) * 16 + h] = _bs; \
            *(LAS f32x4*)(_d) = st0; } \
        *(LAS f32x4*)(_d + 2048) = st1; *(LAS f32x4*)(_d + 4096) = _k; \
        *(LAS f32x4*)(_d + 6144) = _kk; *(LAS f32x4*)(_d + 8192) = _kk * st4; *(LAS f32x4*)(_d + 10240) = st5; } while (0)
        st0 = (f32x4){0.f, 0.f, 0.f, 0.f};
        SCAN_LOADS(rr);
        SCAN_STORES(0, rr);
        const int slot = lane >> 3, j = lane & 7, r = wid * 8 + slot;
        f32x2 S0[4], S1[4];
#pragma unroll
        for (int i = 0; i < 4; ++i) { S0[i] = (f32x2){0.f, 0.f}; S1[i] = (f32x2){(8 * j + 2 * i) == r ? 1.f : 0.f, (8 * j + 2 * i + 1) == r ? 1.f : 0.f}; }
        if (MODE == 3 && c > 0) {
            const float* ps0 = PSI + (size_t)(bh * 4) * 4096;
#pragma unroll
            for (int i = 0; i < 2; ++i) *(LAS f32x4*)(Sm + (tid + i * 512) * 4) = *(const f32x4*)(ps0 + (tid + i * 512) * 4);
            for (int cc = 1; cc < c; ++cc) {
                const float* ph = PHI + (size_t)(bh * 4 + cc) * 4096; const float* ps = PSI + (size_t)(bh * 4 + cc) * 4096;
#pragma unroll
                for (int i = 0; i < 2; ++i) *(LAS f32x4*)(Pm + (tid + i * 512) * 4) = *(const f32x4*)(ph + (tid + i * 512) * 4);
                const int v = tid >> 3, kq = (tid & 7) * 8;
                f32x4 a0 = *(const f32x4*)(ps + v * 64 + kq), a1 = *(const f32x4*)(ps + v * 64 + kq + 4);
                __syncthreads();
#pragma unroll 8
                for (int k = 0; k < 64; ++k) {
                    const float s = Sm[v * 64 + k];
                    a0 += s * *(const LAS f32x4*)(Pm + k * 64 + kq); a1 += s * *(const LAS f32x4*)(Pm + k * 64 + kq + 4);
                }
                __syncthreads();
                *(LAS f32x4*)(Sm + v * 64 + kq) = a0; *(LAS f32x4*)(Sm + v * 64 + kq + 4) = a1;
            }
            __syncthreads();
            const f32x4 i0 = *(const LAS f32x4*)(Sm + r * 64 + 8 * j), i1 = *(const LAS f32x4*)(Sm + r * 64 + 8 * j + 4);
            S0[0] = i0.lo; S0[1] = i0.hi; S0[2] = i1.lo; S0[3] = i1.hi;
        }
        __syncthreads();
        int cb = 0;
        for (int sc = 0; sc < NSUB; ++sc) {
            const int t0 = sc * 32;
            const bool more = (sc + 1 < NSUB);
            if (more) {
                const int tn = t0 + 32 + rr;
                if (tn < CL) SCAN_LOADS(tn);
                else { st0 = (f32x4){0.f, 0.f, 0.f, 0.f}; st1 = st0; st2 = st0; st4 = st0; st5 = st0; }
            }
            {
                const LAS float* bp = buf + cb * 12288;
                const int ns = (CL - t0) < 32 ? (CL - t0) : 32;
                LAS float* yt = (LAS float*)(lds + 98304) + cb * 2048 + r;
                StepOps A, B;
                ld_ops<MODE == 3>(A, bp, 0, j, r);
                for (int s = 0; s < ns; s += 2) {
                    ld_ops<MODE == 3>(B, bp, s + 1, j, r);
                    scan_update<true>(S0, A);
                    if (MODE == 1) scan_update<false>(S1, A);
                    if (MODE == 3) { const float ya = scan_y(S0, A); yt[s * 64] = ya; }
                    if (s + 2 < ns) ld_ops<MODE == 3>(A, bp, s + 2, j, r);
                    scan_update<true>(S0, B);
                    if (MODE == 1) scan_update<false>(S1, B);
                    if (MODE == 3) { const float yb = scan_y(S0, B); yt[(s + 1) * 64] = yb; }
                }
            }
            if (more) SCAN_STORES(cb ^ 1, t0 + 32 + rr);
            __syncthreads();
            if (MODE == 3 && t0 + rr < CL)
                *(f32x4*)(p.Y + (size_t)(b * L + c * CL + t0 + rr) * 1024 + h * 64 + c4) = *(const LAS f32x4*)((LAS float*)(lds + 98304) + cb * 2048 + rr * 64 + c4);
            cb ^= 1;
        }
        if (MODE == 1) {
            float* ps = PSI + ((size_t)(bh * 4 + c) * 64 + r) * 64 + 8 * j; float* ph = PHI + ((size_t)(bh * 4 + c) * 64 + r) * 64 + 8 * j;
            *(f32x4*)(ps) = (f32x4){S0[0][0], S0[0][1], S0[1][0], S0[1][1]}; *(f32x4*)(ps + 4) = (f32x4){S0[2][0], S0[2][1], S0[3][0], S0[3][1]};
            *(f32x4*)(ph) = (f32x4){S1[0][0], S1[0][1], S1[1][0], S1[1][1]}; *(f32x4*)(ph + 4) = (f32x4){S1[2][0], S1[2][1], S1[3][0], S1[3][1]};
        }
#undef SCAN_LOADS
#undef SCAN_STORES
    }
}

__device__ __forceinline__ void gla_out_norm_phase(const CD& p) {
    const int lane = threadIdx.x & 63, fr = lane & 15, fq = lane >> 4;
    const int gw = blockIdx.x * 8 + (threadIdx.x >> 6), nw = gridDim.x * 8;
    for (int tix = gw; tix < NGI * 4; tix += nw) {
        const int item = tix >> 2, mi = tix & 3, bh = item / NCH, n = item - bh * NCH, b = bh >> 2, h = bh & 3;
        f32x4 acc[16];
#pragma unroll
        for (int i = 0; i < 16; ++i) acc[i] = (f32x4){0.f, 0.f, 0.f, 0.f};
        {
            const bf16_t* ap = p.P + (size_t)item * 4096 + (mi * 16 + fr) * 64 + fq * 8;
            const bf16_t* bp = p.VT + (size_t)item * 16384 + fr * 64 + fq * 8;
            {
                const bf16x8 a0 = *(const bf16x8*)(ap), a1 = *(const bf16x8*)(ap + 32);
                bf16x8 bf0[16], bf1[16];
#pragma unroll
                for (int ni = 0; ni < 16; ++ni) { bf0[ni] = *(const bf16x8*)(bp + ni * 16 * 64); bf1[ni] = *(const bf16x8*)(bp + ni * 16 * 64 + 32); }
#pragma unroll
                for (int ni = 0; ni < 16; ++ni) { acc[ni] = __builtin_amdgcn_mfma_f32_16x16x32_bf16(bf0[ni], a0, acc[ni], 0, 0, 0); acc[ni] = __builtin_amdgcn_mfma_f32_16x16x32_bf16(bf1[ni], a1, acc[ni], 0, 0, 0); }
            }
        }
        {
            const bf16_t* ap = p.QDEC + (size_t)item * 8192 + (mi * 16 + fr) * 128 + fq * 8;
            const bf16_t* bp = p.SPT + (size_t)item * 32768 + fr * 128 + fq * 8;
#pragma unroll 1
            for (int k = 0; k < 128; k += 64) {
                const bf16x8 a0 = *(const bf16x8*)(ap + k), a1 = *(const bf16x8*)(ap + k + 32);
                bf16x8 bf0[16], bf1[16];
#pragma unroll
                for (int ni = 0; ni < 16; ++ni) { bf0[ni] = *(const bf16x8*)(bp + ni * 16 * 128 + k); bf1[ni] = *(const bf16x8*)(bp + ni * 16 * 128 + k + 32); }
#pragma unroll
                for (int ni = 0; ni < 16; ++ni) { acc[ni] = __builtin_amdgcn_mfma_f32_16x16x32_bf16(bf0[ni], a0, acc[ni], 0, 0, 0); acc[ni] = __builtin_amdgcn_mfma_f32_16x16x32_bf16(bf1[ni], a1, acc[ni], 0, 0, 0); }
            }
        }
        const int t = n * 64 + mi * 16 + fr - 48;
        const bool valid = (t >= 0 && t < L);
        const size_t rowo = (size_t)(b * L + (valid ? t : 0));
        u32x2 gt[16];
#pragma unroll
        for (int ni = 0; ni < 16; ++ni) gt[ni] = *(const u32x2*)(p.GATE + rowo * 1024 + h * 256 + ni * 16 + fq * 4);
        float ss = 0.f;
#pragma unroll
        for (int ni = 0; ni < 16; ++ni) ss += (acc[ni][0] * acc[ni][0] + acc[ni][1] * acc[ni][1]) + (acc[ni][2] * acc[ni][2] + acc[ni][3] * acc[ni][3]);
        ss += __shfl_xor(ss, 16); ss += __shfl_xor(ss, 32);
        const float rs = rsqrtf(ss * (1.0f / 256.0f) + 1e-6f);
        if (valid) {
#pragma unroll
            for (int ni = 0; ni < 16; ++ni) {
                const f32x4 v = acc[ni] * rs;
                u32x2 w; w.x = pk2(v[0] * lo_f(gt[ni].x), v[1] * hi_f(gt[ni].x)); w.y = pk2(v[2] * lo_f(gt[ni].y), v[3] * hi_f(gt[ni].y));
                *(u32x2*)(p.CAT + rowo * D + h * 256 + ni * 16 + fq * 4) = w;
            }
        }
    }
}

__device__ __forceinline__ void post_phase(const CD& p) {
    const int lane = threadIdx.x & 63;
    const int gw = blockIdx.x * 8 + (threadIdx.x >> 6), nw = gridDim.x * 8;
    for (int itb = gw; itb < M * 4; itb += nw * 4) {
        f32x4 yv[4], vrv[4], ggv[4]; float bnv[4];
#pragma unroll
        for (int u = 0; u < 4; ++u) {
            const int it = itb + u * nw, ic = it < M * 4 ? it : 0, hh = (ic & 3) * 4 + (lane >> 4);
            const size_t o = (size_t)(ic >> 2) * 1024 + hh * 64 + (lane & 15) * 4;
            yv[u] = *(const f32x4*)(p.Y + o); vrv[u] = *(const f32x4*)(p.VR + o); ggv[u] = *(const f32x4*)(p.G + o); bnv[u] = p.BONUS[(ic >> 2) * 16 + hh];
        }
#pragma unroll
        for (int u = 0; u < 4; ++u) {
        const int it = itb + u * nw;
        if (it >= M * 4) continue;
        const int row = it >> 2, h = (it & 3) * 4 + (lane >> 4), c = h * 64 + (lane & 15) * 4;
        const f32x4 y = yv[u];
        const float mu = sum16((y[0] + y[1]) + (y[2] + y[3])) * (1.0f / 64.0f);
        const f32x4 dv = y - mu;
        const float var = sum16(dv[0] * dv[0] + dv[1] * dv[1] + dv[2] * dv[2] + dv[3] * dv[3]) * (1.0f / 64.0f);
        const float rstd = rsqrtf(var + 64e-5f);
        const f32x4 yn = dv * rstd * *(const f32x4*)(p.rw_ln_g + c) + *(const f32x4*)(p.rw_ln_b + c);
        const f32x4 res = (yn + bnv[u] * vrv[u]) * ggv[u];
        u32x2 w; w.x = pk2(res[0], res[1]); w.y = pk2(res[2], res[3]);
        *(u32x2*)(p.CAT + (size_t)row * D + 1024 + c) = w;
        }
    }
}

struct Params { const float* in[31]; float* out; unsigned char* ws; };

__global__ void __launch_bounds__(NTHREADS, 2) fwd_megakernel(Params prm) {
    extern __shared__ __attribute__((aligned(16))) unsigned char lds_raw[];
    LAS unsigned char* lds = (LAS unsigned char*)lds_raw;
    cg::grid_group grid = cg::this_grid();
    size_t zoff = 0;
    unsigned char* ws = prm.ws;
    {
        unsigned* bw = (unsigned*)(ws + XO_BAR);
        if (blockIdx.x == 0) {
            for (int i = threadIdx.x; i < BAR_WORDS; i += NTHREADS) bw[i] = 0u;
            float* ss = (float*)(ws + XO_SS);
            for (int i = threadIdx.x; i < 3 * M; i += NTHREADS) ss[i] = 0.f;
        }
        if (threadIdx.x < 4) ((LAS unsigned*)(lds + LDS_ST_OFF))[threadIdx.x] = 0u;
        __syncthreads();
    }
    XcdBarrier xbar; xbar.bar = (unsigned*)(ws + XO_BAR); xbar.x = 0; xbar.st = (volatile LAS unsigned*)(lds + LDS_ST_OFF);
#ifndef PROBE_MASK
#define PROBE_MASK 0ull
#endif
#if PROBE_MASK
    unsigned long long tacc = 0ull, tprev = __builtin_amdgcn_s_memrealtime(); int tphase = 0;
#define TICK() do { const unsigned long long _n = __builtin_amdgcn_s_memrealtime(); if (((unsigned long long)(PROBE_MASK) >> tphase) & 1ull) tacc += _n - tprev; tprev = _n; ++tphase; } while (0)
#else
#define TICK() do {} while (0)
#endif
#if PROBE_MASK && defined(PROBE_SPLIT)
#define PSPLIT() do { SYNC(); TICK(); } while (0)
#else
#define PSPLIT() do {} while (0)
#endif
#define GEMM_FULL(FULLM_, A_, Bt_, N_, K_, EP_) do { pg8::StaticOrder S_; S_.init((FULLM_) ? 33 * 256 : MBIG, (N_), (int)gridDim.x, (int)blockIdx.x); const auto ep_ = EP_; \
        pg8::gemm_phase(lds, (A_), (Bt_), (K_), S_, ep_); PSPLIT(); if (!(FULLM_)) gemm_rem_phase(lds, (A_), (Bt_), (N_), (K_), ep_); PSPLIT(); } while (0)
#define SYNC() do { xcd_barrier(xbar); asm volatile("" : "+s"(zoff) :: "memory"); ws = prm.ws + zoff; } while (0)
#define SYNC0() do { grid.sync(); xbar = xcd_barrier_post((unsigned*)(ws + XO_BAR), (volatile LAS unsigned*)(lds + LDS_ST_OFF)); asm volatile("" : "+s"(zoff) :: "memory"); ws = prm.ws + zoff; } while (0)
#define WSF(off) ((float*)(ws + (off)))
#define WSB(off) ((bf16_t*)(ws + (off)))
#define CTR(j) ((unsigned*)(ws + XO_BAR) + 3456 + (j))
#define SSQ(j) (WSF(XO_SS) + (j) * M)
#define MKCD(p) CD p; \
        p.z2 = WSF(OFF_Z); p.gla_w2 = prm.in[10]; p.gla_b = prm.in[11]; p.gla_norm_g = prm.in[12]; p.rw_mu = prm.in[13]; p.rw_w0 = prm.in[14]; p.rw_a0 = prm.in[16]; \
        p.rw_kk = prm.in[19]; p.rw_ka = prm.in[20]; p.rw_rk = prm.in[21]; p.rw_ln_g = prm.in[22]; p.rw_ln_b = prm.in[23]; \
        p.R = WSF(XO_R); p.KR = WSF(XO_KR); p.VR = WSF(XO_VR); p.G = WSF(XO_G); p.Y = WSF(XO_Y); \
        p.CDEC = WSF(XO_CDEC); p.BONUS = WSF(XO_BONUS); p.DECAY = WSF(ZO_DECAY); p.A = WSF(ZO_A); p.KK = WSF(ZO_KK); p.O = WSF(ZO_O); \
        p.LW = WSB(XO_LW); p.LA = WSB(XO_LA); p.LG = WSB(XO_LG); p.GATE = WSB(XO_GATE); \
        p.QDEC = WSB(XO_QDEC); p.KDEC = WSB(XO_KDEC); p.K2T = WSB(XO_K2T); p.VT = WSB(XO_VT); \
        p.W2T = WSB(XO_W2T); p.A2T = WSB(XO_A2T); p.G2T = WSB(XO_G2T); \
        p.CST = WSB(ZO_CST); p.SPT = WSB(ZO_SPT); p.P = WSB(ZO_P); p.CAT = WSB(OFF_ACT);

    rms_phase<1>(nullptr, WSF(OFF_H), prm.in[0], prm.in[1], prm.in[25], WSB(OFF_HN), nullptr);
    convert_wt(prm.in[2], WSB(XO_WB), D, NAB, NAB, nullptr, lds);
    convert_wt(prm.in[15], WSB(XO_W2T), 64, 1024, 1024, nullptr, lds);
    convert_wt(prm.in[17], WSB(XO_A2T), 64, 1024, 1024, nullptr, lds);
    convert_wt(prm.in[18], WSB(XO_G2T), 128, 1024, 1024, nullptr, lds);
    SYNC0(); TICK();
    GEMM_FULL(1, WSB(OFF_HN), WSB(XO_WB), NAB, D, (EpStoreBf16{WSB(OFF_Z), NAB}));
    convert_steal(prm.in[8], WSB(XO_WC), D, D, D, nullptr, CTR(0), lds);
    convert_steal<true>(prm.in[27], WSB(OFF_W), D, NUP, NUP, prm.in[26], CTR(1), lds);
    SYNC(); TICK();
    mixer_ab_phase(WSB(OFF_Z), prm.in[3], prm.in[4], prm.in[5], prm.in[6], prm.in[7], WSB(OFF_ACT), lds);
    SYNC(); TICK();
    GEMM_FULL(0, WSB(OFF_ACT), WSB(XO_WC), D, D, (EpResid0{prm.in[0], prm.in[1], WSF(OFF_H), WSB(OFF_HN), SSQ(0)}));
    SYNC(); TICK();
    GEMM_FULL(1, WSB(OFF_HN), WSB(OFF_W), NUP, D, (EpGate{WSB(OFF_ACT), WSB(OFF_Z), SSQ(0), prm.in[28]}));
    convert_steal(prm.in[29], WSB(XO_WC), DFF, D, D, nullptr, CTR(2), lds);
    convert_steal(prm.in[9], WSB(XO_WB), D, NCD, NCDP, prm.in[25] + D, CTR(3), lds);
    SYNC(); TICK();
    gate_fixup_phase(WSB(OFF_Z), prm.in[28], WSB(OFF_ACT));
    SYNC(); TICK();
    GEMM_FULL(0, WSB(OFF_ACT), WSB(XO_WC), D, DFF, (EpResid{WSF(OFF_H), WSB(OFF_HN), SSQ(1)}));
    SYNC(); TICK();
    GEMM_FULL(1, WSB(OFF_HN), WSB(XO_WB), NCDP, D, (EpScaleStoreF32{WSF(OFF_Z), NCDP, SSQ(1)}));
    convert_steal(prm.in[24], WSB(XO_WC), D, D, D, nullptr, CTR(4), lds);
    convert_steal<true>(prm.in[27] + (size_t)D * NUP, WSB(OFF_W), D, NUP, NUP, prm.in[26] + D, CTR(5), lds);
    SYNC(); TICK();
    { MKCD(p) prep1_phase(p, lds); }
    SYNC(); TICK();
    { MKCD(p) small_gemm_phase(p); }
    SYNC(); TICK();
    { MKCD(p) prep2_phase(p); }
    { MKCD(p) rwkv_scan_pass<1>(p, WSF(ZO_PSI), WSF(ZO_PHI), lds); }
    SYNC(); TICK();
    { MKCD(p) rwkv_scan_pass<3>(p, WSF(ZO_PSI), WSF(ZO_PHI), lds); }
    SYNC(); TICK();
    { MKCD(p) gla_out_norm_phase(p); }
    { MKCD(p) post_phase(p); }
    SYNC(); TICK();
    GEMM_FULL(0, WSB(OFF_ACT), WSB(XO_WC), D, D, (EpResid{WSF(OFF_H), WSB(OFF_HN), SSQ(2)}));
    SYNC(); TICK();
    GEMM_FULL(1, WSB(OFF_HN), WSB(OFF_W), NUP, D, (EpGate{WSB(OFF_ACT), WSB(OFF_Z), SSQ(2), prm.in[28] + (size_t)3 * NUP}));
    convert_steal(prm.in[29] + (size_t)DFF * D, WSB(XO_WC), DFF, D, D, nullptr, CTR(6), lds);
    SYNC(); TICK();
    gate_fixup_phase(WSB(OFF_Z), prm.in[28] + (size_t)3 * NUP, WSB(OFF_ACT));
    SYNC(); TICK();
    GEMM_FULL(0, WSB(OFF_ACT), WSB(XO_WC), D, DFF, (EpAddF32{WSF(OFF_H), D}));
    SYNC(); TICK();
    rms_phase<2>(WSF(OFF_H), nullptr, nullptr, nullptr, prm.in[30], nullptr, prm.out);
#if PROBE_MASK
    TICK();
    if (blockIdx.x == 0) { const unsigned long long t0 = __builtin_amdgcn_s_memrealtime(); while (__builtin_amdgcn_s_memrealtime() - t0 < tacc) __builtin_amdgcn_s_sleep(8); }
#endif
}

extern "C" void kernel_launch(void* const* d_in, const int* in_sizes, int n_in, void* d_out, int out_size, void* d_ws, size_t ws_size, hipStream_t stream) {
    static int grid_blocks = 0;
    if (!grid_blocks) {
        if (n_in != 31 || ws_size < WS_END) { fprintf(stderr, "kernel_launch: expected 31 inputs and >= %zu bytes of workspace (got %d, %zu)\n", (size_t)WS_END, n_in, ws_size); grid_blocks = -1; return; }
        int dev = 0, cus = 0, per_cu = 0;
        hipGetDevice(&dev);
        hipDeviceGetAttribute(&cus, hipDeviceAttributeMultiprocessorCount, dev);
        hipFuncSetAttribute((const void*)fwd_megakernel, hipFuncAttributeMaxDynamicSharedMemorySize, LDS_BYTES);
        hipOccupancyMaxActiveBlocksPerMultiprocessor(&per_cu, (const void*)fwd_megakernel, NTHREADS, LDS_BYTES);
        if (per_cu < 1) per_cu = 1;
        if (per_cu > 1) per_cu = 1;
        (void)hipGetLastError();
        grid_blocks = cus * per_cu;
    }
    if (grid_blocks < 0) return;
    Params p{};
    for (int i = 0; i < 31; ++i) p.in[i] = (const float*)d_in[i];
    p.out = (float*)d_out; p.ws = (unsigned char*)d_ws;
    void* args[] = {&p};
    hipError_t e = hipLaunchCooperativeKernel((const void*)fwd_megakernel, dim3(grid_blocks), dim3(NTHREADS), args, LDS_BYTES, stream);
    if (e != hipSuccess) fprintf(stderr, "cooperative launch failed: %s (grid %d)\n", hipGetErrorString(e), grid_blocks);
}
```

```cpp
#include <hip/hip_runtime.h>
#include <hip/hip_cooperative_groups.h>
#include <cstdio>
namespace cg = cooperative_groups;

#define LAS __attribute__((address_space(3)))
typedef unsigned short bf16_t;
typedef short bf16x8 __attribute__((ext_vector_type(8)));
typedef float f32x4 __attribute__((ext_vector_type(4)));
typedef float f32x2 __attribute__((ext_vector_type(2)));
typedef unsigned u32x4 __attribute__((ext_vector_type(4)));
typedef unsigned u32x2 __attribute__((ext_vector_type(2)));

constexpr int D = 2048, L = 2064, NBATCH = 4, SEQ = 2048, NMETA = 16, M = NBATCH * L  , MBIG = 8192;
constexpr int DFF = 5632, NUP = 2 * DFF, NAB = 5120, NCD = 6416, NCDP = 6656;
constexpr int NCH = 33;
constexpr int NGI = NBATCH * 4 * NCH;
constexpr int LDS_ST_OFF = 139264;
constexpr int LDS_BYTES = LDS_ST_OFF + 16;
constexpr int NTHREADS = 512;

constexpr size_t al256(size_t x) { return (x + 255) & ~(size_t)255; }
constexpr size_t OFF_H = 0;
constexpr size_t OFF_W = OFF_H + al256((size_t)M * D * 4);
constexpr size_t OFF_HN = OFF_W + al256((size_t)NUP * D * 2);
constexpr size_t OFF_Z = OFF_HN + al256((size_t)M * D * 2);
constexpr size_t OFF_ACT = OFF_Z + al256((size_t)M * NCDP * 4);
constexpr size_t OFF_X = OFF_ACT + al256((size_t)M * DFF * 2);
constexpr size_t SZ_M1024F = al256((size_t)M * 1024 * 4);
constexpr size_t XO_R = OFF_X;
constexpr size_t XO_KR = XO_R + SZ_M1024F;
constexpr size_t XO_VR = XO_KR + SZ_M1024F;
constexpr size_t XO_G = XO_VR + SZ_M1024F;
constexpr size_t XO_Y = OFF_HN;
constexpr size_t XO_LW = XO_G + SZ_M1024F;
constexpr size_t XO_LA = XO_LW + al256((size_t)M * 64 * 2);
constexpr size_t XO_LG = XO_LA + al256((size_t)M * 64 * 2);
constexpr size_t XO_GATE = XO_LG + al256((size_t)M * 128 * 2);
constexpr size_t XO_QDEC = XO_GATE + al256((size_t)M * 1024 * 2);
constexpr size_t XO_KDEC = XO_QDEC + al256((size_t)NGI * 64 * 128 * 2);
constexpr size_t XO_K2T = XO_KDEC + al256((size_t)NGI * 64 * 128 * 2);
constexpr size_t XO_VT = XO_K2T + al256((size_t)NGI * 64 * 128 * 2);
constexpr size_t XO_CDEC = XO_VT + al256((size_t)NGI * 256 * 64 * 2);
constexpr size_t XO_BONUS = XO_CDEC + al256((size_t)NGI * 128 * 4);
constexpr size_t XO_W2T = XO_BONUS + al256((size_t)M * 16 * 4);
constexpr size_t XO_A2T = XO_W2T + al256((size_t)1024 * 64 * 2);
constexpr size_t XO_G2T = XO_A2T + al256((size_t)1024 * 64 * 2);
constexpr size_t XO_BAR = XO_G2T + al256((size_t)1024 * 128 * 2);
constexpr int BAR_WORDS = 3456 + 64;
constexpr size_t XO_SS = XO_BAR + al256((size_t)BAR_WORDS * 4);
constexpr size_t XO_WB = XO_SS + al256((size_t)3 * M * 4);
constexpr size_t XO_WC = XO_WB + al256((size_t)NCDP * D * 2);
constexpr size_t WS_END = XO_WC + al256((size_t)D * DFF * 2);
constexpr size_t ZO_DECAY = OFF_Z;
constexpr size_t ZO_A = ZO_DECAY + SZ_M1024F;
constexpr size_t ZO_KK = ZO_A + SZ_M1024F;
constexpr size_t ZO_O = ZO_KK + SZ_M1024F;
constexpr size_t ZO_CST = ZO_O + SZ_M1024F;
constexpr size_t ZO_SPT = ZO_CST + al256((size_t)NGI * 256 * 128 * 2);
constexpr size_t ZO_P = ZO_SPT + al256((size_t)NGI * 256 * 128 * 2);
constexpr size_t ZO_END = ZO_P + al256((size_t)NGI * 64 * 64 * 2);
constexpr size_t ZO_PSI = ZO_END;
constexpr size_t ZO_PHI = ZO_PSI + al256((size_t)256 * 4096 * 4);
static_assert(ZO_PHI + al256((size_t)256 * 4096 * 4) <= OFF_ACT, "Z sub-regions overflow");
static_assert(SZ_M1024F <= (size_t)M * D * 2 + 256, "Y must fit in HN");

__device__ __forceinline__ float bf2f(unsigned b) { return __uint_as_float(b << 16); }
__device__ __forceinline__ unsigned f2bf(float f) { unsigned u = __float_as_uint(f); u += 0x7FFFu + ((u >> 16) & 1u); return u >> 16; }
typedef __bf16 bf16x2_t __attribute__((ext_vector_type(2)));
__device__ __forceinline__ unsigned pk2(float lo, float hi) { const f32x2 v = (f32x2){lo, hi}; const bf16x2_t b = __builtin_convertvector(v, bf16x2_t); return __builtin_bit_cast(unsigned, b); }
__device__ __forceinline__ float lo_f(unsigned w) { return __uint_as_float(w << 16); }
__device__ __forceinline__ float hi_f(unsigned w) { return __uint_as_float(w & 0xffff0000u); }
__device__ __forceinline__ float sigm(float x) { return 1.0f / (1.0f + expf(-x)); }
__device__ __forceinline__ float silu(float x) { return x * sigm(x); }
__device__ __forceinline__ float fsigm(float x) { return __builtin_amdgcn_rcpf(1.0f + __builtin_amdgcn_exp2f(x * -1.4426950408889634f)); }
__device__ __forceinline__ float fsilu(float x) { return x * fsigm(x); }
__device__ __forceinline__ float logsig(float x) { return fminf(x, 0.f) - log1pf(expf(-fabsf(x))); }
__device__ __forceinline__ float wave_sum(float v) {
#pragma unroll
    for (int o = 32; o >= 1; o >>= 1) v += __shfl_xor(v, o);
    return v;
}
__device__ __forceinline__ float sum16(float v) {
#pragma unroll
    for (int o = 8; o >= 1; o >>= 1) v += __shfl_xor(v, o);
    return v;
}
__device__ __forceinline__ float quad_sum(float x) {
    x += __int_as_float(__builtin_amdgcn_update_dpp(0, __float_as_int(x), 0xB1, 0xF, 0xF, false));
    x += __int_as_float(__builtin_amdgcn_update_dpp(0, __float_as_int(x), 0x4E, 0xF, 0xF, false));
    return x;
}


#define XB_TMO      128
#define XB_XCNT(j)  (256  + 64 * (j))
#define XB_XSUB(j)  (1280 + 64 * (j))
#define XB_XGEN(j)  (2304 + 64 * (j))
#define XB_TOP      3328
#define XB_TOPGEN   3392
#define XCD_BAR_WORDS 3456
#define XB_SPIN_CAP (1u << 20)
__device__ __forceinline__ unsigned xb_ld(unsigned* p)              { return __hip_atomic_load(p, __ATOMIC_RELAXED, __HIP_MEMORY_SCOPE_AGENT); }
__device__ __forceinline__ unsigned xb_add(unsigned* p, unsigned v) { return __hip_atomic_fetch_add(p, v, __ATOMIC_RELAXED, __HIP_MEMORY_SCOPE_AGENT); }
__device__ __forceinline__ unsigned xb_xcc_id() { return (unsigned)__builtin_amdgcn_s_getreg((3 << 11) | 20) & 0xFu; }
#define XB_SPIN(cond, bar) do { unsigned _sp = 0; while (cond) { __builtin_amdgcn_s_sleep(1); \
    if ((++_sp & 255u) == 0u) { if (xb_ld(&(bar)[XB_TMO])) break; if (_sp > XB_SPIN_CAP) { atomicAdd(&(bar)[XB_TMO], 1u); break; } } } } while (0)
struct XcdBarrier { unsigned* bar; unsigned x; volatile LAS unsigned* st; };
__device__ __forceinline__ XcdBarrier xcd_barrier_post(unsigned* bar, volatile LAS unsigned* st) {
    XcdBarrier b; b.bar = bar; b.x = xb_xcc_id(); b.st = st;
    if (threadIdx.x == 0) (void)xb_add(&bar[XB_XCNT(b.x)], 1u);
    return b;
}
__device__ __forceinline__ void xcd_barrier_complete(unsigned* bar, unsigned x, unsigned& nloc, unsigned& nx) {
    const unsigned G = gridDim.x * gridDim.y * gridDim.z;
    unsigned sum, cnt, mine, sp = 0u;
    for (;;) {
        sum = 0u; cnt = 0u; mine = 0u;
#pragma unroll
        for (unsigned j = 0; j < 16; ++j) { const unsigned c = xb_ld(&bar[XB_XCNT(j)]); sum += c; cnt += (c > 0u) ? 1u : 0u; mine = (j == x) ? c : mine; }
        if (sum == G) break;
        __builtin_amdgcn_s_sleep(1);
        if ((++sp & 255u) == 0u) { if (xb_ld(&bar[XB_TMO])) break; if (sp > XB_SPIN_CAP) { atomicAdd(&bar[XB_TMO], 1u); break; } }
    }
    nloc = mine > 0u ? mine : 1u; nx = cnt > 0u ? cnt : 1u;
}
__device__ __forceinline__ void xcd_barrier(const XcdBarrier& b) {
    asm volatile("s_waitcnt vmcnt(0)" ::: "memory");
    __syncthreads();
    if (threadIdx.x == 0) {
        unsigned* bar = b.bar;
        __builtin_amdgcn_s_waitcnt(0);
        unsigned nloc = b.st[0], nx = b.st[1];
        if (nloc == 0u) { xcd_barrier_complete(bar, b.x, nloc, nx); b.st[0] = nloc; b.st[1] = nx; }
        const unsigned old = xb_add(&bar[XB_XSUB(b.x)], 1u);
        const unsigned gen = old / nloc;
        if (old + 1u == (gen + 1u) * nloc) {
            __builtin_amdgcn_fence(__ATOMIC_RELEASE, "agent");
            asm volatile("s_waitcnt vmcnt(0)" ::: "memory");
            const unsigned og = xb_add(&bar[XB_TOP], 1u);
            const unsigned tg = og / nx;
            if (og + 1u == (tg + 1u) * nx) xb_add(&bar[XB_TOPGEN], 1u);
            else XB_SPIN(xb_ld(&bar[XB_TOPGEN]) == tg, bar);
            __builtin_amdgcn_fence(__ATOMIC_ACQUIRE, "agent");
            xb_add(&bar[XB_XGEN(b.x)], 1u);
            asm volatile("s_waitcnt vmcnt(0)" ::: "memory");
        } else {
            XB_SPIN(xb_ld(&bar[XB_XGEN(b.x)]) == gen, bar);
            __builtin_amdgcn_fence(__ATOMIC_ACQUIRE, "agent");
            asm volatile("s_waitcnt vmcnt(0)" ::: "memory");
        }
    }
    __syncthreads();
}

namespace pg8 {
constexpr int BM = 256, BK = 64, HALF = 128, HTB = HALF * BK * 2, NXCD = 8, WGM = 4;
__device__ __forceinline__ int lds_byte(int r, int c) { const int st = (r >> 4) * 2 + (c >> 5), rr = r & 15, cc = c & 31, ob = rr * 64 + cc * 2; return st * 1024 + (ob ^ (((ob >> 9) & 1) << 5)); }
__device__ __forceinline__ void stage_rc(int b, int& R, int& C) { const int st = b / 1024, sb = b % 1024, swz = sb ^ (((sb >> 9) & 1) << 5); R = (st >> 1) * 16 + swz / 64; C = (st & 1) * 32 + (swz % 64) / 2; }
struct Unit { int pm, pn; };
struct StaticOrder {
    int nM, nN, nwg, G, c;
    __device__ void init(int Mr, int N, int G_, int c_) { nM = Mr / BM; nN = N / BM; nwg = nM * nN; G = G_; c = c_; }
    __device__ bool next(int i, Unit& u) const {
        const long Lx = (long)i * G + c; if (Lx >= nwg) return false;
        int wgid = (int)Lx; { const int q = nwg / NXCD, r = nwg % NXCD, xcd = wgid % NXCD, off = wgid / NXCD; wgid = (xcd < r ? xcd * (q + 1) : r * (q + 1) + (xcd - r) * q) + off; }
        const int nig = WGM * nN, gid = wgid / nig, fm = gid * WGM, gsz = (nM - fm) < WGM ? (nM - fm) : WGM;
        u.pm = fm + ((wgid % nig) % gsz); u.pn = (wgid % nig) / gsz; return true;
    }
};
template <class F>
__device__ __forceinline__ void gemm_phase(LAS unsigned char* lds, const bf16_t* gA, const bf16_t* gBt, const int K, const StaticOrder& S, const F& f) {
    int tid = threadIdx.x; asm volatile("" : "+v"(tid));
    const int wid = __builtin_amdgcn_readfirstlane(tid >> 6), lane = tid & 63, wr = wid >> 2, wc = wid & 3, fr = lane & 15, fq = lane >> 4;
    const int nt = K / BK;
    unsigned voffA[2];
#pragma unroll
    for (int i = 0; i < 2; ++i) { int R, C; stage_rc(tid * 16 + i * 8192, R, C); voffA[i] = (unsigned)(R * K + C) * 2u; }
    const size_t kstep = (size_t)(BK * 2);
    const size_t hstep = (size_t)HALF * K * 2;
    const size_t tstep = 2 * hstep;
    const unsigned ldsw = (unsigned)wid * 1024u;
    const int aoff = lds_byte(wr * 64 + fr, fq * 8), boff = lds_byte(wc * 32 + fr, fq * 8);
#define PG8_SA(b, h) (((b) * 2 + (h)) * HTB)
#define PG8_SB(b, h) ((4 + (b) * 2 + (h)) * HTB)
#define PG8_STAGE(bufoff, gbase, voff) do { _Pragma("unroll") for (int _i = 0; _i < 2; ++_i) \
        __builtin_amdgcn_global_load_lds((const unsigned*)((const char*)(gbase) + (voff)[_i]), (LAS unsigned*)(lds + (bufoff) + ldsw + _i * 8192), 16, 0, 0); } while (0)
#define PG8_LDA(dst, b, h) do { _Pragma("unroll") for (int m = 0; m < 4; ++m) _Pragma("unroll") for (int k = 0; k < 2; ++k) dst[m][k] = *(const LAS bf16x8*)(lds + PG8_SA(b, h) + aoff + m * 2048 + k * 1024); } while (0)
#define PG8_LDB(dst, b, h) do { _Pragma("unroll") for (int n = 0; n < 2; ++n) _Pragma("unroll") for (int k = 0; k < 2; ++k) dst[n][k] = *(const LAS bf16x8*)(lds + PG8_SB(b, h) + boff + n * 2048 + k * 1024); } while (0)
#define PG8_MMA(ai, bj, At, Bt) do { __builtin_amdgcn_s_setprio(1); _Pragma("unroll") for (int m = 0; m < 4; ++m) _Pragma("unroll") for (int n = 0; n < 2; ++n) _Pragma("unroll") for (int k = 0; k < 2; ++k) \
        acc[ai][bj][m][n] = __builtin_amdgcn_mfma_f32_16x16x32_bf16(Bt[n][k], At[m][k], acc[ai][bj][m][n], 0, 0, 0); __builtin_amdgcn_s_setprio(0); } while (0)
#define PG8_WAIT_V(n) asm volatile("s_waitcnt vmcnt(" #n ")" ::: "memory")
#define PG8_WAIT_L(n) asm volatile("s_waitcnt lgkmcnt(" #n ")" ::: "memory")
#define PG8_BAR __builtin_amdgcn_s_barrier()
#define PG8_SCHED __builtin_amdgcn_sched_barrier(0)
    Unit cur, nxt; int ui = 0;
    if (!S.next(0, cur)) return;
    f32x4 acc[2][2][4][2];
#pragma unroll
    for (int a = 0; a < 2; ++a)
#pragma unroll
        for (int b = 0; b < 2; ++b)
#pragma unroll
            for (int m = 0; m < 4; ++m)
#pragma unroll
                for (int n = 0; n < 2; ++n) acc[a][b][m][n] = (f32x4){0.f, 0.f, 0.f, 0.f};
    bf16x8 At[4][2], B0[2][2], B1[2][2];
    const char* cA = (const char*)gA + (size_t)cur.pm * tstep; const char* cB = (const char*)gBt + (size_t)cur.pn * tstep;
    PG8_STAGE(PG8_SB(0, 0), cB, voffA); PG8_STAGE(PG8_SA(0, 0), cA, voffA); PG8_STAGE(PG8_SB(0, 1), cB + hstep, voffA); PG8_STAGE(PG8_SA(0, 1), cA + hstep, voffA);
    if (wr == 1) PG8_BAR;
    PG8_WAIT_V(4); PG8_BAR;
    PG8_STAGE(PG8_SB(1, 0), cB + kstep, voffA); PG8_STAGE(PG8_SA(1, 0), cA + kstep, voffA); PG8_STAGE(PG8_SB(1, 1), cB + hstep + kstep, voffA);
    PG8_WAIT_V(6); PG8_BAR;
    for (;;) {
        const bool has_next = S.next(ui + 1, nxt);
        const char* nA = has_next ? (const char*)gA + (size_t)nxt.pm * tstep : cA; const char* nB = has_next ? (const char*)gBt + (size_t)nxt.pn * tstep : cB;
        for (int t = 0; t < nt; t += 2) {
            const bool last = (t == nt - 2);
            const char* a1 = cA + (size_t)(t + 1) * kstep;
            const char* a2 = last ? nA : cA + (size_t)(t + 2) * kstep; const char* b2 = last ? nB : cB + (size_t)(t + 2) * kstep;
            const char* a3 = a2 + kstep; const char* b3 = b2 + kstep;
            PG8_LDB(B0, 0, 0); PG8_SCHED; PG8_LDA(At, 0, 0); PG8_STAGE(PG8_SA(1, 1), a1 + hstep, voffA);
            PG8_WAIT_L(8); PG8_BAR; PG8_WAIT_L(0); PG8_MMA(0, 0, At, B0); PG8_BAR; PG8_SCHED;
            PG8_LDB(B1, 0, 1); PG8_STAGE(PG8_SB(0, 0), b2, voffA);
            PG8_BAR; PG8_WAIT_L(0); PG8_MMA(0, 1, At, B1); PG8_BAR;
            PG8_LDA(At, 0, 1); PG8_STAGE(PG8_SA(0, 0), a2, voffA);
            PG8_BAR; PG8_WAIT_L(0); PG8_MMA(1, 0, At, B0); PG8_BAR; PG8_SCHED;
            PG8_STAGE(PG8_SB(0, 1), b2 + hstep, voffA);
            PG8_WAIT_V(6); PG8_BAR; PG8_MMA(1, 1, At, B1); PG8_BAR;
            PG8_LDB(B0, 1, 0); PG8_SCHED; PG8_LDA(At, 1, 0); PG8_STAGE(PG8_SA(0, 1), a2 + hstep, voffA);
            PG8_WAIT_L(8); PG8_BAR; PG8_WAIT_L(0); PG8_MMA(0, 0, At, B0); PG8_BAR; PG8_SCHED;
            PG8_LDB(B1, 1, 1); PG8_STAGE(PG8_SB(1, 0), b3, voffA);
            PG8_BAR; PG8_WAIT_L(0); PG8_MMA(0, 1, At, B1); PG8_BAR;
            PG8_LDA(At, 1, 1); PG8_STAGE(PG8_SA(1, 0), a3, voffA);
            PG8_BAR; PG8_WAIT_L(0); PG8_MMA(1, 0, At, B0); PG8_BAR; PG8_SCHED;
            PG8_STAGE(PG8_SB(1, 1), b3 + hstep, voffA);
            PG8_WAIT_V(6); PG8_BAR; PG8_MMA(1, 1, At, B1); PG8_BAR;
        }
        if constexpr (F::GATE) { f.tile(acc, cur.pm, cur.pn, wr, wc, fr, fq); }
        else {
            const int row0 = cur.pm * BM + wr * 64 + fr, col0 = cur.pn * BM + wc * 32 + 4 * fq;
            float sc[2][4];
#pragma unroll
            for (int ai = 0; ai < 2; ++ai)
#pragma unroll
                for (int m = 0; m < 4; ++m) sc[ai][m] = f.begin(row0 + ai * HALF + m * 16);
#pragma unroll
            for (int ai = 0; ai < 2; ++ai) {
                f32x4 hv[4][2][2];
#pragma unroll
                for (int m = 0; m < 4; ++m)
#pragma unroll
                    for (int bj = 0; bj < 2; ++bj)
#pragma unroll
                        for (int n = 0; n < 2; ++n) hv[m][bj][n] = f.pre(row0 + ai * HALF + m * 16, col0 + bj * HALF + n * 16);
#pragma unroll
                for (int m = 0; m < 4; ++m) {
                    const int row = row0 + ai * HALF + m * 16;
                    float ssq = 0.f;
#pragma unroll
                    for (int bj = 0; bj < 2; ++bj)
#pragma unroll
                        for (int n = 0; n < 2; ++n) ssq += f(row, col0 + bj * HALF + n * 16, acc[ai][bj][m][n], hv[m][bj][n], sc[ai][m]);
                    f.end(row, ssq, 0);
                }
            }
        }
        if (!has_next) break;
#pragma unroll
        for (int a = 0; a < 2; ++a)
#pragma unroll
            for (int b = 0; b < 2; ++b)
#pragma unroll
                for (int m = 0; m < 4; ++m)
#pragma unroll
                    for (int n = 0; n < 2; ++n) acc[a][b][m][n] = (f32x4){0.f, 0.f, 0.f, 0.f};
        cur = nxt; cA = nA; cB = nB; ++ui;
    }
    PG8_WAIT_V(0);
    if (wr == 0) PG8_BAR;
    PG8_BAR;
#undef PG8_SA
#undef PG8_SB
#undef PG8_STAGE
#undef PG8_LDA
#undef PG8_LDB
#undef PG8_MMA
#undef PG8_WAIT_V
#undef PG8_WAIT_L
#undef PG8_BAR
#undef PG8_SCHED
}
}

template <int UNR>
__device__ __forceinline__ void wave_tile_mma(const bf16_t* __restrict__ A, int lda, const bf16_t* __restrict__ Bt, int ldb, int k0, int k1, f32x4 (&acc)[4][4], int fr, int fq) {
    const bf16_t* ap = A + (size_t)fr * lda + fq * 8;
    const bf16_t* bp = Bt + (size_t)fr * ldb + fq * 8;
    int k = k0;
#pragma unroll 1
    for (; k + 32 * UNR <= k1; k += 32 * UNR) {
        bf16x8 a[UNR][4], b[UNR][4];
#pragma unroll
        for (int u = 0; u < UNR; ++u)
#pragma unroll
            for (int i = 0; i < 4; ++i) { a[u][i] = *(const bf16x8*)(ap + (size_t)i * 16 * lda + k + 32 * u); b[u][i] = *(const bf16x8*)(bp + (size_t)i * 16 * ldb + k + 32 * u); }
#pragma unroll
        for (int u = 0; u < UNR; ++u)
#pragma unroll
            for (int mi = 0; mi < 4; ++mi)
#pragma unroll
                for (int ni = 0; ni < 4; ++ni) acc[mi][ni] = __builtin_amdgcn_mfma_f32_16x16x32_bf16(b[u][ni], a[u][mi], acc[mi][ni], 0, 0, 0);
    }
#pragma unroll 1
    for (; k < k1; k += 32) {
        bf16x8 a[4], b[4];
#pragma unroll
        for (int i = 0; i < 4; ++i) { a[i] = *(const bf16x8*)(ap + (size_t)i * 16 * lda + k); b[i] = *(const bf16x8*)(bp + (size_t)i * 16 * ldb + k); }
#pragma unroll
        for (int mi = 0; mi < 4; ++mi)
#pragma unroll
            for (int ni = 0; ni < 4; ++ni) acc[mi][ni] = __builtin_amdgcn_mfma_f32_16x16x32_bf16(b[ni], a[mi], acc[mi][ni], 0, 0, 0);
    }
}
__device__ __forceinline__ void zero_acc(f32x4 (&acc)[4][4]) {
#pragma unroll
    for (int i = 0; i < 4; ++i)
#pragma unroll
        for (int j = 0; j < 4; ++j) acc[i][j] = (f32x4){0.f, 0.f, 0.f, 0.f};
}

template <class F>
__device__ __forceinline__ void gemm_rem_phase(LAS unsigned char* lds, const bf16_t* A, const bf16_t* Bt, int N, int K, const F& f) {
    const int tid = threadIdx.x, wid = __builtin_amdgcn_readfirstlane(tid >> 6), lane = tid & 63, fr = lane & 15, fq = lane >> 4;
    const int ntiles = N / 64, kw = K / 8;
    for (int tile = (int)gridDim.x - 1 - (int)blockIdx.x; tile < ntiles; tile += gridDim.x) {
        const int n0 = tile * 64;
        f32x4 acc[4][4]; zero_acc(acc);
        wave_tile_mma<4>(A + (size_t)MBIG * K, K, Bt + (size_t)n0 * K, K, wid * kw, (wid + 1) * kw, acc, fr, fq);
        LAS float* P = (LAS float*)lds + wid * 4096;
#pragma unroll
        for (int mi = 0; mi < 4; ++mi)
#pragma unroll
            for (int ni = 0; ni < 4; ++ni) *(LAS f32x4*)(P + ((mi * 4 + ni) * 64 + lane) * 4) = acc[mi][ni];
        __syncthreads();
#pragma unroll
        for (int i = 0; i < 2; ++i) {
            const int fg = wid + 8 * i, r = (fg >> 2) * 16 + fr, c4 = (fg & 3) * 16 + fq * 4;
            f32x4 s = (f32x4){0.f, 0.f, 0.f, 0.f};
#pragma unroll
            for (int w = 0; w < 8; ++w) s += *(const LAS f32x4*)((LAS float*)lds + w * 4096 + (fg * 64 + lane) * 4);
            const float sc = f.begin(MBIG + r);
            const f32x4 hv = f.pre(MBIG + r, n0 + c4);
            const float ssq = f(MBIG + r, n0 + c4, s, hv, sc);
            f.end(MBIG + r, ssq, 0);
        }
        __syncthreads();
    }
}

__device__ __forceinline__ float rstd_of(const float* SS, int row) { return rsqrtf(SS[row] * (1.0f / D) + 1e-6f); }
struct EpStoreBf16 { static constexpr bool GATE = false; bf16_t* O; int ld;
    __device__ __forceinline__ float begin(int) const { return 1.f; }
    __device__ __forceinline__ f32x4 pre(int, int) const { return (f32x4){0.f, 0.f, 0.f, 0.f}; }
    __device__ __forceinline__ float operator()(int row, int col, f32x4 v, f32x4, float) const { if (row < M) { u32x2 w; w.x = pk2(v[0], v[1]); w.y = pk2(v[2], v[3]); *(u32x2*)(O + (size_t)row * ld + col) = w; } return 0.f; }
    __device__ __forceinline__ void end(int, float, int) const {} };
struct EpScaleStoreBf16 { static constexpr bool GATE = false; bf16_t* O; int ld; const float* SS;
    __device__ __forceinline__ float begin(int row) const { return rstd_of(SS, row < M ? row : M - 1); }
    __device__ __forceinline__ f32x4 pre(int, int) const { return (f32x4){0.f, 0.f, 0.f, 0.f}; }
    __device__ __forceinline__ float operator()(int row, int col, f32x4 v, f32x4, float s) const { if (row < M) { v = v * s; u32x2 w; w.x = pk2(v[0], v[1]); w.y = pk2(v[2], v[3]); *(u32x2*)(O + (size_t)row * ld + col) = w; } return 0.f; }
    __device__ __forceinline__ void end(int, float, int) const {} };
struct EpScaleStoreF32 { static constexpr bool GATE = false; float* O; int ld; const float* SS;
    __device__ __forceinline__ float begin(int row) const { return rstd_of(SS, row < M ? row : M - 1); }
    __device__ __forceinline__ f32x4 pre(int, int) const { return (f32x4){0.f, 0.f, 0.f, 0.f}; }
    __device__ __forceinline__ float operator()(int row, int col, f32x4 v, f32x4, float s) const { if (row < M) *(f32x4*)(O + (size_t)row * ld + col) = v * s; return 0.f; }
    __device__ __forceinline__ void end(int, float, int) const {} };
struct EpAddF32 { static constexpr bool GATE = false; float* H; int ld;
    __device__ __forceinline__ float begin(int) const { return 1.f; }
    __device__ __forceinline__ f32x4 pre(int row, int col) const { return *(const f32x4*)(H + (size_t)row * ld + col); }
    __device__ __forceinline__ float operator()(int row, int col, f32x4 v, f32x4 h, float) const { *(f32x4*)(H + (size_t)row * ld + col) = h + v; return 0.f; }
    __device__ __forceinline__ void end(int, float, int) const {} };
struct EpResid { static constexpr bool GATE = false; float* H; bf16_t* HB; float* SS;
    __device__ __forceinline__ float begin(int) const { return 1.f; }
    __device__ __forceinline__ f32x4 pre(int row, int col) const { return *(const f32x4*)(H + (size_t)row * D + col); }
    __device__ __forceinline__ float operator()(int row, int col, f32x4 v, f32x4 h0, float) const {
        const f32x4 h = h0 + v; *(f32x4*)(H + (size_t)row * D + col) = h;
        u32x2 w; w.x = pk2(h[0], h[1]); w.y = pk2(h[2], h[3]); *(u32x2*)(HB + (size_t)row * D + col) = w;
        return (h[0] * h[0] + h[1] * h[1]) + (h[2] * h[2] + h[3] * h[3]); }
    __device__ __forceinline__ void end(int row, float ssq, int kind) const {
        const int lane = threadIdx.x & 63;
        if (kind == 0) { ssq += __shfl_xor(ssq, 16); ssq += __shfl_xor(ssq, 32); if (lane < 16) atomicAdd(SS + row, ssq); }
        else { ssq = sum16(ssq); if ((lane & 15) == 0) atomicAdd(SS + row, ssq); } } };

__device__ __forceinline__ f32x4 dpp_ror(f32x4 v, const int which) {
    f32x4 o;
#pragma unroll
    for (int e = 0; e < 4; ++e) o[e] = which == 1 ? __int_as_float(__builtin_amdgcn_update_dpp(0, __float_as_int(v[e]), 0x121, 0xF, 0xF, false))
                                                  : __int_as_float(__builtin_amdgcn_update_dpp(0, __float_as_int(v[e]), 0x122, 0xF, 0xF, false));
    return o;
}
struct EpGate { static constexpr bool GATE = true; bf16_t* G; bf16_t* U; const float* SS; const float* dw;
    __device__ __forceinline__ float begin(int) const { return 1.f; }
    __device__ __forceinline__ f32x4 pre(int, int) const { return (f32x4){0.f, 0.f, 0.f, 0.f}; }
    __device__ __forceinline__ float operator()(int, int, f32x4, f32x4, float) const { return 0.f; }
    __device__ __forceinline__ void end(int, float, int) const {}
    __device__ __forceinline__ void tile(f32x4 (&acc)[2][2][4][2], int pm, int pn, int wr, int wc, int fr, int fq) const {
        const int rowb = pm * 256 + wr * 64 + fr;
        f32x4 wva[2][3], wga[2][3];
#pragma unroll
        for (int n = 0; n < 2; ++n)
#pragma unroll
            for (int j = 0; j < 3; ++j) { const int chh = pn * 128 + wc * 32 + n * 16 + 4 * fq; wva[n][j] = *(const f32x4*)(dw + j * NUP + chh); wga[n][j] = *(const f32x4*)(dw + j * NUP + DFF + chh); }
#pragma unroll
        for (int ai = 0; ai < 2; ++ai)
#pragma unroll
            for (int m = 0; m < 4; ++m) {
                const int row = rowb + ai * 128 + m * 16;
                const float s = rstd_of(SS, row < M ? row : M - 1);
#pragma unroll
                for (int bj = 0; bj < 2; ++bj)
#pragma unroll
                    for (int n = 0; n < 2; ++n) acc[ai][bj][m][n] = acc[ai][bj][m][n] * s;
            }
#pragma unroll
        for (int n = 0; n < 2; ++n) {
            const int ch = pn * 128 + wc * 32 + n * 16 + 4 * fq;
            const int ucol = pn * 256 + wc * 32 + n * 16 + 4 * fq;
            f32x4 wv[3], wg[3];
#pragma unroll
            for (int j = 0; j < 3; ++j) { wv[j] = wva[n][j]; wg[j] = wga[n][j]; }
#pragma unroll
            for (int ai = 0; ai < 2; ++ai)
#pragma unroll
                for (int m = 0; m < 4; ++m) {
                    const int row = rowb + ai * 128 + m * 16;
                    const f32x4 cv = acc[ai][0][m][n], cg = acc[ai][1][m][n];
                    const f32x4 zv = (f32x4){0.f, 0.f, 0.f, 0.f};
                    const f32x4 pv = m > 0 ? acc[ai][0][m > 0 ? m - 1 : 0][n] : zv, pg = m > 0 ? acc[ai][1][m > 0 ? m - 1 : 0][n] : zv;
                    f32x4 v1 = dpp_ror(fr == 15 ? pv : cv, 1), v2 = dpp_ror(fr >= 14 ? pv : cv, 2);
                    f32x4 g1 = dpp_ror(fr == 15 ? pg : cg, 1), g2 = dpp_ror(fr >= 14 ? pg : cg, 2);
                    const int t = row % L;
                    if (t == 0) { v1 = zv; g1 = zv; }
                    if (t <= 1) { v2 = zv; g2 = zv; }
                    const f32x4 val = v2 * wv[0] + v1 * wv[1] + cv * wv[2], gat = g2 * wg[0] + g1 * wg[1] + cg * wg[2];
                    const bool edge_lo = (m == 0 && fr < 2), edge_hi = (m == 3 && fr >= 14);
                    if (row < M) {
                        if (!edge_lo) {
                            u32x2 w; w.x = pk2(fsilu(gat[0]) * val[0], fsilu(gat[1]) * val[1]); w.y = pk2(fsilu(gat[2]) * val[2], fsilu(gat[3]) * val[3]);
                            *(u32x2*)(G + (size_t)row * DFF + ch) = w;
                        }
                        if (edge_lo || edge_hi) {
                            u32x2 a, b; a.x = pk2(cv[0], cv[1]); a.y = pk2(cv[2], cv[3]); b.x = pk2(cg[0], cg[1]); b.y = pk2(cg[2], cg[3]);
                            *(u32x2*)(U + (size_t)row * NUP + ucol) = a; *(u32x2*)(U + (size_t)row * NUP + ucol + 128) = b;
                        }
                    }
                }
        }
    }
};
__device__ __forceinline__ void gate_fixup_phase(const bf16_t* __restrict__ U, const float* __restrict__ dw, bf16_t* __restrict__ G) {
    const int gtid = blockIdx.x * NTHREADS + threadIdx.x, nth = gridDim.x * NTHREADS;
    constexpr int NC4 = DFF / 4, NBLK = M / 64;
    for (int idx = gtid; idx < NBLK * 2 * NC4; idx += nth) {
        const int c4 = idx % NC4, rr = (idx / NC4) & 1, blk = idx / (2 * NC4);
        const int row = blk * 64 + rr, t = row % L, ch = c4 * 4;
        const int ucol = (ch >> 7) * 256 + (ch & 127);
        f32x4 val = (f32x4){0.f, 0.f, 0.f, 0.f}, gat = val;
#pragma unroll
        for (int j = 0; j < 3; ++j) {
            if (t - 2 + j >= 0) {
                const bf16_t* ur = U + (size_t)(row - 2 + j) * NUP + ucol;
                const u32x2 a = *(const u32x2*)(ur), b = *(const u32x2*)(ur + 128);
                const f32x4 wv = *(const f32x4*)(dw + j * NUP + ch), wg = *(const f32x4*)(dw + j * NUP + DFF + ch);
                val += (f32x4){lo_f(a.x), hi_f(a.x), lo_f(a.y), hi_f(a.y)} * wv; gat += (f32x4){lo_f(b.x), hi_f(b.x), lo_f(b.y), hi_f(b.y)} * wg;
            }
        }
        u32x2 w; w.x = pk2(fsilu(gat[0]) * val[0], fsilu(gat[1]) * val[1]); w.y = pk2(fsilu(gat[2]) * val[2], fsilu(gat[3]) * val[3]);
        *(u32x2*)(G + (size_t)row * DFF + ch) = w;
    }
}

struct EpResid0 { static constexpr bool GATE = false; const float* x; const float* meta; float* H; bf16_t* HB; float* SS;
    __device__ __forceinline__ float begin(int) const { return 1.f; }
    __device__ __forceinline__ f32x4 pre(int row, int col) const { const int b = row / L, t = row - b * L;
        return *(const f32x4*)((t < NMETA ? meta + (size_t)t * D : x + ((size_t)b * SEQ + (t - NMETA)) * D) + col); }
    __device__ __forceinline__ float operator()(int row, int col, f32x4 v, f32x4 h0, float) const {
        const f32x4 h = h0 + v; *(f32x4*)(H + (size_t)row * D + col) = h;
        u32x2 w; w.x = pk2(h[0], h[1]); w.y = pk2(h[2], h[3]); *(u32x2*)(HB + (size_t)row * D + col) = w;
        return (h[0] * h[0] + h[1] * h[1]) + (h[2] * h[2] + h[3] * h[3]); }
    __device__ __forceinline__ void end(int row, float ssq, int kind) const {
        const int lane = threadIdx.x & 63;
        if (kind == 0) { ssq += __shfl_xor(ssq, 16); ssq += __shfl_xor(ssq, 32); if (lane < 16) atomicAdd(SS + row, ssq); }
        else { ssq = sum16(ssq); if ((lane & 15) == 0) atomicAdd(SS + row, ssq); } } };

template <class F>
__device__ __forceinline__ void gemm_full(LAS unsigned char* lds, const bf16_t* A, const bf16_t* Bt, int N, int K, const F& f) {
    pg8::StaticOrder S; S.init(MBIG, N, (int)gridDim.x, (int)blockIdx.x);
    pg8::gemm_phase(lds, A, Bt, K, S, f);
    gemm_rem_phase(lds, A, Bt, N, K, f);
}

__device__ __forceinline__ void convert_item(const float* __restrict__ src, bf16_t* __restrict__ dst, int K, int N, const float* __restrict__ gain, int item, int lane) {
    const int tk = K / 64;
    const int kk0 = (item % tk) * 64 + (lane & 7) * 8, n4 = (item / tk) * 32 + (lane >> 3) * 4;
    f32x4 v[8];
#pragma unroll
    for (int i = 0; i < 8; ++i) v[i] = (n4 < N) ? *(const f32x4*)(src + (size_t)(kk0 + i) * N + n4) : (f32x4){0.f, 0.f, 0.f, 0.f};
    if (gain) {
        const f32x4 g0 = *(const f32x4*)(gain + kk0), g1 = *(const f32x4*)(gain + kk0 + 4);
#pragma unroll
        for (int i = 0; i < 4; ++i) { v[i] = v[i] * g0[i]; v[4 + i] = v[4 + i] * g1[i]; }
    }
#pragma unroll
    for (int e = 0; e < 4; ++e) {
        u32x4 w; w.x = pk2(v[0][e], v[1][e]); w.y = pk2(v[2][e], v[3][e]); w.z = pk2(v[4][e], v[5][e]); w.w = pk2(v[6][e], v[7][e]);
        *(u32x4*)(dst + (size_t)(n4 + e) * K + kk0) = w;
    }
}
__device__ __forceinline__ void convert_wt(const float* __restrict__ src, bf16_t* __restrict__ dst, int K, int N, int Npad, const float* __restrict__ gain, LAS unsigned char* lds) {
    const int nitems = (K / 64) * (Npad / 32), lane = threadIdx.x & 63;
    for (int it = blockIdx.x * 8 + (threadIdx.x >> 6); it < nitems; it += gridDim.x * 8) convert_item(src, dst, K, N, gain, it, lane);
}
__device__ __forceinline__ int up_src_col(int n) { return ((n & 128) ? DFF : 0) + ((n >> 8) << 7) + (n & 127); }
template <bool PERMUP>
__device__ __forceinline__ void convert_item2(const float* __restrict__ src, bf16_t* __restrict__ dst, int K, int N, const float* __restrict__ gain, int itemA, int itemB, bool hasB, int lane) {
    const int tk = K / 64;
    int kk0[2], n4[2];
    kk0[0] = (itemA % tk) * 64 + (lane & 7) * 8; n4[0] = (itemA / tk) * 32 + (lane >> 3) * 4;
    const int ib = hasB ? itemB : itemA;
    kk0[1] = (ib % tk) * 64 + (lane & 7) * 8; n4[1] = (ib / tk) * 32 + (lane >> 3) * 4;
    f32x4 v[2][8];
#pragma unroll
    for (int u = 0; u < 2; ++u)
#pragma unroll
        for (int i = 0; i < 8; ++i) v[u][i] = (n4[u] < N) ? *(const f32x4*)(src + (size_t)(kk0[u] + i) * N + (PERMUP ? up_src_col(n4[u]) : n4[u])) : (f32x4){0.f, 0.f, 0.f, 0.f};
#pragma unroll
    for (int u = 0; u < 2; ++u) {
        if (u == 1 && !hasB) break;
        if (gain) {
            const f32x4 g0 = *(const f32x4*)(gain + kk0[u]), g1 = *(const f32x4*)(gain + kk0[u] + 4);
#pragma unroll
            for (int i = 0; i < 4; ++i) { v[u][i] = v[u][i] * g0[i]; v[u][4 + i] = v[u][4 + i] * g1[i]; }
        }
#pragma unroll
        for (int e = 0; e < 4; ++e) {
            u32x4 w; w.x = pk2(v[u][0][e], v[u][1][e]); w.y = pk2(v[u][2][e], v[u][3][e]); w.z = pk2(v[u][4][e], v[u][5][e]); w.w = pk2(v[u][6][e], v[u][7][e]);
            *(u32x4*)(dst + (size_t)(n4[u] + e) * K + kk0[u]) = w;
        }
    }
}
template <bool PERMUP = false>
__device__ __forceinline__ void convert_steal(const float* __restrict__ src, bf16_t* __restrict__ dst, int K, int N, int Npad, const float* __restrict__ gain, unsigned* ctr, LAS unsigned char* lds) {
    const int nitems = (K / 64) * (Npad / 32), lane = threadIdx.x & 63, wid = threadIdx.x >> 6;
    volatile LAS unsigned* slot = (volatile LAS unsigned*)(lds + LDS_ST_OFF + 8);
    if (threadIdx.x == 0) *slot = __hip_atomic_fetch_add(ctr, 64u, __ATOMIC_RELAXED, __HIP_MEMORY_SCOPE_AGENT);
    __syncthreads();
    int t0 = (int)*slot;
    __syncthreads();
    while (t0 < nitems) {
        unsigned nxt = 0u;
        if (threadIdx.x == 0) nxt = __hip_atomic_fetch_add(ctr, 64u, __ATOMIC_RELAXED, __HIP_MEMORY_SCOPE_AGENT);
#pragma unroll 1
        for (int q = 0; q < 8; q += 2) {
            const int ia = t0 + wid + 8 * q, ib = ia + 8;
            if (ia < nitems) convert_item2<PERMUP>(src, dst, K, N, gain, ia, ib, ib < nitems, lane);
        }
        if (threadIdx.x == 0) *slot = nxt;
        __syncthreads();
        t0 = (int)*slot;
        __syncthreads();
    }
}

template <int MODE>
__device__ __forceinline__ void rms_phase(const float* __restrict__ h_in, float* __restrict__ h_out, const float* __restrict__ x, const float* __restrict__ meta,
                          const float* __restrict__ gain, bf16_t* __restrict__ hn, float* __restrict__ out) {
    const int lane = threadIdx.x & 63, gw = blockIdx.x * 8 + (threadIdx.x >> 6), nw = gridDim.x * 8;
    for (int row = gw; row < M; row += nw) {
        const int b = row / L, t = row - b * L;
        if (MODE == 2 && t < NMETA) continue;
        const float* src;
        if (MODE == 1) src = (t < NMETA) ? meta + (size_t)t * D : x + ((size_t)b * SEQ + (t - NMETA)) * D;
        else src = h_in + (size_t)row * D;
        f32x4 v[8]; float ss = 0.f;
#pragma unroll
        for (int i = 0; i < 8; ++i) { v[i] = *(const f32x4*)(src + (lane + i * 64) * 4); ss += v[i][0] * v[i][0] + v[i][1] * v[i][1] + v[i][2] * v[i][2] + v[i][3] * v[i][3]; }
        ss = wave_sum(ss);
        const float r = rsqrtf(ss * (1.0f / D) + 1e-6f);
#pragma unroll
        for (int i = 0; i < 8; ++i) {
            const int c = (lane + i * 64) * 4;
            const f32x4 g = *(const f32x4*)(gain + c);
            const f32x4 o = v[i] * r * g;
            if (MODE == 2) *(f32x4*)(out + ((size_t)b * SEQ + (t - NMETA)) * D + c) = o;
            else { u32x2 w; w.x = pk2(o[0], o[1]); w.y = pk2(o[2], o[3]); *(u32x2*)(hn + (size_t)row * D + c) = w; }
        }
    }
}

__device__ __forceinline__ void mixer_ab_phase(const bf16_t* __restrict__ z1, const float* __restrict__ conf_dw, const float* __restrict__ conf_b, const float* __restrict__ ln_g,
                               const float* __restrict__ ln_b, const float* __restrict__ sc_dw, bf16_t* __restrict__ cat, LAS unsigned char* lds) {
    const int tid = threadIdx.x, wid = __builtin_amdgcn_readfirstlane(tid >> 6), lane = tid & 63;
    constexpr int TT = 33, TPB = (L + TT - 1) / TT;
    LAS unsigned* S32 = (LAS unsigned*)lds;
    LAS float* C = (LAS float*)lds;
    for (int tile = blockIdx.x; tile < NBATCH * TPB; tile += gridDim.x) {
        const int b = tile / TPB, t0 = (tile % TPB) * TT;
        const int nt = (L - t0) < TT ? (L - t0) : TT;
        static_assert((TT + 30) % 7 == 0, "staging loop is unrolled by 7");
#pragma unroll 1
        for (int r0 = 0; r0 < TT + 30; r0 += 7) {
            unsigned av[7], gv[7];
#pragma unroll
            for (int u = 0; u < 7; ++u) {
                const int t = t0 - 30 + r0 + u, tc = t < 0 ? 0 : (t >= L ? L - 1 : t);
                const bf16_t* zr = z1 + (size_t)(b * L + tc) * NAB;
                av[u] = *(const unsigned*)(zr + 2 * tid); gv[u] = *(const unsigned*)(zr + 1024 + 2 * tid);
            }
#pragma unroll
            for (int u = 0; u < 7; ++u) {
                const int t = t0 - 30 + r0 + u;
                unsigned w = pk2(lo_f(av[u]) * fsigm(lo_f(gv[u])), hi_f(av[u]) * fsigm(hi_f(gv[u])));
                if (t < 0 || t >= L) w = 0u;
                S32[(r0 + u) * 512 + tid] = w;
            }
        }
        __syncthreads();
        f32x2 acc[TT];
#pragma unroll
        for (int t = 0; t < TT; ++t) acc[t] = (f32x2){0.f, 0.f};
        f32x2 wnext = *(const f32x2*)(conf_dw + 2 * tid);
#pragma unroll 1
        for (int j = 0; j < 31; ++j) {
            const f32x2 w = wnext;
            wnext = *(const f32x2*)(conf_dw + (j < 30 ? j + 1 : j) * 1024 + 2 * tid);
#pragma unroll
            for (int t = 0; t < TT; ++t) { const unsigned xw = S32[(t + j) * 512 + tid]; acc[t] += (f32x2){lo_f(xw), hi_f(xw)} * w; }
        }
        const f32x2 bias = *(const f32x2*)(conf_b + 2 * tid);
        __syncthreads();
#pragma unroll
        for (int t = 0; t < TT; ++t) *(LAS f32x2*)(C + t * 1024 + 2 * tid) = acc[t] + bias;
        __syncthreads();
        for (int q = 0; q < 5; ++q) {
            const int tt = wid + 8 * q;
            if (tt < nt) {
                f32x4 v[4]; float s = 0.f;
#pragma unroll
                for (int i = 0; i < 4; ++i) { v[i] = *(const LAS f32x4*)(C + tt * 1024 + (lane + i * 64) * 4); s += (v[i][0] + v[i][1]) + (v[i][2] + v[i][3]); }
                const float mean = wave_sum(s) * (1.0f / 1024.0f);
                float qv = 0.f;
#pragma unroll
                for (int i = 0; i < 4; ++i) { const f32x4 d = v[i] - mean; qv += d[0] * d[0] + d[1] * d[1] + d[2] * d[2] + d[3] * d[3]; }
                const float rstd = rsqrtf(wave_sum(qv) * (1.0f / 1024.0f) + 1e-5f);
                bf16_t* orow = cat + (size_t)(b * L + t0 + tt) * D;
#pragma unroll
                for (int i = 0; i < 4; ++i) {
                    const int c = (lane + i * 64) * 4;
                    const f32x4 g = *(const f32x4*)(ln_g + c), bb = *(const f32x4*)(ln_b + c);
                    const f32x4 y = (v[i] - mean) * rstd * g + bb;
                    u32x2 w; w.x = pk2(fsilu(y[0]), fsilu(y[1])); w.y = pk2(fsilu(y[2]), fsilu(y[3]));
                    *(u32x2*)(orow + c) = w;
                }
            }
        }
        __syncthreads();
    }
    const int gtid = blockIdx.x * NTHREADS + tid, nth = gridDim.x * NTHREADS;
    for (int idx = gtid; idx < M * 128; idx += nth) {
        const int row = idx >> 7, c = (idx & 127) * 8, t = row % L;
        float acc[8];
#pragma unroll
        for (int e = 0; e < 8; ++e) acc[e] = 0.f;
#pragma unroll
        for (int j = 0; j < 3; ++j) {
            if (t - 2 + j >= 0) {
                const bf16_t* zr = z1 + (size_t)(row - 2 + j) * NAB;
                const u32x4 sc = *(const u32x4*)(zr + 3072 + c), sx = *(const u32x4*)(zr + 4096 + c);
                const f32x4 w0 = *(const f32x4*)(sc_dw + j * 1024 + c), w1 = *(const f32x4*)(sc_dw + j * 1024 + c + 4);
                acc[0] += lo_f(sc.x) * lo_f(sx.x) * w0[0]; acc[1] += hi_f(sc.x) * hi_f(sx.x) * w0[1];
                acc[2] += lo_f(sc.y) * lo_f(sx.y) * w0[2]; acc[3] += hi_f(sc.y) * hi_f(sx.y) * w0[3];
                acc[4] += lo_f(sc.z) * lo_f(sx.z) * w1[0]; acc[5] += hi_f(sc.z) * hi_f(sx.z) * w1[1];
                acc[6] += lo_f(sc.w) * lo_f(sx.w) * w1[2]; acc[7] += hi_f(sc.w) * hi_f(sx.w) * w1[3];
            }
        }
        const u32x4 sb = *(const u32x4*)(z1 + (size_t)row * NAB + 2048 + c);
        u32x4 o;
        o.x = pk2(lo_f(sb.x) * acc[0], hi_f(sb.x) * acc[1]); o.y = pk2(lo_f(sb.y) * acc[2], hi_f(sb.y) * acc[3]);
        o.z = pk2(lo_f(sb.z) * acc[4], hi_f(sb.z) * acc[5]); o.w = pk2(lo_f(sb.w) * acc[6], hi_f(sb.w) * acc[7]);
        *(u32x4*)(cat + (size_t)row * D + 1024 + c) = o;
    }
}

__device__ __forceinline__ void ffn_gate_phase(const bf16_t* __restrict__ u, const float* __restrict__ dw  , bf16_t* __restrict__ g) {
    const int gtid = blockIdx.x * NTHREADS + threadIdx.x, nth = gridDim.x * NTHREADS;
    constexpr int NC8 = DFF / 8, NRUN = L / 16;
    for (int idx = gtid; idx < NBATCH * NRUN * NC8; idx += nth) {
        const int c = (idx % NC8) * 8, run = (idx / NC8) % NRUN, b = idx / (NC8 * NRUN), t0 = run * 16;
        float wv[3][8], wg[3][8];
#pragma unroll
        for (int j = 0; j < 3; ++j) {
            const f32x4 a0 = *(const f32x4*)(dw + j * NUP + c), a1 = *(const f32x4*)(dw + j * NUP + c + 4);
            const f32x4 g0 = *(const f32x4*)(dw + j * NUP + DFF + c), g1 = *(const f32x4*)(dw + j * NUP + DFF + c + 4);
#pragma unroll
            for (int e = 0; e < 4; ++e) { wv[j][e] = a0[e]; wv[j][4 + e] = a1[e]; wg[j][e] = g0[e]; wg[j][4 + e] = g1[e]; }
        }
        u32x4 v2 = (u32x4){0u, 0u, 0u, 0u}, v1 = v2, g2 = v2, g1 = v2;
        if (t0 >= 2) {
            const bf16_t* r2 = u + (size_t)(b * L + t0 - 2) * NUP; const bf16_t* r1 = r2 + NUP;
            v2 = *(const u32x4*)(r2 + c); g2 = *(const u32x4*)(r2 + DFF + c); v1 = *(const u32x4*)(r1 + c); g1 = *(const u32x4*)(r1 + DFF + c);
        }
#pragma unroll 4
        for (int i = 0; i < 16; ++i) {
            const size_t row = (size_t)(b * L + t0 + i);
            const u32x4 v0 = *(const u32x4*)(u + row * NUP + c), g0 = *(const u32x4*)(u + row * NUP + DFF + c);
            float val[8], gat[8];
#define TAP(e, W2, W1, W0, sel) \
            val[e] = sel(v2.W2) * wv[0][e] + sel(v1.W1) * wv[1][e] + sel(v0.W0) * wv[2][e]; gat[e] = sel(g2.W2) * wg[0][e] + sel(g1.W1) * wg[1][e] + sel(g0.W0) * wg[2][e];
            TAP(0, x, x, x, lo_f) TAP(1, x, x, x, hi_f) TAP(2, y, y, y, lo_f) TAP(3, y, y, y, hi_f)
            TAP(4, z, z, z, lo_f) TAP(5, z, z, z, hi_f) TAP(6, w, w, w, lo_f) TAP(7, w, w, w, hi_f)
#undef TAP
            u32x4 o;
            o.x = pk2(fsilu(gat[0]) * val[0], fsilu(gat[1]) * val[1]); o.y = pk2(fsilu(gat[2]) * val[2], fsilu(gat[3]) * val[3]);
            o.z = pk2(fsilu(gat[4]) * val[4], fsilu(gat[5]) * val[5]); o.w = pk2(fsilu(gat[6]) * val[6], fsilu(gat[7]) * val[7]);
            *(u32x4*)(g + row * DFF + c) = o;
            v2 = v1; g2 = g1; v1 = v0; g1 = g0;
        }
    }
}

struct CD {
    const float *z2, *gla_w2, *gla_b, *gla_norm_g, *rw_mu, *rw_w0, *rw_a0, *rw_kk, *rw_ka, *rw_rk, *rw_ln_g, *rw_ln_b;
    float *R, *KR, *VR, *G, *Y, *CDEC, *BONUS, *DECAY, *A, *KK, *O;
    bf16_t *LW, *LA, *LG, *GATE, *QDEC, *KDEC, *K2T, *VT, *W2T, *A2T, *G2T, *CST, *SPT, *P, *CAT;
};

__device__ __forceinline__ void prep1_phase(const CD& p, LAS unsigned char* lds) {
    const int tid = threadIdx.x, wid = __builtin_amdgcn_readfirstlane(tid >> 6), lane = tid & 63;
    LAS float* tot = (LAS float*)lds;
    for (int item = blockIdx.x; item < NGI; item += gridDim.x) {
        const int bh = item / NCH, n = item - bh * NCH, b = bh >> 2, h = bh & 3;
        const int pg = wid >> 1, d = (wid & 1) * 64 + lane;
        float w2r[16];
#pragma unroll
        for (int r = 0; r < 16; ++r) w2r[r] = p.gla_w2[r * 512 + h * 128 + d];
        const float bias = p.gla_b[h * 128 + d];
        float la[16]; float run = 0.f;
#pragma unroll
        for (int i = 0; i < 16; ++i) {
            const int t = n * 64 + pg * 16 + i - 48;
            float v = 0.f;
            if (t >= 0 && t < L) {
                const float* gl = p.z2 + (size_t)(b * L + t) * NCDP + 3072;
                float xx = bias;
#pragma unroll
                for (int r = 0; r < 16; ++r) xx += gl[r] * w2r[r];
                v = logsig(xx) * (1.0f / 16.0f);
            }
            run += v; la[i] = run;
        }
        tot[pg * 128 + d] = run;
        __syncthreads();
        float off = 0.f, last = 0.f;
#pragma unroll
        for (int g4 = 0; g4 < 4; ++g4) { const float tv = tot[g4 * 128 + d]; if (g4 < pg) off += tv; last += tv; }
        unsigned k2p[8];
#pragma unroll
        for (int i = 0; i < 16; ++i) {
            const int pp = pg * 16 + i, t = n * 64 + pp - 48;
            const float cum = off + la[i];
            float q = 0.f, k = 0.f;
            if (t >= 0 && t < L) { const float* zr = p.z2 + (size_t)(b * L + t) * NCDP; q = zr[h * 128 + d] * 0.08838834764831845f; k = zr[512 + h * 128 + d]; }
            const float qd = q * expf(cum), kd = k * expf(-cum), k2 = k * expf(last - cum);
            p.QDEC[((size_t)item * 64 + pp) * 128 + d] = (bf16_t)f2bf(qd);
            p.KDEC[((size_t)item * 64 + pp) * 128 + d] = (bf16_t)f2bf(kd);
            if (i & 1) k2p[i >> 1] |= f2bf(k2) << 16; else k2p[i >> 1] = f2bf(k2);
        }
        {
            bf16_t* dst = p.K2T + ((size_t)item * 128 + d) * 64 + pg * 16;
            *(u32x4*)(dst) = (u32x4){k2p[0], k2p[1], k2p[2], k2p[3]};
            *(u32x4*)(dst + 8) = (u32x4){k2p[4], k2p[5], k2p[6], k2p[7]};
        }
        if (pg == 0) p.CDEC[item * 128 + d] = expf(last);
        {
            const int v = tid & 255, ph = tid >> 8;
            unsigned vp[16];
#pragma unroll
            for (int i = 0; i < 32; ++i) {
                const int t = n * 64 + ph * 32 + i - 48;
                float xv = 0.f;
                if (t >= 0 && t < L) xv = p.z2[(size_t)(b * L + t) * NCDP + 1024 + h * 256 + v];
                if (i & 1) vp[i >> 1] |= f2bf(xv) << 16; else vp[i >> 1] = f2bf(xv);
            }
            bf16_t* dst = p.VT + ((size_t)item * 256 + v) * 64 + ph * 32;
#pragma unroll
            for (int s = 0; s < 4; ++s) *(u32x4*)(dst + s * 8) = (u32x4){vp[s * 4 + 0], vp[s * 4 + 1], vp[s * 4 + 2], vp[s * 4 + 3]};
        }
        __syncthreads();
    }
    const int gtid = blockIdx.x * NTHREADS + tid, nth = gridDim.x * NTHREADS;
    for (int base = gtid; base < M * 256; base += nth * 4) {
        f32x4 go[4], ng[4];
#pragma unroll
        for (int u = 0; u < 4; ++u) {
            const int idx = base + u * nth, ic = idx < M * 256 ? idx : 0, row = ic >> 8, c = (ic & 255) * 4;
            go[u] = *(const f32x4*)(p.z2 + (size_t)row * NCDP + 2048 + c); ng[u] = *(const f32x4*)(p.gla_norm_g + c);
        }
#pragma unroll
        for (int u = 0; u < 4; ++u) {
            const int idx = base + u * nth;
            if (idx < M * 256) {
                const int row = idx >> 8, c = (idx & 255) * 4;
                u32x2 w; w.x = pk2(fsilu(go[u][0]) * ng[u][0], fsilu(go[u][1]) * ng[u][1]); w.y = pk2(fsilu(go[u][2]) * ng[u][2], fsilu(go[u][3]) * ng[u][3]);
                *(u32x2*)(p.GATE + (size_t)row * 1024 + c) = w;
            }
        }
    }
    for (int base = gtid; base < M * 832; base += nth * 4) {
        f32x4 zv[4], zpv[4], muv[4];
#pragma unroll
        for (int u = 0; u < 4; ++u) {
            const int idx = base + u * nth, ic = idx < M * 832 ? idx : 0, row = ic / 832, c4 = (ic - row * 832) * 4, t = row % L;
            zv[u] = *(const f32x4*)(p.z2 + (size_t)row * NCDP + 3088 + c4);
            zpv[u] = *(const f32x4*)(p.z2 + (size_t)(t > 0 ? row - 1 : row) * NCDP + 3088 + c4);
            if (t == 0) zpv[u] = (f32x4){0.f, 0.f, 0.f, 0.f};
            muv[u] = *(const f32x4*)(p.rw_mu + c4);
        }
#pragma unroll
        for (int u = 0; u < 4; ++u) {
        const int idx = base + u * nth;
        if (idx >= M * 832) continue;
        const int row = idx / 832, c4 = (idx - row * 832) * 4;
        const f32x4 zr = zv[u] + (zpv[u] - zv[u]) * muv[u];
        if (c4 < 1024) *(f32x4*)(p.R + (size_t)row * 1024 + c4) = zr;
        else if (c4 < 2048) *(f32x4*)(p.KR + (size_t)row * 1024 + c4 - 1024) = zr;
        else if (c4 < 3072) *(f32x4*)(p.VR + (size_t)row * 1024 + c4 - 2048) = zr;
        else if (c4 < 3136) { u32x2 w; w.x = pk2(tanhf(zr[0]), tanhf(zr[1])); w.y = pk2(tanhf(zr[2]), tanhf(zr[3])); *(u32x2*)(p.LW + (size_t)row * 64 + c4 - 3072) = w; }
        else if (c4 < 3200) { u32x2 w; w.x = pk2(zr[0], zr[1]); w.y = pk2(zr[2], zr[3]); *(u32x2*)(p.LA + (size_t)row * 64 + c4 - 3136) = w; }
        else { u32x2 w; w.x = pk2(sigm(zr[0]), sigm(zr[1])); w.y = pk2(sigm(zr[2]), sigm(zr[3])); *(u32x2*)(p.LG + (size_t)row * 128 + c4 - 3200) = w; }
        }
    }
}

__device__ __forceinline__ void small_gemm_phase(const CD& p) {
    const int lane = threadIdx.x & 63, fr = lane & 15, fq = lane >> 4;
    const int gw = blockIdx.x * 8 + (threadIdx.x >> 6), nw = gridDim.x * 8;
    constexpr int TL = (M / 64) * 16;
    constexpr int T0 = 3 * TL, T1 = T0 + NGI, T2 = T1 + NGI * 8;
    for (int tix = gw; tix < T2; tix += nw) {
        f32x4 acc[4][4]; zero_acc(acc);
        if (tix < T0) {
            const int which = tix / TL, r = tix - which * TL, m0 = (r >> 4) * 64, n0 = (r & 15) * 64;
            if (which == 0) {
                f32x4 w0v[4];
#pragma unroll
                for (int ni = 0; ni < 4; ++ni) w0v[ni] = *(const f32x4*)(p.rw_w0 + n0 + ni * 16 + fq * 4);
                wave_tile_mma<2>(p.LW + (size_t)m0 * 64, 64, p.W2T + (size_t)n0 * 64, 64, 0, 64, acc, fr, fq);
#pragma unroll
                for (int mi = 0; mi < 4; ++mi)
#pragma unroll
                    for (int ni = 0; ni < 4; ++ni) {
                        const int row = m0 + mi * 16 + fr, col = n0 + ni * 16 + fq * 4;
                        const f32x4 w0 = w0v[ni]; f32x4 o;
#pragma unroll
                        for (int e = 0; e < 4; ++e) o[e] = expf(-0.6065306597126334f * sigm(w0[e] + acc[mi][ni][e]));
                        *(f32x4*)(p.DECAY + (size_t)row * 1024 + col) = o;
                    }
            } else if (which == 1) {
                f32x4 a0v[4];
#pragma unroll
                for (int ni = 0; ni < 4; ++ni) a0v[ni] = *(const f32x4*)(p.rw_a0 + n0 + ni * 16 + fq * 4);
                wave_tile_mma<2>(p.LA + (size_t)m0 * 64, 64, p.A2T + (size_t)n0 * 64, 64, 0, 64, acc, fr, fq);
#pragma unroll
                for (int mi = 0; mi < 4; ++mi)
#pragma unroll
                    for (int ni = 0; ni < 4; ++ni) {
                        const int row = m0 + mi * 16 + fr, col = n0 + ni * 16 + fq * 4;
                        const f32x4 a0 = a0v[ni]; f32x4 o;
#pragma unroll
                        for (int e = 0; e < 4; ++e) o[e] = fsigm(a0[e] + acc[mi][ni][e]);
                        *(f32x4*)(p.A + (size_t)row * 1024 + col) = o;
                    }
            } else {
                wave_tile_mma<4>(p.LG + (size_t)m0 * 128, 128, p.G2T + (size_t)n0 * 128, 128, 0, 128, acc, fr, fq);
#pragma unroll
                for (int mi = 0; mi < 4; ++mi)
#pragma unroll
                    for (int ni = 0; ni < 4; ++ni) {
                        const int row = m0 + mi * 16 + fr, col = n0 + ni * 16 + fq * 4;
                        *(f32x4*)(p.G + (size_t)row * 1024 + col) = acc[mi][ni];
                    }
            }
        } else if (tix < T1) {
            const int item = tix - T0;
            wave_tile_mma<4>(p.QDEC + (size_t)item * 8192, 128, p.KDEC + (size_t)item * 8192, 128, 0, 128, acc, fr, fq);
#pragma unroll
            for (int mi = 0; mi < 4; ++mi)
#pragma unroll
                for (int ni = 0; ni < 4; ++ni) {
                    const int pp = mi * 16 + fr, s0 = ni * 16 + fq * 4;
                    f32x4 v = acc[mi][ni];
#pragma unroll
                    for (int e = 0; e < 4; ++e) if (s0 + e > pp) v[e] = 0.f;
                    u32x2 w; w.x = pk2(v[0], v[1]); w.y = pk2(v[2], v[3]);
                    *(u32x2*)(p.P + (size_t)item * 4096 + pp * 64 + s0) = w;
                }
        } else {
            const int r = tix - T1, item = r >> 3, vt = (r >> 1) & 3, dt = r & 1;
            wave_tile_mma<2>(p.VT + ((size_t)item * 256 + vt * 64) * 64, 64, p.K2T + ((size_t)item * 128 + dt * 64) * 64, 64, 0, 64, acc, fr, fq);
#pragma unroll
            for (int mi = 0; mi < 4; ++mi)
#pragma unroll
                for (int ni = 0; ni < 4; ++ni) {
                    const int v = vt * 64 + mi * 16 + fr, d0 = dt * 64 + ni * 16 + fq * 4;
                    u32x2 w; w.x = pk2(acc[mi][ni][0], acc[mi][ni][1]); w.y = pk2(acc[mi][ni][2], acc[mi][ni][3]);
                    *(u32x2*)(p.CST + ((size_t)item * 256 + v) * 128 + d0) = w;
                }
        }
    }
}

__device__ __forceinline__ void prep2_phase(const CD& p) {
    if ((blockIdx.x & 3) != 3) return;
    const int gtid = (blockIdx.x >> 2) * NTHREADS + threadIdx.x, nth = (gridDim.x >> 2) * NTHREADS;
    for (int e = gtid; e < 16 * 256 * 32; e += nth) {
        const int d4 = (e & 31) * 4, v = (e >> 5) & 255, bh = e >> 13;
        f32x4 S = (f32x4){0.f, 0.f, 0.f, 0.f};
        const size_t o0 = ((size_t)(bh * NCH) * 256 + v) * 128 + d4;
        f32x4 decs[3]; u32x2 css[3];
#pragma unroll 1
        for (int n0 = 0; n0 < NCH; n0 += 3) {
#pragma unroll
            for (int u = 0; u < 3; ++u) { decs[u] = *(const f32x4*)(p.CDEC + (bh * NCH + n0 + u) * 128 + d4); css[u] = *(const u32x2*)(p.CST + o0 + (size_t)(n0 + u) * 32768); }
#pragma unroll
            for (int u = 0; u < 3; ++u) {
                u32x2 w; w.x = pk2(S[0], S[1]); w.y = pk2(S[2], S[3]);
                *(u32x2*)(p.SPT + o0 + (size_t)(n0 + u) * 32768) = w;
                S = S * decs[u] + (f32x4){lo_f(css[u].x), hi_f(css[u].x), lo_f(css[u].y), hi_f(css[u].y)};
            }
        }
    }
}

__device__ __forceinline__ void gla_out_phase(const CD& p) {
    const int lane = threadIdx.x & 63, fr = lane & 15, fq = lane >> 4;
    const int gw = blockIdx.x * 8 + (threadIdx.x >> 6), nw = gridDim.x * 8;
    for (int tix = gw; tix < NGI * 4; tix += nw) {
        const int item = tix >> 2, vt = tix & 3, bh = item / NCH, n = item - bh * NCH, b = bh >> 2, h = bh & 3;
        f32x4 acc[4][4]; zero_acc(acc);
        wave_tile_mma<2>(p.P + (size_t)item * 4096, 64, p.VT + ((size_t)item * 256 + vt * 64) * 64, 64, 0, 64, acc, fr, fq);
        wave_tile_mma<4>(p.QDEC + (size_t)item * 8192, 128, p.SPT + ((size_t)item * 256 + vt * 64) * 128, 128, 0, 128, acc, fr, fq);
#pragma unroll
        for (int mi = 0; mi < 4; ++mi) {
            const int t = n * 64 + mi * 16 + fr - 48;
            if (t >= 0 && t < L) {
#pragma unroll
                for (int ni = 0; ni < 4; ++ni) *(f32x4*)(p.O + (size_t)(b * L + t) * 1024 + h * 256 + vt * 64 + ni * 16 + fq * 4) = acc[mi][ni];
            }
        }
    }
}

__device__ __forceinline__ float oct_sum(float x) {
    x += __int_as_float(__builtin_amdgcn_update_dpp(0, __float_as_int(x), 0xB1, 0xF, 0xF, false));
    x += __int_as_float(__builtin_amdgcn_update_dpp(0, __float_as_int(x), 0x4E, 0xF, 0xF, false));
    x += __int_as_float(__builtin_amdgcn_update_dpp(0, __float_as_int(x), 0x141, 0xF, 0xF, false));
    return x;
}
struct StepOps { f32x4 r[2], w[2], k[2], kk[2], b[2]; float v; };
template <bool WITH_R>
__device__ __forceinline__ void ld_ops(StepOps& o, const LAS float* bp, int s, int j, int vidx) {
    const LAS float* sp = bp + s * 64 + j * 8;
    if (WITH_R) { o.r[0] = *(const LAS f32x4*)(sp); o.r[1] = *(const LAS f32x4*)(sp + 4); }
    o.w[0] = *(const LAS f32x4*)(sp + 2048); o.w[1] = *(const LAS f32x4*)(sp + 2048 + 4);
    o.k[0] = *(const LAS f32x4*)(sp + 4096); o.k[1] = *(const LAS f32x4*)(sp + 4096 + 4);
    o.kk[0] = *(const LAS f32x4*)(sp + 6144); o.kk[1] = *(const LAS f32x4*)(sp + 6144 + 4);
    o.b[0] = *(const LAS f32x4*)(sp + 8192); o.b[1] = *(const LAS f32x4*)(sp + 8192 + 4);
    o.v = bp[10240 + s * 64 + vidx];
}
template <bool WITH_V>
__device__ __forceinline__ void scan_update(f32x2 (&S)[4], const StepOps& o) {
    f32x2 sa2 = S[0] * o.kk[0].lo + S[1] * o.kk[0].hi;
    sa2 += S[2] * o.kk[1].lo + S[3] * o.kk[1].hi;
    const float sa = -oct_sum(sa2[0] + sa2[1]);
    const f32x2 sv = (f32x2){sa, sa};
    if (WITH_V) {
        const f32x2 vv = (f32x2){o.v, o.v};
        S[0] = S[0] * o.w[0].lo + (sv * o.b[0].lo + vv * o.k[0].lo);
        S[1] = S[1] * o.w[0].hi + (sv * o.b[0].hi + vv * o.k[0].hi);
        S[2] = S[2] * o.w[1].lo + (sv * o.b[1].lo + vv * o.k[1].lo);
        S[3] = S[3] * o.w[1].hi + (sv * o.b[1].hi + vv * o.k[1].hi);
    } else {
        S[0] = S[0] * o.w[0].lo + sv * o.b[0].lo;
        S[1] = S[1] * o.w[0].hi + sv * o.b[0].hi;
        S[2] = S[2] * o.w[1].lo + sv * o.b[1].lo;
        S[3] = S[3] * o.w[1].hi + sv * o.b[1].hi;
    }
}
__device__ __forceinline__ float scan_y(const f32x2 (&S)[4], const StepOps& o) {
    f32x2 y2 = S[0] * o.r[0].lo + S[1] * o.r[0].hi;
    y2 += S[2] * o.r[1].lo + S[3] * o.r[1].hi;
    return oct_sum(y2[0] + y2[1]);
}
template <int MODE>
__device__ __forceinline__ void rwkv_scan_pass(const CD& p, float* __restrict__ PSI, float* __restrict__ PHI, LAS unsigned char* lds) {
    constexpr int CL = L / 4, NSUB = (CL + 31) / 32;
    const int tid = threadIdx.x, wid = __builtin_amdgcn_readfirstlane(tid >> 6), lane = tid & 63;
    LAS float* buf = (LAS float*)lds;
    LAS float* Sm = (LAS float*)(lds + 98304);
    LAS float* Pm = (LAS float*)(lds + 114688);
    for (int item = blockIdx.x; item < 256; item += gridDim.x) {
        const int bh = item >> 2, c = item & 3, b = bh >> 4, h = bh & 15;
        if (MODE == 1 && c == 3) continue;
        const int rr = tid >> 4, c4 = (tid & 15) * 4;
        const size_t gbase = (size_t)(b * L + c * CL) * 1024 + h * 64 + c4;
        f32x4 st0, st1, st2, st4, st5;
        const f32x4 pkk = *(const f32x4*)(p.rw_kk + h * 64 + c4), pka = *(const f32x4*)(p.rw_ka + h * 64 + c4), prk = *(const f32x4*)(p.rw_rk + h * 64 + c4);
#define SCAN_LOADS(tn) do { const size_t _o = gbase + (size_t)(tn) * 1024; \
        if (MODE == 3) st0 = *(const f32x4*)(p.R + _o); st1 = *(const f32x4*)(p.DECAY + _o); st2 = *(const f32x4*)(p.KR + _o); \
        st4 = *(const f32x4*)(p.A + _o); st5 = *(const f32x4*)(p.VR + _o); } while (0)
#define SCAN_STORES(bb, tl) do { LAS float* _d = buf + (bb) * 12288 + rr * 64 + c4; \
        f32x4 _kk = st2 * pkk; const float _ss = sum16(_kk[0] * _kk[0] + _kk[1] * _kk[1] + _kk[2] * _kk[2] + _kk[3] * _kk[3]); \
        _kk = _kk * (1.0f / fmaxf(sqrtf(_ss), 1e-12f)); \
        const f32x4 _k = st2 * (1.0f + (st4 - 1.0f) * pka); \
        if (MODE == 3) { const f32x4 _rk = st0 * _k * prk; const float _bs = sum16((_rk[0] + _rk[1]) + (_rk[2] + _rk[3])); \
            if ((tid & 15) == 0 && (tl) < CL) p.BONUS[(size_t)(b * L + c * CL + (tl)) * 16 + h] = _bs; \
            *(LAS f32x4*)(_d) = st0; } \
        *(LAS f32x4*)(_d + 2048) = st1; *(LAS f32x4*)(_d + 4096) = _k; \
        *(LAS f32x4*)(_d + 6144) = _kk; *(LAS f32x4*)(_d + 8192) = _kk * st4; *(LAS f32x4*)(_d + 10240) = st5; } while (0)
        st0 = (f32x4){0.f, 0.f, 0.f, 0.f};
        SCAN_LOADS(rr);
        SCAN_STORES(0, rr);
        const int slot = lane >> 3, j = lane & 7, r = wid * 8 + slot;
        f32x2 S0[4], S1[4];
#pragma unroll
        for (int i = 0; i < 4; ++i) { S0[i] = (f32x2){0.f, 0.f}; S1[i] = (f32x2){(8 * j + 2 * i) == r ? 1.f : 0.f, (8 * j + 2 * i + 1) == r ? 1.f : 0.f}; }
        if (MODE == 3 && c > 0) {
            const float* ps0 = PSI + (size_t)(bh * 4) * 4096;
#pragma unroll
            for (int i = 0; i < 2; ++i) *(LAS f32x4*)(Sm + (tid + i * 512) * 4) = *(const f32x4*)(ps0 + (tid + i * 512) * 4);
            for (int cc = 1; cc < c; ++cc) {
                const float* ph = PHI + (size_t)(bh * 4 + cc) * 4096; const float* ps = PSI + (size_t)(bh * 4 + cc) * 4096;
#pragma unroll
                for (int i = 0; i < 2; ++i) *(LAS f32x4*)(Pm + (tid + i * 512) * 4) = *(const f32x4*)(ph + (tid + i * 512) * 4);
                const int v = tid >> 3, kq = (tid & 7) * 8;
                f32x4 a0 = *(const f32x4*)(ps + v * 64 + kq), a1 = *(const f32x4*)(ps + v * 64 + kq + 4);
                __syncthreads();
#pragma unroll 8
                for (int k = 0; k < 64; ++k) {
                    const float s = Sm[v * 64 + k];
                    a0 += s * *(const LAS f32x4*)(Pm + k * 64 + kq); a1 += s * *(const LAS f32x4*)(Pm + k * 64 + kq + 4);
                }
                __syncthreads();
                *(LAS f32x4*)(Sm + v * 64 + kq) = a0; *(LAS f32x4*)(Sm + v * 64 + kq + 4) = a1;
            }
            __syncthreads();
            const f32x4 i0 = *(const LAS f32x4*)(Sm + r * 64 + 8 * j), i1 = *(const LAS f32x4*)(Sm + r * 64 + 8 * j + 4);
            S0[0] = i0.lo; S0[1] = i0.hi; S0[2] = i1.lo; S0[3] = i1.hi;
        }
        __syncthreads();
        int cb = 0;
        for (int sc = 0; sc < NSUB; ++sc) {
            const int t0 = sc * 32;
            const bool more = (sc + 1 < NSUB);
            if (more) {
                const int tn = t0 + 32 + rr;
                if (tn < CL) SCAN_LOADS(tn);
                else { st0 = (f32x4){0.f, 0.f, 0.f, 0.f}; st1 = st0; st2 = st0; st4 = st0; st5 = st0; }
            }
            {
                const LAS float* bp = buf + cb * 12288;
                const int ns = (CL - t0) < 32 ? (CL - t0) : 32;
                LAS float* yt = (LAS float*)(lds + 98304) + cb * 2048 + r;
                StepOps A, B;
                ld_ops<MODE == 3>(A, bp, 0, j, r);
                for (int s = 0; s < ns; s += 2) {
                    ld_ops<MODE == 3>(B, bp, s + 1, j, r);
                    scan_update<true>(S0, A);
                    if (MODE == 1) scan_update<false>(S1, A);
                    if (MODE == 3) { const float ya = scan_y(S0, A); yt[s * 64] = ya; }
                    if (s + 2 < ns) ld_ops<MODE == 3>(A, bp, s + 2, j, r);
                    scan_update<true>(S0, B);
                    if (MODE == 1) scan_update<false>(S1, B);
                    if (MODE == 3) { const float yb = scan_y(S0, B); yt[(s + 1) * 64] = yb; }
                }
            }
            if (more) SCAN_STORES(cb ^ 1, t0 + 32 + rr);
            __syncthreads();
            if (MODE == 3 && t0 + rr < CL)
                *(f32x4*)(p.Y + (size_t)(b * L + c * CL + t0 + rr) * 1024 + h * 64 + c4) = *(const LAS f32x4*)((LAS float*)(lds + 98304) + cb * 2048 + rr * 64 + c4);
            cb ^= 1;
        }
        if (MODE == 1) {
            float* ps = PSI + ((size_t)(bh * 4 + c) * 64 + r) * 64 + 8 * j; float* ph = PHI + ((size_t)(bh * 4 + c) * 64 + r) * 64 + 8 * j;
            *(f32x4*)(ps) = (f32x4){S0[0][0], S0[0][1], S0[1][0], S0[1][1]}; *(f32x4*)(ps + 4) = (f32x4){S0[2][0], S0[2][1], S0[3][0], S0[3][1]};
            *(f32x4*)(ph) = (f32x4){S1[0][0], S1[0][1], S1[1][0], S1[1][1]}; *(f32x4*)(ph + 4) = (f32x4){S1[2][0], S1[2][1], S1[3][0], S1[3][1]};
        }
#undef SCAN_LOADS
#undef SCAN_STORES
    }
}

__device__ __forceinline__ void post_phase(const CD& p) {
    const int lane = threadIdx.x & 63;
    const int gw = blockIdx.x * 8 + (threadIdx.x >> 6), nw = gridDim.x * 8;
    for (int itb = gw; itb < M * 4; itb += nw * 4) {
        f32x4 vv[4]; u32x2 gv[4];
#pragma unroll
        for (int u = 0; u < 4; ++u) {
            const int it = itb + u * nw, ic = it < M * 4 ? it : 0;
            const size_t o = (size_t)(ic >> 2) * 1024 + (ic & 3) * 256 + lane * 4;
            vv[u] = *(const f32x4*)(p.O + o); gv[u] = *(const u32x2*)(p.GATE + o);
        }
#pragma unroll
        for (int u = 0; u < 4; ++u) {
            const int it = itb + u * nw;
            if (it >= M * 4) continue;
            const int row = it >> 2, h = it & 3;
            const f32x4 v = vv[u]; const u32x2 gt = gv[u];
            const float ss = wave_sum(v[0] * v[0] + v[1] * v[1] + v[2] * v[2] + v[3] * v[3]);
            const float rs = rsqrtf(ss * (1.0f / 256.0f) + 1e-6f);
            u32x2 w; w.x = pk2(v[0] * rs * lo_f(gt.x), v[1] * rs * hi_f(gt.x)); w.y = pk2(v[2] * rs * lo_f(gt.y), v[3] * rs * hi_f(gt.y));
            *(u32x2*)(p.CAT + (size_t)row * D + h * 256 + lane * 4) = w;
        }
    }
    for (int itb = gw; itb < M * 4; itb += nw * 4) {
        f32x4 yv[4], vrv[4], ggv[4]; float bnv[4];
#pragma unroll
        for (int u = 0; u < 4; ++u) {
            const int it = itb + u * nw, ic = it < M * 4 ? it : 0, hh = (ic & 3) * 4 + (lane >> 4);
            const size_t o = (size_t)(ic >> 2) * 1024 + hh * 64 + (lane & 15) * 4;
            yv[u] = *(const f32x4*)(p.Y + o); vrv[u] = *(const f32x4*)(p.VR + o); ggv[u] = *(const f32x4*)(p.G + o); bnv[u] = p.BONUS[(ic >> 2) * 16 + hh];
        }
#pragma unroll
        for (int u = 0; u < 4; ++u) {
        const int it = itb + u * nw;
        if (it >= M * 4) continue;
        const int row = it >> 2, h = (it & 3) * 4 + (lane >> 4), c = h * 64 + (lane & 15) * 4;
        const f32x4 y = yv[u];
        const float mu = sum16((y[0] + y[1]) + (y[2] + y[3])) * (1.0f / 64.0f);
        const f32x4 dv = y - mu;
        const float var = sum16(dv[0] * dv[0] + dv[1] * dv[1] + dv[2] * dv[2] + dv[3] * dv[3]) * (1.0f / 64.0f);
        const float rstd = rsqrtf(var + 64e-5f);
        const f32x4 yn = dv * rstd * *(const f32x4*)(p.rw_ln_g + c) + *(const f32x4*)(p.rw_ln_b + c);
        const f32x4 res = (yn + bnv[u] * vrv[u]) * ggv[u];
        u32x2 w; w.x = pk2(res[0], res[1]); w.y = pk2(res[2], res[3]);
        *(u32x2*)(p.CAT + (size_t)row * D + 1024 + c) = w;
        }
    }
}

struct Params { const float* in[31]; float* out; unsigned char* ws; };

__global__ void __launch_bounds__(NTHREADS, 2) fwd_megakernel(Params prm) {
    extern __shared__ __attribute__((aligned(16))) unsigned char lds_raw[];
    LAS unsigned char* lds = (LAS unsigned char*)lds_raw;
    cg::grid_group grid = cg::this_grid();
    size_t zoff = 0;
    unsigned char* ws = prm.ws;
    {
        unsigned* bw = (unsigned*)(ws + XO_BAR);
        if (blockIdx.x == 0) {
            for (int i = threadIdx.x; i < BAR_WORDS; i += NTHREADS) bw[i] = 0u;
            float* ss = (float*)(ws + XO_SS);
            for (int i = threadIdx.x; i < 3 * M; i += NTHREADS) ss[i] = 0.f;
        }
        if (threadIdx.x < 4) ((LAS unsigned*)(lds + LDS_ST_OFF))[threadIdx.x] = 0u;
        __syncthreads();
    }
    XcdBarrier xbar; xbar.bar = (unsigned*)(ws + XO_BAR); xbar.x = 0; xbar.st = (volatile LAS unsigned*)(lds + LDS_ST_OFF);
#ifndef PROBE_MASK
#define PROBE_MASK 0ull
#endif
#if PROBE_MASK
    unsigned long long tacc = 0ull, tprev = __builtin_amdgcn_s_memrealtime(); int tphase = 0;
#define TICK() do { const unsigned long long _n = __builtin_amdgcn_s_memrealtime(); if (((unsigned long long)(PROBE_MASK) >> tphase) & 1ull) tacc += _n - tprev; tprev = _n; ++tphase; } while (0)
#else
#define TICK() do {} while (0)
#endif
#if PROBE_MASK && defined(PROBE_SPLIT)
#define PSPLIT() do { SYNC(); TICK(); } while (0)
#else
#define PSPLIT() do {} while (0)
#endif
#define GEMM_FULL(FULLM_, A_, Bt_, N_, K_, EP_) do { pg8::StaticOrder S_; S_.init((FULLM_) ? 33 * 256 : MBIG, (N_), (int)gridDim.x, (int)blockIdx.x); const auto ep_ = EP_; \
        pg8::gemm_phase(lds, (A_), (Bt_), (K_), S_, ep_); PSPLIT(); if (!(FULLM_)) gemm_rem_phase(lds, (A_), (Bt_), (N_), (K_), ep_); PSPLIT(); } while (0)
#define SYNC() do { xcd_barrier(xbar); asm volatile("" : "+s"(zoff) :: "memory"); ws = prm.ws + zoff; } while (0)
#define SYNC0() do { grid.sync(); xbar = xcd_barrier_post((unsigned*)(ws + XO_BAR), (volatile LAS unsigned*)(lds + LDS_ST_OFF)); asm volatile("" : "+s"(zoff) :: "memory"); ws = prm.ws + zoff; } while (0)
#define WSF(off) ((float*)(ws + (off)))
#define WSB(off) ((bf16_t*)(ws + (off)))
#define CTR(j) ((unsigned*)(ws + XO_BAR) + 3456 + (j))
#define SSQ(j) (WSF(XO_SS) + (j) * M)
#define MKCD(p) CD p; \
        p.z2 = WSF(OFF_Z); p.gla_w2 = prm.in[10]; p.gla_b = prm.in[11]; p.gla_norm_g = prm.in[12]; p.rw_mu = prm.in[13]; p.rw_w0 = prm.in[14]; p.rw_a0 = prm.in[16]; \
        p.rw_kk = prm.in[19]; p.rw_ka = prm.in[20]; p.rw_rk = prm.in[21]; p.rw_ln_g = prm.in[22]; p.rw_ln_b = prm.in[23]; \
        p.R = WSF(XO_R); p.KR = WSF(XO_KR); p.VR = WSF(XO_VR); p.G = WSF(XO_G); p.Y = WSF(XO_Y); \
        p.CDEC = WSF(XO_CDEC); p.BONUS = WSF(XO_BONUS); p.DECAY = WSF(ZO_DECAY); p.A = WSF(ZO_A); p.KK = WSF(ZO_KK); p.O = WSF(ZO_O); \
        p.LW = WSB(XO_LW); p.LA = WSB(XO_LA); p.LG = WSB(XO_LG); p.GATE = WSB(XO_GATE); \
        p.QDEC = WSB(XO_QDEC); p.KDEC = WSB(XO_KDEC); p.K2T = WSB(XO_K2T); p.VT = WSB(XO_VT); \
        p.W2T = WSB(XO_W2T); p.A2T = WSB(XO_A2T); p.G2T = WSB(XO_G2T); \
        p.CST = WSB(ZO_CST); p.SPT = WSB(ZO_SPT); p.P = WSB(ZO_P); p.CAT = WSB(OFF_ACT);

    rms_phase<1>(nullptr, WSF(OFF_H), prm.in[0], prm.in[1], prm.in[25], WSB(OFF_HN), nullptr);
    convert_wt(prm.in[2], WSB(XO_WB), D, NAB, NAB, nullptr, lds);
    convert_wt(prm.in[15], WSB(XO_W2T), 64, 1024, 1024, nullptr, lds);
    convert_wt(prm.in[17], WSB(XO_A2T), 64, 1024, 1024, nullptr, lds);
    convert_wt(prm.in[18], WSB(XO_G2T), 128, 1024, 1024, nullptr, lds);
    SYNC0(); TICK();
    GEMM_FULL(1, WSB(OFF_HN), WSB(XO_WB), NAB, D, (EpStoreBf16{WSB(OFF_Z), NAB}));
    convert_steal(prm.in[8], WSB(XO_WC), D, D, D, nullptr, CTR(0), lds);
    convert_steal<true>(prm.in[27], WSB(OFF_W), D, NUP, NUP, prm.in[26], CTR(1), lds);
    SYNC(); TICK();
    mixer_ab_phase(WSB(OFF_Z), prm.in[3], prm.in[4], prm.in[5], prm.in[6], prm.in[7], WSB(OFF_ACT), lds);
    SYNC(); TICK();
    GEMM_FULL(0, WSB(OFF_ACT), WSB(XO_WC), D, D, (EpResid0{prm.in[0], prm.in[1], WSF(OFF_H), WSB(OFF_HN), SSQ(0)}));
    SYNC(); TICK();
    GEMM_FULL(1, WSB(OFF_HN), WSB(OFF_W), NUP, D, (EpGate{WSB(OFF_ACT), WSB(OFF_Z), SSQ(0), prm.in[28]}));
    convert_steal(prm.in[29], WSB(XO_WC), DFF, D, D, nullptr, CTR(2), lds);
    convert_steal(prm.in[9], WSB(XO_WB), D, NCD, NCDP, prm.in[25] + D, CTR(3), lds);
    SYNC(); TICK();
    gate_fixup_phase(WSB(OFF_Z), prm.in[28], WSB(OFF_ACT));
    SYNC(); TICK();
    GEMM_FULL(0, WSB(OFF_ACT), WSB(XO_WC), D, DFF, (EpResid{WSF(OFF_H), WSB(OFF_HN), SSQ(1)}));
    SYNC(); TICK();
    GEMM_FULL(1, WSB(OFF_HN), WSB(XO_WB), NCDP, D, (EpScaleStoreF32{WSF(OFF_Z), NCDP, SSQ(1)}));
    convert_steal(prm.in[24], WSB(XO_WC), D, D, D, nullptr, CTR(4), lds);
    convert_steal<true>(prm.in[27] + (size_t)D * NUP, WSB(OFF_W), D, NUP, NUP, prm.in[26] + D, CTR(5), lds);
    SYNC(); TICK();
    { MKCD(p) prep1_phase(p, lds); }
    SYNC(); TICK();
    { MKCD(p) small_gemm_phase(p); }
    SYNC(); TICK();
    { MKCD(p) prep2_phase(p); }
    { MKCD(p) rwkv_scan_pass<1>(p, WSF(ZO_PSI), WSF(ZO_PHI), lds); }
    SYNC(); TICK();
    { MKCD(p) gla_out_phase(p); }
    { MKCD(p) rwkv_scan_pass<3>(p, WSF(ZO_PSI), WSF(ZO_PHI), lds); }
    SYNC(); TICK();
    { MKCD(p) post_phase(p); }
    SYNC(); TICK();
    GEMM_FULL(0, WSB(OFF_ACT), WSB(XO_WC), D, D, (EpResid{WSF(OFF_H), WSB(OFF_HN), SSQ(2)}));
    SYNC(); TICK();
    GEMM_FULL(1, WSB(OFF_HN), WSB(OFF_W), NUP, D, (EpGate{WSB(OFF_ACT), WSB(OFF_Z), SSQ(2), prm.in[28] + (size_t)3 * NUP}));
    convert_steal(prm.in[29] + (size_t)DFF * D, WSB(XO_WC), DFF, D, D, nullptr, CTR(6), lds);
    SYNC(); TICK();
    gate_fixup_phase(WSB(OFF_Z), prm.in[28] + (size_t)3 * NUP, WSB(OFF_ACT));
    SYNC(); TICK();
    GEMM_FULL(0, WSB(OFF_ACT), WSB(XO_WC), D, DFF, (EpAddF32{WSF(OFF_H), D}));
    SYNC(); TICK();
    rms_phase<2>(WSF(OFF_H), nullptr, nullptr, nullptr, prm.in[30], nullptr, prm.out);
#if PROBE_MASK
    TICK();
    if (blockIdx.x == 0) { const unsigned long long t0 = __builtin_amdgcn_s_memrealtime(); while (__builtin_amdgcn_s_memrealtime() - t0 < tacc) __builtin_amdgcn_s_sleep(8); }
#endif
}

extern "C" void kernel_launch(void* const* d_in, const int* in_sizes, int n_in, void* d_out, int out_size, void* d_ws, size_t ws_size, hipStream_t stream) {
    static int grid_blocks = 0;
    if (!grid_blocks) {
        if (n_in != 31 || ws_size < WS_END) { fprintf(stderr, "kernel_launch: expected 31 inputs and >= %zu bytes of workspace (got %d, %zu)\n", (size_t)WS_END, n_in, ws_size); grid_blocks = -1; return; }
        int dev = 0, cus = 0, per_cu = 0;
        hipGetDevice(&dev);
        hipDeviceGetAttribute(&cus, hipDeviceAttributeMultiprocessorCount, dev);
        hipFuncSetAttribute((const void*)fwd_megakernel, hipFuncAttributeMaxDynamicSharedMemorySize, LDS_BYTES);
        hipOccupancyMaxActiveBlocksPerMultiprocessor(&per_cu, (const void*)fwd_megakernel, NTHREADS, LDS_BYTES);
        if (per_cu < 1) per_cu = 1;
        if (per_cu > 1) per_cu = 1;
        (void)hipGetLastError();
        grid_blocks = cus * per_cu;
    }
    if (grid_blocks < 0) return;
    Params p{};
    for (int i = 0; i < 31; ++i) p.in[i] = (const float*)d_in[i];
    p.out = (float*)d_out; p.ws = (unsigned char*)d_ws;
    void* args[] = {&p};
    hipError_t e = hipLaunchCooperativeKernel((const void*)fwd_megakernel, dim3(grid_blocks), dim3(NTHREADS), args, LDS_BYTES, stream);
    if (e != hipSuccess) fprintf(stderr, "cooperative launch failed: %s (grid %d)\n", hipGetErrorString(e), grid_blocks);
}
```

```cpp
#include <hip/hip_runtime.h>
#include <hip/hip_cooperative_groups.h>
#include <cstdio>
namespace cg = cooperative_groups;

#define LAS __attribute__((address_space(3)))
typedef unsigned short bf16_t;
typedef short bf16x8 __attribute__((ext_vector_type(8)));
typedef float f32x4 __attribute__((ext_vector_type(4)));
typedef float f32x2 __attribute__((ext_vector_type(2)));
typedef unsigned u32x4 __attribute__((ext_vector_type(4)));
typedef unsigned u32x2 __attribute__((ext_vector_type(2)));

constexpr int D = 2048, L = 2064, NBATCH = 4, SEQ = 2048, NMETA = 16, M = NBATCH * L  , MBIG = 8192;
constexpr int DFF = 5632, NUP = 2 * DFF, NAB = 5120, NCD = 6416, NCDP = 6656;
constexpr int NCH = 33;
constexpr int NGI = NBATCH * 4 * NCH;
constexpr int LDS_ST_OFF = 139264;
constexpr int LDS_BYTES = LDS_ST_OFF + 16;
constexpr int NTHREADS = 512;

constexpr size_t al256(size_t x) { return (x + 255) & ~(size_t)255; }
constexpr size_t OFF_H = 0;
constexpr size_t OFF_W = OFF_H + al256((size_t)M * D * 4);
constexpr size_t OFF_HN = OFF_W + al256((size_t)NUP * D * 2);
constexpr size_t OFF_Z = OFF_HN + al256((size_t)M * D * 2);
constexpr size_t OFF_ACT = OFF_Z + al256((size_t)M * NCDP * 4);
constexpr size_t OFF_X = OFF_ACT + al256((size_t)M * DFF * 2);
constexpr size_t SZ_M1024F = al256((size_t)M * 1024 * 4);
constexpr size_t XO_R = OFF_X;
constexpr size_t XO_KR = XO_R + SZ_M1024F;
constexpr size_t XO_VR = XO_KR + SZ_M1024F;
constexpr size_t XO_G = XO_VR + SZ_M1024F;
constexpr size_t XO_Y = OFF_HN;
constexpr size_t XO_LW = XO_G + SZ_M1024F;
constexpr size_t XO_LA = XO_LW + al256((size_t)M * 64 * 2);
constexpr size_t XO_LG = XO_LA + al256((size_t)M * 64 * 2);
constexpr size_t XO_GATE = XO_LG + al256((size_t)M * 128 * 2);
constexpr size_t XO_QDEC = XO_GATE + al256((size_t)M * 1024 * 2);
constexpr size_t XO_KDEC = XO_QDEC + al256((size_t)NGI * 64 * 128 * 2);
constexpr size_t XO_K2T = XO_KDEC + al256((size_t)NGI * 64 * 128 * 2);
constexpr size_t XO_VT = XO_K2T + al256((size_t)NGI * 64 * 128 * 2);
constexpr size_t XO_CDEC = XO_VT + al256((size_t)NGI * 256 * 64 * 2);
constexpr size_t XO_BONUS = XO_CDEC + al256((size_t)NGI * 128 * 4);
constexpr size_t XO_W2T = XO_BONUS + al256((size_t)M * 16 * 4);
constexpr size_t XO_A2T = XO_W2T + al256((size_t)1024 * 64 * 2);
constexpr size_t XO_G2T = XO_A2T + al256((size_t)1024 * 64 * 2);
constexpr size_t XO_BAR = XO_G2T + al256((size_t)1024 * 128 * 2);
constexpr int BAR_WORDS = 3456 + 64;
constexpr size_t XO_SS = XO_BAR + al256((size_t)BAR_WORDS * 4);
constexpr size_t XO_WB = XO_SS + al256((size_t)3 * M * 4);
constexpr size_t XO_WC = XO_WB + al256((size_t)NCDP * D * 2);
constexpr size_t WS_END = XO_WC + al256((size_t)D * DFF * 2);
constexpr size_t ZO_DECAY = OFF_Z;
constexpr size_t ZO_A = ZO_DECAY + SZ_M1024F;
constexpr size_t ZO_KK = ZO_A + SZ_M1024F;
constexpr size_t ZO_O = ZO_KK + SZ_M1024F;
constexpr size_t ZO_CST = ZO_O + SZ_M1024F;
constexpr size_t ZO_SPT = ZO_CST + al256((size_t)NGI * 256 * 128 * 2);
constexpr size_t ZO_P = ZO_SPT + al256((size_t)NGI * 256 * 128 * 2);
constexpr size_t ZO_END = ZO_P + al256((size_t)NGI * 64 * 64 * 2);
constexpr size_t ZO_PSI = ZO_END;
constexpr size_t ZO_PHI = ZO_PSI + al256((size_t)256 * 4096 * 4);
static_assert(ZO_PHI + al256((size_t)256 * 4096 * 4) <= OFF_ACT, "Z sub-regions overflow");
static_assert(SZ_M1024F <= (size_t)M * D * 2 + 256, "Y must fit in HN");

__device__ __forceinline__ float bf2f(unsigned b) { return __uint_as_float(b << 16); }
__device__ __forceinline__ unsigned f2bf(float f) { unsigned u = __float_as_uint(f); u += 0x7FFFu + ((u >> 16) & 1u); return u >> 16; }
typedef __bf16 bf16x2_t __attribute__((ext_vector_type(2)));
__device__ __forceinline__ unsigned pk2(float lo, float hi) { const f32x2 v = (f32x2){lo, hi}; const bf16x2_t b = __builtin_convertvector(v, bf16x2_t); return __builtin_bit_cast(unsigned, b); }
__device__ __forceinline__ float lo_f(unsigned w) { return __uint_as_float(w << 16); }
__device__ __forceinline__ float hi_f(unsigned w) { return __uint_as_float(w & 0xffff0000u); }
__device__ __forceinline__ float sigm(float x) { return 1.0f / (1.0f + expf(-x)); }
__device__ __forceinline__ float silu(float x) { return x * sigm(x); }
__device__ __forceinline__ float fsigm(float x) { return __builtin_amdgcn_rcpf(1.0f + __builtin_amdgcn_exp2f(x * -1.4426950408889634f)); }
__device__ __forceinline__ float fsilu(float x) { return x * fsigm(x); }
__device__ __forceinline__ float logsig(float x) { return fminf(x, 0.f) - log1pf(expf(-fabsf(x))); }
__device__ __forceinline__ float wave_sum(float v) {
#pragma unroll
    for (int o = 32; o >= 1; o >>= 1) v += __shfl_xor(v, o);
    return v;
}
__device__ __forceinline__ float sum16(float v) {
#pragma unroll
    for (int o = 8; o >= 1; o >>= 1) v += __shfl_xor(v, o);
    return v;
}
__device__ __forceinline__ float quad_sum(float x) {
    x += __int_as_float(__builtin_amdgcn_update_dpp(0, __float_as_int(x), 0xB1, 0xF, 0xF, false));
    x += __int_as_float(__builtin_amdgcn_update_dpp(0, __float_as_int(x), 0x4E, 0xF, 0xF, false));
    return x;
}


#define XB_TMO      128
#define XB_XCNT(j)  (256  + 64 * (j))
#define XB_XSUB(j)  (1280 + 64 * (j))
#define XB_XGEN(j)  (2304 + 64 * (j))
#define XB_TOP      3328
#define XB_TOPGEN   3392
#define XCD_BAR_WORDS 3456
#define XB_SPIN_CAP (1u << 20)
__device__ __forceinline__ unsigned xb_ld(unsigned* p)              { return __hip_atomic_load(p, __ATOMIC_RELAXED, __HIP_MEMORY_SCOPE_AGENT); }
__device__ __forceinline__ unsigned xb_add(unsigned* p, unsigned v) { return __hip_atomic_fetch_add(p, v, __ATOMIC_RELAXED, __HIP_MEMORY_SCOPE_AGENT); }
__device__ __forceinline__ unsigned xb_xcc_id() { return (unsigned)__builtin_amdgcn_s_getreg((3 << 11) | 20) & 0xFu; }
#define XB_SPIN(cond, bar) do { unsigned _sp = 0; while (cond) { __builtin_amdgcn_s_sleep(1); \
    if ((++_sp & 255u) == 0u) { if (xb_ld(&(bar)[XB_TMO])) break; if (_sp > XB_SPIN_CAP) { atomicAdd(&(bar)[XB_TMO], 1u); break; } } } } while (0)
struct XcdBarrier { unsigned* bar; unsigned x; volatile LAS unsigned* st; };
__device__ __forceinline__ XcdBarrier xcd_barrier_post(unsigned* bar, volatile LAS unsigned* st) {
    XcdBarrier b; b.bar = bar; b.x = xb_xcc_id(); b.st = st;
    if (threadIdx.x == 0) (void)xb_add(&bar[XB_XCNT(b.x)], 1u);
    return b;
}
__device__ __forceinline__ void xcd_barrier_complete(unsigned* bar, unsigned x, unsigned& nloc, unsigned& nx) {
    const unsigned G = gridDim.x * gridDim.y * gridDim.z;
    unsigned sum, cnt, mine, sp = 0u;
    for (;;) {
        sum = 0u; cnt = 0u; mine = 0u;
#pragma unroll
        for (unsigned j = 0; j < 16; ++j) { const unsigned c = xb_ld(&bar[XB_XCNT(j)]); sum += c; cnt += (c > 0u) ? 1u : 0u; mine = (j == x) ? c : mine; }
        if (sum == G) break;
        __builtin_amdgcn_s_sleep(1);
        if ((++sp & 255u) == 0u) { if (xb_ld(&bar[XB_TMO])) break; if (sp > XB_SPIN_CAP) { atomicAdd(&bar[XB_TMO], 1u); break; } }
    }
    nloc = mine > 0u ? mine : 1u; nx = cnt > 0u ? cnt : 1u;
}
__device__ __forceinline__ void xcd_barrier(const XcdBarrier& b) {
    asm volatile("s_waitcnt vmcnt(0)" ::: "memory");
    __syncthreads();
    if (threadIdx.x == 0) {
        unsigned* bar = b.bar;
        __builtin_amdgcn_s_waitcnt(0);
        unsigned nloc = b.st[0], nx = b.st[1];
        if (nloc == 0u) { xcd_barrier_complete(bar, b.x, nloc, nx); b.st[0] = nloc; b.st[1] = nx; }
        const unsigned old = xb_add(&bar[XB_XSUB(b.x)], 1u);
        const unsigned gen = old / nloc;
        if (old + 1u == (gen + 1u) * nloc) {
            __builtin_amdgcn_fence(__ATOMIC_RELEASE, "agent");
            asm volatile("s_waitcnt vmcnt(0)" ::: "memory");
            const unsigned og = xb_add(&bar[XB_TOP], 1u);
            const unsigned tg = og / nx;
            if (og + 1u == (tg + 1u) * nx) xb_add(&bar[XB_TOPGEN], 1u);
            else XB_SPIN(xb_ld(&bar[XB_TOPGEN]) == tg, bar);
            __builtin_amdgcn_fence(__ATOMIC_ACQUIRE, "agent");
            xb_add(&bar[XB_XGEN(b.x)], 1u);
            asm volatile("s_waitcnt vmcnt(0)" ::: "memory");
        } else {
            XB_SPIN(xb_ld(&bar[XB_XGEN(b.x)]) == gen, bar);
            __builtin_amdgcn_fence(__ATOMIC_ACQUIRE, "agent");
            asm volatile("s_waitcnt vmcnt(0)" ::: "memory");
        }
    }
    __syncthreads();
}

namespace pg8 {
constexpr int BM = 256, BK = 64, HALF = 128, HTB = HALF * BK * 2, NXCD = 8, WGM = 4;
__device__ __forceinline__ int lds_byte(int r, int c) { const int st = (r >> 4) * 2 + (c >> 5), rr = r & 15, cc = c & 31, ob = rr * 64 + cc * 2; return st * 1024 + (ob ^ (((ob >> 9) & 1) << 5)); }
__device__ __forceinline__ void stage_rc(int b, int& R, int& C) { const int st = b / 1024, sb = b % 1024, swz = sb ^ (((sb >> 9) & 1) << 5); R = (st >> 1) * 16 + swz / 64; C = (st & 1) * 32 + (swz % 64) / 2; }
struct Unit { int pm, pn; };
struct StaticOrder {
    int nM, nN, nwg, G, c;
    __device__ void init(int Mr, int N, int G_, int c_) { nM = Mr / BM; nN = N / BM; nwg = nM * nN; G = G_; c = c_; }
    __device__ bool next(int i, Unit& u) const {
        const long Lx = (long)i * G + c; if (Lx >= nwg) return false;
        int wgid = (int)Lx; { const int q = nwg / NXCD, r = nwg % NXCD, xcd = wgid % NXCD, off = wgid / NXCD; wgid = (xcd < r ? xcd * (q + 1) : r * (q + 1) + (xcd - r) * q) + off; }
        const int nig = WGM * nN, gid = wgid / nig, fm = gid * WGM, gsz = (nM - fm) < WGM ? (nM - fm) : WGM;
        u.pm = fm + ((wgid % nig) % gsz); u.pn = (wgid % nig) / gsz; return true;
    }
};
template <class F>
__device__ __forceinline__ void gemm_phase(LAS unsigned char* lds, const bf16_t* gA, const bf16_t* gBt, const int K, const StaticOrder& S, const F& f) {
    int tid = threadIdx.x; asm volatile("" : "+v"(tid));
    const int wid = __builtin_amdgcn_readfirstlane(tid >> 6), lane = tid & 63, wr = wid >> 2, wc = wid & 3, fr = lane & 15, fq = lane >> 4;
    const int nt = K / BK;
    unsigned voffA[2];
#pragma unroll
    for (int i = 0; i < 2; ++i) { int R, C; stage_rc(tid * 16 + i * 8192, R, C); voffA[i] = (unsigned)(R * K + C) * 2u; }
    const size_t kstep = (size_t)(BK * 2);
    const size_t hstep = (size_t)HALF * K * 2;
    const size_t tstep = 2 * hstep;
    const unsigned ldsw = (unsigned)wid * 1024u;
    const int aoff = lds_byte(wr * 64 + fr, fq * 8), boff = lds_byte(wc * 32 + fr, fq * 8);
#define PG8_SA(b, h) (((b) * 2 + (h)) * HTB)
#define PG8_SB(b, h) ((4 + (b) * 2 + (h)) * HTB)
#define PG8_STAGE(bufoff, gbase, voff) do { _Pragma("unroll") for (int _i = 0; _i < 2; ++_i) \
        __builtin_amdgcn_global_load_lds((const unsigned*)((const char*)(gbase) + (voff)[_i]), (LAS unsigned*)(lds + (bufoff) + ldsw + _i * 8192), 16, 0, 0); } while (0)
#define PG8_LDA(dst, b, h) do { _Pragma("unroll") for (int m = 0; m < 4; ++m) _Pragma("unroll") for (int k = 0; k < 2; ++k) dst[m][k] = *(const LAS bf16x8*)(lds + PG8_SA(b, h) + aoff + m * 2048 + k * 1024); } while (0)
#define PG8_LDB(dst, b, h) do { _Pragma("unroll") for (int n = 0; n < 2; ++n) _Pragma("unroll") for (int k = 0; k < 2; ++k) dst[n][k] = *(const LAS bf16x8*)(lds + PG8_SB(b, h) + boff + n * 2048 + k * 1024); } while (0)
#define PG8_MMA(ai, bj, At, Bt) do { __builtin_amdgcn_s_setprio(1); _Pragma("unroll") for (int m = 0; m < 4; ++m) _Pragma("unroll") for (int n = 0; n < 2; ++n) _Pragma("unroll") for (int k = 0; k < 2; ++k) \
        acc[ai][bj][m][n] = __builtin_amdgcn_mfma_f32_16x16x32_bf16(Bt[n][k], At[m][k], acc[ai][bj][m][n], 0, 0, 0); __builtin_amdgcn_s_setprio(0); } while (0)
#define PG8_WAIT_V(n) asm volatile("s_waitcnt vmcnt(" #n ")" ::: "memory")
#define PG8_WAIT_L(n) asm volatile("s_waitcnt lgkmcnt(" #n ")" ::: "memory")
#define PG8_BAR __builtin_amdgcn_s_barrier()
#define PG8_SCHED __builtin_amdgcn_sched_barrier(0)
    Unit cur, nxt; int ui = 0;
    if (!S.next(0, cur)) return;
    f32x4 acc[2][2][4][2];
#pragma unroll
    for (int a = 0; a < 2; ++a)
#pragma unroll
        for (int b = 0; b < 2; ++b)
#pragma unroll
            for (int m = 0; m < 4; ++m)
#pragma unroll
                for (int n = 0; n < 2; ++n) acc[a][b][m][n] = (f32x4){0.f, 0.f, 0.f, 0.f};
    bf16x8 At[4][2], B0[2][2], B1[2][2];
    const char* cA = (const char*)gA + (size_t)cur.pm * tstep; const char* cB = (const char*)gBt + (size_t)cur.pn * tstep;
    PG8_STAGE(PG8_SB(0, 0), cB, voffA); PG8_STAGE(PG8_SA(0, 0), cA, voffA); PG8_STAGE(PG8_SB(0, 1), cB + hstep, voffA); PG8_STAGE(PG8_SA(0, 1), cA + hstep, voffA);
    if (wr == 1) PG8_BAR;
    PG8_WAIT_V(4); PG8_BAR;
    PG8_STAGE(PG8_SB(1, 0), cB + kstep, voffA); PG8_STAGE(PG8_SA(1, 0), cA + kstep, voffA); PG8_STAGE(PG8_SB(1, 1), cB + hstep + kstep, voffA);
    PG8_WAIT_V(6); PG8_BAR;
    for (;;) {
        const bool has_next = S.next(ui + 1, nxt);
        const char* nA = has_next ? (const char*)gA + (size_t)nxt.pm * tstep : cA; const char* nB = has_next ? (const char*)gBt + (size_t)nxt.pn * tstep : cB;
        for (int t = 0; t < nt; t += 2) {
            const bool last = (t == nt - 2);
            const char* a1 = cA + (size_t)(t + 1) * kstep;
            const char* a2 = last ? nA : cA + (size_t)(t + 2) * kstep; const char* b2 = last ? nB : cB + (size_t)(t + 2) * kstep;
            const char* a3 = a2 + kstep; const char* b3 = b2 + kstep;
            PG8_LDB(B0, 0, 0); PG8_SCHED; PG8_LDA(At, 0, 0); PG8_STAGE(PG8_SA(1, 1), a1 + hstep, voffA);
            PG8_WAIT_L(8); PG8_BAR; PG8_WAIT_L(0); PG8_MMA(0, 0, At, B0); PG8_BAR; PG8_SCHED;
            PG8_LDB(B1, 0, 1); PG8_STAGE(PG8_SB(0, 0), b2, voffA);
            PG8_BAR; PG8_WAIT_L(0); PG8_MMA(0, 1, At, B1); PG8_BAR;
            PG8_LDA(At, 0, 1); PG8_STAGE(PG8_SA(0, 0), a2, voffA);
            PG8_BAR; PG8_WAIT_L(0); PG8_MMA(1, 0, At, B0); PG8_BAR; PG8_SCHED;
            PG8_STAGE(PG8_SB(0, 1), b2 + hstep, voffA);
            PG8_WAIT_V(6); PG8_BAR; PG8_MMA(1, 1, At, B1); PG8_BAR;
            PG8_LDB(B0, 1, 0); PG8_SCHED; PG8_LDA(At, 1, 0); PG8_STAGE(PG8_SA(0, 1), a2 + hstep, voffA);
            PG8_WAIT_L(8); PG8_BAR; PG8_WAIT_L(0); PG8_MMA(0, 0, At, B0); PG8_BAR; PG8_SCHED;
            PG8_LDB(B1, 1, 1); PG8_STAGE(PG8_SB(1, 0), b3, voffA);
            PG8_BAR; PG8_WAIT_L(0); PG8_MMA(0, 1, At, B1); PG8_BAR;
            PG8_LDA(At, 1, 1); PG8_STAGE(PG8_SA(1, 0), a3, voffA);
            PG8_BAR; PG8_WAIT_L(0); PG8_MMA(1, 0, At, B0); PG8_BAR; PG8_SCHED;
            PG8_STAGE(PG8_SB(1, 1), b3 + hstep, voffA);
            PG8_WAIT_V(6); PG8_BAR; PG8_MMA(1, 1, At, B1); PG8_BAR;
        }
        if constexpr (F::GATE) { f.tile(acc, cur.pm, cur.pn, wr, wc, fr, fq); }
        else {
            const int row0 = cur.pm * BM + wr * 64 + fr, col0 = cur.pn * BM + wc * 32 + 4 * fq;
            float sc[2][4];
#pragma unroll
            for (int ai = 0; ai < 2; ++ai)
#pragma unroll
                for (int m = 0; m < 4; ++m) sc[ai][m] = f.begin(row0 + ai * HALF + m * 16);
#pragma unroll
            for (int ai = 0; ai < 2; ++ai) {
                f32x4 hv[4][2][2];
#pragma unroll
                for (int m = 0; m < 4; ++m)
#pragma unroll
                    for (int bj = 0; bj < 2; ++bj)
#pragma unroll
                        for (int n = 0; n < 2; ++n) hv[m][bj][n] = f.pre(row0 + ai * HALF + m * 16, col0 + bj * HALF + n * 16);
#pragma unroll
                for (int m = 0; m < 4; ++m) {
                    const int row = row0 + ai * HALF + m * 16;
                    float ssq = 0.f;
#pragma unroll
                    for (int bj = 0; bj < 2; ++bj)
#pragma unroll
                        for (int n = 0; n < 2; ++n) ssq += f(row, col0 + bj * HALF + n * 16, acc[ai][bj][m][n], hv[m][bj][n], sc[ai][m]);
                    f.end(row, ssq, 0);
                }
            }
        }
        if (!has_next) break;
#pragma unroll
        for (int a = 0; a < 2; ++a)
#pragma unroll
            for (int b = 0; b < 2; ++b)
#pragma unroll
                for (int m = 0; m < 4; ++m)
#pragma unroll
                    for (int n = 0; n < 2; ++n) acc[a][b][m][n] = (f32x4){0.f, 0.f, 0.f, 0.f};
        cur = nxt; cA = nA; cB = nB; ++ui;
    }
    PG8_WAIT_V(0);
    if (wr == 0) PG8_BAR;
    PG8_BAR;
#undef PG8_SA
#undef PG8_SB
#undef PG8_STAGE
#undef PG8_LDA
#undef PG8_LDB
#undef PG8_MMA
#undef PG8_WAIT_V
#undef PG8_WAIT_L
#undef PG8_BAR
#undef PG8_SCHED
}
}

template <int UNR>
__device__ __forceinline__ void wave_tile_mma(const bf16_t* __restrict__ A, int lda, const bf16_t* __restrict__ Bt, int ldb, int k0, int k1, f32x4 (&acc)[4][4], int fr, int fq) {
    const bf16_t* ap = A + (size_t)fr * lda + fq * 8;
    const bf16_t* bp = Bt + (size_t)fr * ldb + fq * 8;
    int k = k0;
#pragma unroll 1
    for (; k + 32 * UNR <= k1; k += 32 * UNR) {
        bf16x8 a[UNR][4], b[UNR][4];
#pragma unroll
        for (int u = 0; u < UNR; ++u)
#pragma unroll
            for (int i = 0; i < 4; ++i) { a[u][i] = *(const bf16x8*)(ap + (size_t)i * 16 * lda + k + 32 * u); b[u][i] = *(const bf16x8*)(bp + (size_t)i * 16 * ldb + k + 32 * u); }
#pragma unroll
        for (int u = 0; u < UNR; ++u)
#pragma unroll
            for (int mi = 0; mi < 4; ++mi)
#pragma unroll
                for (int ni = 0; ni < 4; ++ni) acc[mi][ni] = __builtin_amdgcn_mfma_f32_16x16x32_bf16(b[u][ni], a[u][mi], acc[mi][ni], 0, 0, 0);
    }
#pragma unroll 1
    for (; k < k1; k += 32) {
        bf16x8 a[4], b[4];
#pragma unroll
        for (int i = 0; i < 4; ++i) { a[i] = *(const bf16x8*)(ap + (size_t)i * 16 * lda + k); b[i] = *(const bf16x8*)(bp + (size_t)i * 16 * ldb + k); }
#pragma unroll
        for (int mi = 0; mi < 4; ++mi)
#pragma unroll
            for (int ni = 0; ni < 4; ++ni) acc[mi][ni] = __builtin_amdgcn_mfma_f32_16x16x32_bf16(b[ni], a[mi], acc[mi][ni], 0, 0, 0);
    }
}
__device__ __forceinline__ void zero_acc(f32x4 (&acc)[4][4]) {
#pragma unroll
    for (int i = 0; i < 4; ++i)
#pragma unroll
        for (int j = 0; j < 4; ++j) acc[i][j] = (f32x4){0.f, 0.f, 0.f, 0.f};
}

template <class F>
__device__ __forceinline__ void gemm_rem_phase(LAS unsigned char* lds, const bf16_t* A, const bf16_t* Bt, int N, int K, const F& f) {
    const int tid = threadIdx.x, wid = __builtin_amdgcn_readfirstlane(tid >> 6), lane = tid & 63, fr = lane & 15, fq = lane >> 4;
    const int ntiles = N / 64, kw = K / 8;
    for (int tile = (int)gridDim.x - 1 - (int)blockIdx.x; tile < ntiles; tile += gridDim.x) {
        const int n0 = tile * 64;
        f32x4 acc[4][4]; zero_acc(acc);
        wave_tile_mma<4>(A + (size_t)MBIG * K, K, Bt + (size_t)n0 * K, K, wid * kw, (wid + 1) * kw, acc, fr, fq);
        LAS float* P = (LAS float*)lds + wid * 4096;
#pragma unroll
        for (int mi = 0; mi < 4; ++mi)
#pragma unroll
            for (int ni = 0; ni < 4; ++ni) *(LAS f32x4*)(P + ((mi * 4 + ni) * 64 + lane) * 4) = acc[mi][ni];
        __syncthreads();
#pragma unroll
        for (int i = 0; i < 2; ++i) {
            const int fg = wid + 8 * i, r = (fg >> 2) * 16 + fr, c4 = (fg & 3) * 16 + fq * 4;
            f32x4 s = (f32x4){0.f, 0.f, 0.f, 0.f};
#pragma unroll
            for (int w = 0; w < 8; ++w) s += *(const LAS f32x4*)((LAS float*)lds + w * 4096 + (fg * 64 + lane) * 4);
            const float sc = f.begin(MBIG + r);
            const f32x4 hv = f.pre(MBIG + r, n0 + c4);
            const float ssq = f(MBIG + r, n0 + c4, s, hv, sc);
            f.end(MBIG + r, ssq, 0);
        }
        __syncthreads();
    }
}

__device__ __forceinline__ float rstd_of(const float* SS, int row) { return rsqrtf(SS[row] * (1.0f / D) + 1e-6f); }
struct EpStoreBf16 { static constexpr bool GATE = false; bf16_t* O; int ld;
    __device__ __forceinline__ float begin(int) const { return 1.f; }
    __device__ __forceinline__ f32x4 pre(int, int) const { return (f32x4){0.f, 0.f, 0.f, 0.f}; }
    __device__ __forceinline__ float operator()(int row, int col, f32x4 v, f32x4, float) const { if (row < M) { u32x2 w; w.x = pk2(v[0], v[1]); w.y = pk2(v[2], v[3]); *(u32x2*)(O + (size_t)row * ld + col) = w; } return 0.f; }
    __device__ __forceinline__ void end(int, float, int) const {} };
struct EpScaleStoreBf16 { static constexpr bool GATE = false; bf16_t* O; int ld; const float* SS;
    __device__ __forceinline__ float begin(int row) const { return rstd_of(SS, row < M ? row : M - 1); }
    __device__ __forceinline__ f32x4 pre(int, int) const { return (f32x4){0.f, 0.f, 0.f, 0.f}; }
    __device__ __forceinline__ float operator()(int row, int col, f32x4 v, f32x4, float s) const { if (row < M) { v = v * s; u32x2 w; w.x = pk2(v[0], v[1]); w.y = pk2(v[2], v[3]); *(u32x2*)(O + (size_t)row * ld + col) = w; } return 0.f; }
    __device__ __forceinline__ void end(int, float, int) const {} };
struct EpScaleStoreF32 { static constexpr bool GATE = false; float* O; int ld; const float* SS;
    __device__ __forceinline__ float begin(int row) const { return rstd_of(SS, row < M ? row : M - 1); }
    __device__ __forceinline__ f32x4 pre(int, int) const { return (f32x4){0.f, 0.f, 0.f, 0.f}; }
    __device__ __forceinline__ float operator()(int row, int col, f32x4 v, f32x4, float s) const { if (row < M) *(f32x4*)(O + (size_t)row * ld + col) = v * s; return 0.f; }
    __device__ __forceinline__ void end(int, float, int) const {} };
struct EpAddF32 { static constexpr bool GATE = false; float* H; int ld;
    __device__ __forceinline__ float begin(int) const { return 1.f; }
    __device__ __forceinline__ f32x4 pre(int row, int col) const { return *(const f32x4*)(H + (size_t)row * ld + col); }
    __device__ __forceinline__ float operator()(int row, int col, f32x4 v, f32x4 h, float) const { *(f32x4*)(H + (size_t)row * ld + col) = h + v; return 0.f; }
    __device__ __forceinline__ void end(int, float, int) const {} };
struct EpResid { static constexpr bool GATE = false; float* H; bf16_t* HB; float* SS;
    __device__ __forceinline__ float begin(int) const { return 1.f; }
    __device__ __forceinline__ f32x4 pre(int row, int col) const { return *(const f32x4*)(H + (size_t)row * D + col); }
    __device__ __forceinline__ float operator()(int row, int col, f32x4 v, f32x4 h0, float) const {
        const f32x4 h = h0 + v; *(f32x4*)(H + (size_t)row * D + col) = h;
        u32x2 w; w.x = pk2(h[0], h[1]); w.y = pk2(h[2], h[3]); *(u32x2*)(HB + (size_t)row * D + col) = w;
        return (h[0] * h[0] + h[1] * h[1]) + (h[2] * h[2] + h[3] * h[3]); }
    __device__ __forceinline__ void end(int row, float ssq, int kind) const {
        const int lane = threadIdx.x & 63;
        if (kind == 0) { ssq += __shfl_xor(ssq, 16); ssq += __shfl_xor(ssq, 32); if (lane < 16) atomicAdd(SS + row, ssq); }
        else { ssq = sum16(ssq); if ((lane & 15) == 0) atomicAdd(SS + row, ssq); } } };

__device__ __forceinline__ f32x4 dpp_ror(f32x4 v, const int which) {
    f32x4 o;
#pragma unroll
    for (int e = 0; e < 4; ++e) o[e] = which == 1 ? __int_as_float(__builtin_amdgcn_update_dpp(0, __float_as_int(v[e]), 0x121, 0xF, 0xF, false))
                                                  : __int_as_float(__builtin_amdgcn_update_dpp(0, __float_as_int(v[e]), 0x122, 0xF, 0xF, false));
    return o;
}
struct EpGate { static constexpr bool GATE = true; bf16_t* G; bf16_t* U; const float* SS; const float* dw;
    __device__ __forceinline__ float begin(int) const { return 1.f; }
    __device__ __forceinline__ f32x4 pre(int, int) const { return (f32x4){0.f, 0.f, 0.f, 0.f}; }
    __device__ __forceinline__ float operator()(int, int, f32x4, f32x4, float) const { return 0.f; }
    __device__ __forceinline__ void end(int, float, int) const {}
    __device__ __forceinline__ void tile(f32x4 (&acc)[2][2][4][2], int pm, int pn, int wr, int wc, int fr, int fq) const {
        const int rowb = pm * 256 + wr * 64 + fr;
        f32x4 wva[2][3], wga[2][3];
#pragma unroll
        for (int n = 0; n < 2; ++n)
#pragma unroll
            for (int j = 0; j < 3; ++j) { const int chh = pn * 128 + wc * 32 + n * 16 + 4 * fq; wva[n][j] = *(const f32x4*)(dw + j * NUP + chh); wga[n][j] = *(const f32x4*)(dw + j * NUP + DFF + chh); }
#pragma unroll
        for (int ai = 0; ai < 2; ++ai)
#pragma unroll
            for (int m = 0; m < 4; ++m) {
                const int row = rowb + ai * 128 + m * 16;
                const float s = rstd_of(SS, row < M ? row : M - 1);
#pragma unroll
                for (int bj = 0; bj < 2; ++bj)
#pragma unroll
                    for (int n = 0; n < 2; ++n) acc[ai][bj][m][n] = acc[ai][bj][m][n] * s;
            }
#pragma unroll
        for (int n = 0; n < 2; ++n) {
            const int ch = pn * 128 + wc * 32 + n * 16 + 4 * fq;
            const int ucol = pn * 256 + wc * 32 + n * 16 + 4 * fq;
            f32x4 wv[3], wg[3];
#pragma unroll
            for (int j = 0; j < 3; ++j) { wv[j] = wva[n][j]; wg[j] = wga[n][j]; }
#pragma unroll
            for (int ai = 0; ai < 2; ++ai)
#pragma unroll
                for (int m = 0; m < 4; ++m) {
                    const int row = rowb + ai * 128 + m * 16;
                    const f32x4 cv = acc[ai][0][m][n], cg = acc[ai][1][m][n];
                    const f32x4 zv = (f32x4){0.f, 0.f, 0.f, 0.f};
                    const f32x4 pv = m > 0 ? acc[ai][0][m > 0 ? m - 1 : 0][n] : zv, pg = m > 0 ? acc[ai][1][m > 0 ? m - 1 : 0][n] : zv;
                    f32x4 v1 = dpp_ror(fr == 15 ? pv : cv, 1), v2 = dpp_ror(fr >= 14 ? pv : cv, 2);
                    f32x4 g1 = dpp_ror(fr == 15 ? pg : cg, 1), g2 = dpp_ror(fr >= 14 ? pg : cg, 2);
                    const int t = row % L;
                    if (t == 0) { v1 = zv; g1 = zv; }
                    if (t <= 1) { v2 = zv; g2 = zv; }
                    const f32x4 val = v2 * wv[0] + v1 * wv[1] + cv * wv[2], gat = g2 * wg[0] + g1 * wg[1] + cg * wg[2];
                    const bool edge_lo = (m == 0 && fr < 2), edge_hi = (m == 3 && fr >= 14);
                    if (row < M) {
                        if (!edge_lo) {
                            u32x2 w; w.x = pk2(fsilu(gat[0]) * val[0], fsilu(gat[1]) * val[1]); w.y = pk2(fsilu(gat[2]) * val[2], fsilu(gat[3]) * val[3]);
                            *(u32x2*)(G + (size_t)row * DFF + ch) = w;
                        }
                        if (edge_lo || edge_hi) {
                            u32x2 a, b; a.x = pk2(cv[0], cv[1]); a.y = pk2(cv[2], cv[3]); b.x = pk2(cg[0], cg[1]); b.y = pk2(cg[2], cg[3]);
                            *(u32x2*)(U + (size_t)row * NUP + ucol) = a; *(u32x2*)(U + (size_t)row * NUP + ucol + 128) = b;
                        }
                    }
                }
        }
    }
};
__device__ __forceinline__ void gate_fixup_phase(const bf16_t* __restrict__ U, const float* __restrict__ dw, bf16_t* __restrict__ G) {
    const int gtid = blockIdx.x * NTHREADS + threadIdx.x, nth = gridDim.x * NTHREADS;
    constexpr int NC4 = DFF / 4, NBLK = M / 64;
    for (int idx = gtid; idx < NBLK * 2 * NC4; idx += nth) {
        const int c4 = idx % NC4, rr = (idx / NC4) & 1, blk = idx / (2 * NC4);
        const int row = blk * 64 + rr, t = row % L, ch = c4 * 4;
        const int ucol = (ch >> 7) * 256 + (ch & 127);
        f32x4 val = (f32x4){0.f, 0.f, 0.f, 0.f}, gat = val;
#pragma unroll
        for (int j = 0; j < 3; ++j) {
            if (t - 2 + j >= 0) {
                const bf16_t* ur = U + (size_t)(row - 2 + j) * NUP + ucol;
                const u32x2 a = *(const u32x2*)(ur), b = *(const u32x2*)(ur + 128);
                const f32x4 wv = *(const f32x4*)(dw + j * NUP + ch), wg = *(const f32x4*)(dw + j * NUP + DFF + ch);
                val += (f32x4){lo_f(a.x), hi_f(a.x), lo_f(a.y), hi_f(a.y)} * wv; gat += (f32x4){lo_f(b.x), hi_f(b.x), lo_f(b.y), hi_f(b.y)} * wg;
            }
        }
        u32x2 w; w.x = pk2(fsilu(gat[0]) * val[0], fsilu(gat[1]) * val[1]); w.y = pk2(fsilu(gat[2]) * val[2], fsilu(gat[3]) * val[3]);
        *(u32x2*)(G + (size_t)row * DFF + ch) = w;
    }
}

struct EpResid0 { static constexpr bool GATE = false; const float* x; const float* meta; float* H; bf16_t* HB; float* SS;
    __device__ __forceinline__ float begin(int) const { return 1.f; }
    __device__ __forceinline__ f32x4 pre(int row, int col) const { const int b = row / L, t = row - b * L;
        return *(const f32x4*)((t < NMETA ? meta + (size_t)t * D : x + ((size_t)b * SEQ + (t - NMETA)) * D) + col); }
    __device__ __forceinline__ float operator()(int row, int col, f32x4 v, f32x4 h0, float) const {
        const f32x4 h = h0 + v; *(f32x4*)(H + (size_t)row * D + col) = h;
        u32x2 w; w.x = pk2(h[0], h[1]); w.y = pk2(h[2], h[3]); *(u32x2*)(HB + (size_t)row * D + col) = w;
        return (h[0] * h[0] + h[1] * h[1]) + (h[2] * h[2] + h[3] * h[3]); }
    __device__ __forceinline__ void end(int row, float ssq, int kind) const {
        const int lane = threadIdx.x & 63;
        if (kind == 0) { ssq += __shfl_xor(ssq, 16); ssq += __shfl_xor(ssq, 32); if (lane < 16) atomicAdd(SS + row, ssq); }
        else { ssq = sum16(ssq); if ((lane & 15) == 0) atomicAdd(SS + row, ssq); } } };

template <class F>
__device__ __forceinline__ void gemm_full(LAS unsigned char* lds, const bf16_t* A, const bf16_t* Bt, int N, int K, const F& f) {
    pg8::StaticOrder S; S.init(MBIG, N, (int)gridDim.x, (int)blockIdx.x);
    pg8::gemm_phase(lds, A, Bt, K, S, f);
    gemm_rem_phase(lds, A, Bt, N, K, f);
}

__device__ __forceinline__ void convert_item(const float* __restrict__ src, bf16_t* __restrict__ dst, int K, int N, const float* __restrict__ gain, int item, int lane) {
    const int tk = K / 64;
    const int kk0 = (item % tk) * 64 + (lane & 7) * 8, n4 = (item / tk) * 32 + (lane >> 3) * 4;
    f32x4 v[8];
#pragma unroll
    for (int i = 0; i < 8; ++i) v[i] = (n4 < N) ? *(const f32x4*)(src + (size_t)(kk0 + i) * N + n4) : (f32x4){0.f, 0.f, 0.f, 0.f};
    if (gain) {
        const f32x4 g0 = *(const f32x4*)(gain + kk0), g1 = *(const f32x4*)(gain + kk0 + 4);
#pragma unroll
        for (int i = 0; i < 4; ++i) { v[i] = v[i] * g0[i]; v[4 + i] = v[4 + i] * g1[i]; }
    }
#pragma unroll
    for (int e = 0; e < 4; ++e) {
        u32x4 w; w.x = pk2(v[0][e], v[1][e]); w.y = pk2(v[2][e], v[3][e]); w.z = pk2(v[4][e], v[5][e]); w.w = pk2(v[6][e], v[7][e]);
        *(u32x4*)(dst + (size_t)(n4 + e) * K + kk0) = w;
    }
}
__device__ __forceinline__ void convert_wt(const float* __restrict__ src, bf16_t* __restrict__ dst, int K, int N, int Npad, const float* __restrict__ gain, LAS unsigned char* lds) {
    const int nitems = (K / 64) * (Npad / 32), lane = threadIdx.x & 63;
    for (int it = blockIdx.x * 8 + (threadIdx.x >> 6); it < nitems; it += gridDim.x * 8) convert_item(src, dst, K, N, gain, it, lane);
}
__device__ __forceinline__ int up_src_col(int n) { return ((n & 128) ? DFF : 0) + ((n >> 8) << 7) + (n & 127); }
template <bool PERMUP>
__device__ __forceinline__ void convert_item2(const float* __restrict__ src, bf16_t* __restrict__ dst, int K, int N, const float* __restrict__ gain, int itemA, int itemB, bool hasB, int lane) {
    const int tk = K / 64;
    int kk0[2], n4[2];
    kk0[0] = (itemA % tk) * 64 + (lane & 7) * 8; n4[0] = (itemA / tk) * 32 + (lane >> 3) * 4;
    const int ib = hasB ? itemB : itemA;
    kk0[1] = (ib % tk) * 64 + (lane & 7) * 8; n4[1] = (ib / tk) * 32 + (lane >> 3) * 4;
    f32x4 v[2][8];
#pragma unroll
    for (int u = 0; u < 2; ++u)
#pragma unroll
        for (int i = 0; i < 8; ++i) v[u][i] = (n4[u] < N) ? *(const f32x4*)(src + (size_t)(kk0[u] + i) * N + (PERMUP ? up_src_col(n4[u]) : n4[u])) : (f32x4){0.f, 0.f, 0.f, 0.f};
#pragma unroll
    for (int u = 0; u < 2; ++u) {
        if (u == 1 && !hasB) break;
        if (gain) {
            const f32x4 g0 = *(const f32x4*)(gain + kk0[u]), g1 = *(const f32x4*)(gain + kk0[u] + 4);
#pragma unroll
            for (int i = 0; i < 4; ++i) { v[u][i] = v[u][i] * g0[i]; v[u][4 + i] = v[u][4 + i] * g1[i]; }
        }
#pragma unroll
        for (int e = 0; e < 4; ++e) {
            u32x4 w; w.x = pk2(v[u][0][e], v[u][1][e]); w.y = pk2(v[u][2][e], v[u][3][e]); w.z = pk2(v[u][4][e], v[u][5][e]); w.w = pk2(v[u][6][e], v[u][7][e]);
            *(u32x4*)(dst + (size_t)(n4[u] + e) * K + kk0[u]) = w;
        }
    }
}
template <bool PERMUP = false>
__device__ __forceinline__ void convert_steal(const float* __restrict__ src, bf16_t* __restrict__ dst, int K, int N, int Npad, const float* __restrict__ gain, unsigned* ctr, LAS unsigned char* lds) {
    const int nitems = (K / 64) * (Npad / 32), lane = threadIdx.x & 63, wid = threadIdx.x >> 6;
    volatile LAS unsigned* slot = (volatile LAS unsigned*)(lds + LDS_ST_OFF + 8);
    if (threadIdx.x == 0) *slot = __hip_atomic_fetch_add(ctr, 64u, __ATOMIC_RELAXED, __HIP_MEMORY_SCOPE_AGENT);
    __syncthreads();
    int t0 = (int)*slot;
    __syncthreads();
    while (t0 < nitems) {
        unsigned nxt = 0u;
        if (threadIdx.x == 0) nxt = __hip_atomic_fetch_add(ctr, 64u, __ATOMIC_RELAXED, __HIP_MEMORY_SCOPE_AGENT);
#pragma unroll 1
        for (int q = 0; q < 8; q += 2) {
            const int ia = t0 + wid + 8 * q, ib = ia + 8;
            if (ia < nitems) convert_item2<PERMUP>(src, dst, K, N, gain, ia, ib, ib < nitems, lane);
        }
        if (threadIdx.x == 0) *slot = nxt;
        __syncthreads();
        t0 = (int)*slot;
        __syncthreads();
    }
}

template <int MODE>
__device__ __forceinline__ void rms_phase(const float* __restrict__ h_in, float* __restrict__ h_out, const float* __restrict__ x, const float* __restrict__ meta,
                          const float* __restrict__ gain, bf16_t* __restrict__ hn, float* __restrict__ out) {
    const int lane = threadIdx.x & 63, gw = blockIdx.x * 8 + (threadIdx.x >> 6), nw = gridDim.x * 8;
    for (int row = gw; row < M; row += nw) {
        const int b = row / L, t = row - b * L;
        if (MODE == 2 && t < NMETA) continue;
        const float* src;
        if (MODE == 1) src = (t < NMETA) ? meta + (size_t)t * D : x + ((size_t)b * SEQ + (t - NMETA)) * D;
        else src = h_in + (size_t)row * D;
        f32x4 v[8]; float ss = 0.f;
#pragma unroll
        for (int i = 0; i < 8; ++i) { v[i] = *(const f32x4*)(src + (lane + i * 64) * 4); ss += v[i][0] * v[i][0] + v[i][1] * v[i][1] + v[i][2] * v[i][2] + v[i][3] * v[i][3]; }
        ss = wave_sum(ss);
        const float r = rsqrtf(ss * (1.0f / D) + 1e-6f);
#pragma unroll
        for (int i = 0; i < 8; ++i) {
            const int c = (lane + i * 64) * 4;
            const f32x4 g = *(const f32x4*)(gain + c);
            const f32x4 o = v[i] * r * g;
            if (MODE == 2) *(f32x4*)(out + ((size_t)b * SEQ + (t - NMETA)) * D + c) = o;
            else { u32x2 w; w.x = pk2(o[0], o[1]); w.y = pk2(o[2], o[3]); *(u32x2*)(hn + (size_t)row * D + c) = w; }
        }
    }
}

__device__ __forceinline__ void mixer_ab_phase(const bf16_t* __restrict__ z1, const float* __restrict__ conf_dw, const float* __restrict__ conf_b, const float* __restrict__ ln_g,
                               const float* __restrict__ ln_b, const float* __restrict__ sc_dw, bf16_t* __restrict__ cat, LAS unsigned char* lds) {
    const int tid = threadIdx.x, wid = __builtin_amdgcn_readfirstlane(tid >> 6), lane = tid & 63;
    constexpr int TT = 33, TPB = (L + TT - 1) / TT;
    LAS unsigned* S32 = (LAS unsigned*)lds;
    LAS float* C = (LAS float*)lds;
    for (int tile = blockIdx.x; tile < NBATCH * TPB; tile += gridDim.x) {
        const int b = tile / TPB, t0 = (tile % TPB) * TT;
        const int nt = (L - t0) < TT ? (L - t0) : TT;
        static_assert((TT + 30) % 7 == 0, "staging loop is unrolled by 7");
#pragma unroll 1
        for (int r0 = 0; r0 < TT + 30; r0 += 7) {
            unsigned av[7], gv[7];
#pragma unroll
            for (int u = 0; u < 7; ++u) {
                const int t = t0 - 30 + r0 + u, tc = t < 0 ? 0 : (t >= L ? L - 1 : t);
                const bf16_t* zr = z1 + (size_t)(b * L + tc) * NAB;
                av[u] = *(const unsigned*)(zr + 2 * tid); gv[u] = *(const unsigned*)(zr + 1024 + 2 * tid);
            }
#pragma unroll
            for (int u = 0; u < 7; ++u) {
                const int t = t0 - 30 + r0 + u;
                unsigned w = pk2(lo_f(av[u]) * fsigm(lo_f(gv[u])), hi_f(av[u]) * fsigm(hi_f(gv[u])));
                if (t < 0 || t >= L) w = 0u;
                S32[(r0 + u) * 512 + tid] = w;
            }
        }
        __syncthreads();
        f32x2 acc[TT];
#pragma unroll
        for (int t = 0; t < TT; ++t) acc[t] = (f32x2){0.f, 0.f};
        f32x2 wnext = *(const f32x2*)(conf_dw + 2 * tid);
#pragma unroll 1
        for (int j = 0; j < 31; ++j) {
            const f32x2 w = wnext;
            wnext = *(const f32x2*)(conf_dw + (j < 30 ? j + 1 : j) * 1024 + 2 * tid);
#pragma unroll
            for (int t = 0; t < TT; ++t) { const unsigned xw = S32[(t + j) * 512 + tid]; acc[t] += (f32x2){lo_f(xw), hi_f(xw)} * w; }
        }
        const f32x2 bias = *(const f32x2*)(conf_b + 2 * tid);
        __syncthreads();
#pragma unroll
        for (int t = 0; t < TT; ++t) *(LAS f32x2*)(C + t * 1024 + 2 * tid) = acc[t] + bias;
        __syncthreads();
        for (int q = 0; q < 5; ++q) {
            const int tt = wid + 8 * q;
            if (tt < nt) {
                f32x4 v[4]; float s = 0.f;
#pragma unroll
                for (int i = 0; i < 4; ++i) { v[i] = *(const LAS f32x4*)(C + tt * 1024 + (lane + i * 64) * 4); s += (v[i][0] + v[i][1]) + (v[i][2] + v[i][3]); }
                const float mean = wave_sum(s) * (1.0f / 1024.0f);
                float qv = 0.f;
#pragma unroll
                for (int i = 0; i < 4; ++i) { const f32x4 d = v[i] - mean; qv += d[0] * d[0] + d[1] * d[1] + d[2] * d[2] + d[3] * d[3]; }
                const float rstd = rsqrtf(wave_sum(qv) * (1.0f / 1024.0f) + 1e-5f);
                bf16_t* orow = cat + (size_t)(b * L + t0 + tt) * D;
#pragma unroll
                for (int i = 0; i < 4; ++i) {
                    const int c = (lane + i * 64) * 4;
                    const f32x4 g = *(const f32x4*)(ln_g + c), bb = *(const f32x4*)(ln_b + c);
                    const f32x4 y = (v[i] - mean) * rstd * g + bb;
                    u32x2 w; w.x = pk2(fsilu(y[0]), fsilu(y[1])); w.y = pk2(fsilu(y[2]), fsilu(y[3]));
                    *(u32x2*)(orow + c) = w;
                }
            }
        }
        __syncthreads();
    }
    const int gtid = blockIdx.x * NTHREADS + tid, nth = gridDim.x * NTHREADS;
    for (int idx = gtid; idx < M * 128; idx += nth) {
        const int row = idx >> 7, c = (idx & 127) * 8, t = row % L;
        float acc[8];
#pragma unroll
        for (int e = 0; e < 8; ++e) acc[e] = 0.f;
#pragma unroll
        for (int j = 0; j < 3; ++j) {
            if (t - 2 + j >= 0) {
                const bf16_t* zr = z1 + (size_t)(row - 2 + j) * NAB;
                const u32x4 sc = *(const u32x4*)(zr + 3072 + c), sx = *(const u32x4*)(zr + 4096 + c);
                const f32x4 w0 = *(const f32x4*)(sc_dw + j * 1024 + c), w1 = *(const f32x4*)(sc_dw + j * 1024 + c + 4);
                acc[0] += lo_f(sc.x) * lo_f(sx.x) * w0[0]; acc[1] += hi_f(sc.x) * hi_f(sx.x) * w0[1];
                acc[2] += lo_f(sc.y) * lo_f(sx.y) * w0[2]; acc[3] += hi_f(sc.y) * hi_f(sx.y) * w0[3];
                acc[4] += lo_f(sc.z) * lo_f(sx.z) * w1[0]; acc[5] += hi_f(sc.z) * hi_f(sx.z) * w1[1];
                acc[6] += lo_f(sc.w) * lo_f(sx.w) * w1[2]; acc[7] += hi_f(sc.w) * hi_f(sx.w) * w1[3];
            }
        }
        const u32x4 sb = *(const u32x4*)(z1 + (size_t)row * NAB + 2048 + c);
        u32x4 o;
        o.x = pk2(lo_f(sb.x) * acc[0], hi_f(sb.x) * acc[1]); o.y = pk2(lo_f(sb.y) * acc[2], hi_f(sb.y) * acc[3]);
        o.z = pk2(lo_f(sb.z) * acc[4], hi_f(sb.z) * acc[5]); o.w = pk2(lo_f(sb.w) * acc[6], hi_f(sb.w) * acc[7]);
        *(u32x4*)(cat + (size_t)row * D + 1024 + c) = o;
    }
}

__device__ __forceinline__ void ffn_gate_phase(const bf16_t* __restrict__ u, const float* __restrict__ dw  , bf16_t* __restrict__ g) {
    const int gtid = blockIdx.x * NTHREADS + threadIdx.x, nth = gridDim.x * NTHREADS;
    constexpr int NC8 = DFF / 8, NRUN = L / 16;
    for (int idx = gtid; idx < NBATCH * NRUN * NC8; idx += nth) {
        const int c = (idx % NC8) * 8, run = (idx / NC8) % NRUN, b = idx / (NC8 * NRUN), t0 = run * 16;
        float wv[3][8], wg[3][8];
#pragma unroll
        for (int j = 0; j < 3; ++j) {
            const f32x4 a0 = *(const f32x4*)(dw + j * NUP + c), a1 = *(const f32x4*)(dw + j * NUP + c + 4);
            const f32x4 g0 = *(const f32x4*)(dw + j * NUP + DFF + c), g1 = *(const f32x4*)(dw + j * NUP + DFF + c + 4);
#pragma unroll
            for (int e = 0; e < 4; ++e) { wv[j][e] = a0[e]; wv[j][4 + e] = a1[e]; wg[j][e] = g0[e]; wg[j][4 + e] = g1[e]; }
        }
        u32x4 v2 = (u32x4){0u, 0u, 0u, 0u}, v1 = v2, g2 = v2, g1 = v2;
        if (t0 >= 2) {
            const bf16_t* r2 = u + (size_t)(b * L + t0 - 2) * NUP; const bf16_t* r1 = r2 + NUP;
            v2 = *(const u32x4*)(r2 + c); g2 = *(const u32x4*)(r2 + DFF + c); v1 = *(const u32x4*)(r1 + c); g1 = *(const u32x4*)(r1 + DFF + c);
        }
#pragma unroll 4
        for (int i = 0; i < 16; ++i) {
            const size_t row = (size_t)(b * L + t0 + i);
            const u32x4 v0 = *(const u32x4*)(u + row * NUP + c), g0 = *(const u32x4*)(u + row * NUP + DFF + c);
            float val[8], gat[8];
#define TAP(e, W2, W1, W0, sel) \
            val[e] = sel(v2.W2) * wv[0][e] + sel(v1.W1) * wv[1][e] + sel(v0.W0) * wv[2][e]; gat[e] = sel(g2.W2) * wg[0][e] + sel(g1.W1) * wg[1][e] + sel(g0.W0) * wg[2][e];
            TAP(0, x, x, x, lo_f) TAP(1, x, x, x, hi_f) TAP(2, y, y, y, lo_f) TAP(3, y, y, y, hi_f)
            TAP(4, z, z, z, lo_f) TAP(5, z, z, z, hi_f) TAP(6, w, w, w, lo_f) TAP(7, w, w, w, hi_f)
#undef TAP
            u32x4 o;
            o.x = pk2(fsilu(gat[0]) * val[0], fsilu(gat[1]) * val[1]); o.y = pk2(fsilu(gat[2]) * val[2], fsilu(gat[3]) * val[3]);
            o.z = pk2(fsilu(gat[4]) * val[4], fsilu(gat[5]) * val[5]); o.w = pk2(fsilu(gat[6]) * val[6], fsilu(gat[7]) * val[7]);
            *(u32x4*)(g + row * DFF + c) = o;
            v2 = v1; g2 = g1; v1 = v0; g1 = g0;
        }
    }
}

struct CD {
    const float *z2, *gla_w2, *gla_b, *gla_norm_g, *rw_mu, *rw_w0, *rw_a0, *rw_kk, *rw_ka, *rw_rk, *rw_ln_g, *rw_ln_b;
    float *R, *KR, *VR, *G, *Y, *CDEC, *BONUS, *DECAY, *A, *KK, *O;
    bf16_t *LW, *LA, *LG, *GATE, *QDEC, *KDEC, *K2T, *VT, *W2T, *A2T, *G2T, *CST, *SPT, *P, *CAT;
};

__device__ __forceinline__ void prep1_phase(const CD& p, LAS unsigned char* lds) {
    const int tid = threadIdx.x, wid = __builtin_amdgcn_readfirstlane(tid >> 6), lane = tid & 63;
    LAS float* tot = (LAS float*)lds;
    for (int item = blockIdx.x; item < NGI; item += gridDim.x) {
        const int bh = item / NCH, n = item - bh * NCH, b = bh >> 2, h = bh & 3;
        const int pg = wid >> 1, d = (wid & 1) * 64 + lane;
        float w2r[16];
#pragma unroll
        for (int r = 0; r < 16; ++r) w2r[r] = p.gla_w2[r * 512 + h * 128 + d];
        const float bias = p.gla_b[h * 128 + d];
        float la[16]; float run = 0.f;
#pragma unroll
        for (int i = 0; i < 16; ++i) {
            const int t = n * 64 + pg * 16 + i - 48;
            float v = 0.f;
            if (t >= 0 && t < L) {
                const float* gl = p.z2 + (size_t)(b * L + t) * NCDP + 3072;
                float xx = bias;
#pragma unroll
                for (int r = 0; r < 16; ++r) xx += gl[r] * w2r[r];
                v = logsig(xx) * (1.0f / 16.0f);
            }
            run += v; la[i] = run;
        }
        tot[pg * 128 + d] = run;
        __syncthreads();
        float off = 0.f, last = 0.f;
#pragma unroll
        for (int g4 = 0; g4 < 4; ++g4) { const float tv = tot[g4 * 128 + d]; if (g4 < pg) off += tv; last += tv; }
        unsigned k2p[8];
#pragma unroll
        for (int i = 0; i < 16; ++i) {
            const int pp = pg * 16 + i, t = n * 64 + pp - 48;
            const float cum = off + la[i];
            float q = 0.f, k = 0.f;
            if (t >= 0 && t < L) { const float* zr = p.z2 + (size_t)(b * L + t) * NCDP; q = zr[h * 128 + d] * 0.08838834764831845f; k = zr[512 + h * 128 + d]; }
            const float qd = q * expf(cum), kd = k * expf(-cum), k2 = k * expf(last - cum);
            p.QDEC[((size_t)item * 64 + pp) * 128 + d] = (bf16_t)f2bf(qd);
            p.KDEC[((size_t)item * 64 + pp) * 128 + d] = (bf16_t)f2bf(kd);
            if (i & 1) k2p[i >> 1] |= f2bf(k2) << 16; else k2p[i >> 1] = f2bf(k2);
        }
        {
            bf16_t* dst = p.K2T + ((size_t)item * 128 + d) * 64 + pg * 16;
            *(u32x4*)(dst) = (u32x4){k2p[0], k2p[1], k2p[2], k2p[3]};
            *(u32x4*)(dst + 8) = (u32x4){k2p[4], k2p[5], k2p[6], k2p[7]};
        }
        if (pg == 0) p.CDEC[item * 128 + d] = expf(last);
        {
            const int v = tid & 255, ph = tid >> 8;
            unsigned vp[16];
#pragma unroll
            for (int i = 0; i < 32; ++i) {
                const int t = n * 64 + ph * 32 + i - 48;
                float xv = 0.f;
                if (t >= 0 && t < L) xv = p.z2[(size_t)(b * L + t) * NCDP + 1024 + h * 256 + v];
                if (i & 1) vp[i >> 1] |= f2bf(xv) << 16; else vp[i >> 1] = f2bf(xv);
            }
            bf16_t* dst = p.VT + ((size_t)item * 256 + v) * 64 + ph * 32;
#pragma unroll
            for (int s = 0; s < 4; ++s) *(u32x4*)(dst + s * 8) = (u32x4){vp[s * 4 + 0], vp[s * 4 + 1], vp[s * 4 + 2], vp[s * 4 + 3]};
        }
        __syncthreads();
    }
    const int gtid = blockIdx.x * NTHREADS + tid, nth = gridDim.x * NTHREADS;
    for (int base = gtid; base < M * 256; base += nth * 4) {
        f32x4 go[4], ng[4];
#pragma unroll
        for (int u = 0; u < 4; ++u) {
            const int idx = base + u * nth, ic = idx < M * 256 ? idx : 0, row = ic >> 8, c = (ic & 255) * 4;
            go[u] = *(const f32x4*)(p.z2 + (size_t)row * NCDP + 2048 + c); ng[u] = *(const f32x4*)(p.gla_norm_g + c);
        }
#pragma unroll
        for (int u = 0; u < 4; ++u) {
            const int idx = base + u * nth;
            if (idx < M * 256) {
                const int row = idx >> 8, c = (idx & 255) * 4;
                u32x2 w; w.x = pk2(fsilu(go[u][0]) * ng[u][0], fsilu(go[u][1]) * ng[u][1]); w.y = pk2(fsilu(go[u][2]) * ng[u][2], fsilu(go[u][3]) * ng[u][3]);
                *(u32x2*)(p.GATE + (size_t)row * 1024 + c) = w;
            }
        }
    }
    for (int base = gtid; base < M * 832; base += nth * 4) {
        f32x4 zv[4], zpv[4], muv[4];
#pragma unroll
        for (int u = 0; u < 4; ++u) {
            const int idx = base + u * nth, ic = idx < M * 832 ? idx : 0, row = ic / 832, c4 = (ic - row * 832) * 4, t = row % L;
            zv[u] = *(const f32x4*)(p.z2 + (size_t)row * NCDP + 3088 + c4);
            zpv[u] = *(const f32x4*)(p.z2 + (size_t)(t > 0 ? row - 1 : row) * NCDP + 3088 + c4);
            if (t == 0) zpv[u] = (f32x4){0.f, 0.f, 0.f, 0.f};
            muv[u] = *(const f32x4*)(p.rw_mu + c4);
        }
#pragma unroll
        for (int u = 0; u < 4; ++u) {
        const int idx = base + u * nth;
        if (idx >= M * 832) continue;
        const int row = idx / 832, c4 = (idx - row * 832) * 4;
        const f32x4 zr = zv[u] + (zpv[u] - zv[u]) * muv[u];
        if (c4 < 1024) *(f32x4*)(p.R + (size_t)row * 1024 + c4) = zr;
        else if (c4 < 2048) *(f32x4*)(p.KR + (size_t)row * 1024 + c4 - 1024) = zr;
        else if (c4 < 3072) *(f32x4*)(p.VR + (size_t)row * 1024 + c4 - 2048) = zr;
        else if (c4 < 3136) { u32x2 w; w.x = pk2(tanhf(zr[0]), tanhf(zr[1])); w.y = pk2(tanhf(zr[2]), tanhf(zr[3])); *(u32x2*)(p.LW + (size_t)row * 64 + c4 - 3072) = w; }
        else if (c4 < 3200) { u32x2 w; w.x = pk2(zr[0], zr[1]); w.y = pk2(zr[2], zr[3]); *(u32x2*)(p.LA + (size_t)row * 64 + c4 - 3136) = w; }
        else { u32x2 w; w.x = pk2(sigm(zr[0]), sigm(zr[1])); w.y = pk2(sigm(zr[2]), sigm(zr[3])); *(u32x2*)(p.LG + (size_t)row * 128 + c4 - 3200) = w; }
        }
    }
}

__device__ __forceinline__ void small_gemm_phase(const CD& p) {
    const int lane = threadIdx.x & 63, fr = lane & 15, fq = lane >> 4;
    const int gw = blockIdx.x * 8 + (threadIdx.x >> 6), nw = gridDim.x * 8;
    constexpr int TL = (M / 64) * 16;
    constexpr int T0 = 3 * TL, T1 = T0 + NGI, T2 = T1 + NGI * 8;
    for (int tix = gw; tix < T2; tix += nw) {
        f32x4 acc[4][4]; zero_acc(acc);
        if (tix < T0) {
            const int which = tix / TL, r = tix - which * TL, m0 = (r >> 4) * 64, n0 = (r & 15) * 64;
            if (which == 0) {
                f32x4 w0v[4];
#pragma unroll
                for (int ni = 0; ni < 4; ++ni) w0v[ni] = *(const f32x4*)(p.rw_w0 + n0 + ni * 16 + fq * 4);
                wave_tile_mma<2>(p.LW + (size_t)m0 * 64, 64, p.W2T + (size_t)n0 * 64, 64, 0, 64, acc, fr, fq);
#pragma unroll
                for (int mi = 0; mi < 4; ++mi)
#pragma unroll
                    for (int ni = 0; ni < 4; ++ni) {
                        const int row = m0 + mi * 16 + fr, col = n0 + ni * 16 + fq * 4;
                        const f32x4 w0 = w0v[ni]; f32x4 o;
#pragma unroll
                        for (int e = 0; e < 4; ++e) o[e] = expf(-0.6065306597126334f * sigm(w0[e] + acc[mi][ni][e]));
                        *(f32x4*)(p.DECAY + (size_t)row * 1024 + col) = o;
                    }
            } else if (which == 1) {
                f32x4 a0v[4];
#pragma unroll
                for (int ni = 0; ni < 4; ++ni) a0v[ni] = *(const f32x4*)(p.rw_a0 + n0 + ni * 16 + fq * 4);
                wave_tile_mma<2>(p.LA + (size_t)m0 * 64, 64, p.A2T + (size_t)n0 * 64, 64, 0, 64, acc, fr, fq);
#pragma unroll
                for (int mi = 0; mi < 4; ++mi)
#pragma unroll
                    for (int ni = 0; ni < 4; ++ni) {
                        const int row = m0 + mi * 16 + fr, col = n0 + ni * 16 + fq * 4;
                        const f32x4 a0 = a0v[ni]; f32x4 o;
#pragma unroll
                        for (int e = 0; e < 4; ++e) o[e] = fsigm(a0[e] + acc[mi][ni][e]);
                        *(f32x4*)(p.A + (size_t)row * 1024 + col) = o;
                    }
            } else {
                wave_tile_mma<4>(p.LG + (size_t)m0 * 128, 128, p.G2T + (size_t)n0 * 128, 128, 0, 128, acc, fr, fq);
#pragma unroll
                for (int mi = 0; mi < 4; ++mi)
#pragma unroll
                    for (int ni = 0; ni < 4; ++ni) {
                        const int row = m0 + mi * 16 + fr, col = n0 + ni * 16 + fq * 4;
                        *(f32x4*)(p.G + (size_t)row * 1024 + col) = acc[mi][ni];
                    }
            }
        } else if (tix < T1) {
            const int item = tix - T0;
            wave_tile_mma<4>(p.QDEC + (size_t)item * 8192, 128, p.KDEC + (size_t)item * 8192, 128, 0, 128, acc, fr, fq);
#pragma unroll
            for (int mi = 0; mi < 4; ++mi)
#pragma unroll
                for (int ni = 0; ni < 4; ++ni) {
                    const int pp = mi * 16 + fr, s0 = ni * 16 + fq * 4;
                    f32x4 v = acc[mi][ni];
#pragma unroll
                    for (int e = 0; e < 4; ++e) if (s0 + e > pp) v[e] = 0.f;
                    u32x2 w; w.x = pk2(v[0], v[1]); w.y = pk2(v[2], v[3]);
                    *(u32x2*)(p.P + (size_t)item * 4096 + pp * 64 + s0) = w;
                }
        } else {
            const int r = tix - T1, item = r >> 3, vt = (r >> 1) & 3, dt = r & 1;
            wave_tile_mma<2>(p.VT + ((size_t)item * 256 + vt * 64) * 64, 64, p.K2T + ((size_t)item * 128 + dt * 64) * 64, 64, 0, 64, acc, fr, fq);
#pragma unroll
            for (int mi = 0; mi < 4; ++mi)
#pragma unroll
                for (int ni = 0; ni < 4; ++ni) {
                    const int v = vt * 64 + mi * 16 + fr, d0 = dt * 64 + ni * 16 + fq * 4;
                    u32x2 w; w.x = pk2(acc[mi][ni][0], acc[mi][ni][1]); w.y = pk2(acc[mi][ni][2], acc[mi][ni][3]);
                    *(u32x2*)(p.CST + ((size_t)item * 256 + v) * 128 + d0) = w;
                }
        }
    }
}

__device__ __forceinline__ void prep2_phase(const CD& p) {
    const int gtid = blockIdx.x * NTHREADS + threadIdx.x, nth = gridDim.x * NTHREADS;
    for (int e = gtid; e < 16 * 256 * 32; e += nth) {
        const int d4 = (e & 31) * 4, v = (e >> 5) & 255, bh = e >> 13;
        f32x4 S = (f32x4){0.f, 0.f, 0.f, 0.f};
        const size_t o0 = ((size_t)(bh * NCH) * 256 + v) * 128 + d4;
        f32x4 decs[3]; u32x2 css[3];
#pragma unroll 1
        for (int n0 = 0; n0 < NCH; n0 += 3) {
#pragma unroll
            for (int u = 0; u < 3; ++u) { decs[u] = *(const f32x4*)(p.CDEC + (bh * NCH + n0 + u) * 128 + d4); css[u] = *(const u32x2*)(p.CST + o0 + (size_t)(n0 + u) * 32768); }
#pragma unroll
            for (int u = 0; u < 3; ++u) {
                u32x2 w; w.x = pk2(S[0], S[1]); w.y = pk2(S[2], S[3]);
                *(u32x2*)(p.SPT + o0 + (size_t)(n0 + u) * 32768) = w;
                S = S * decs[u] + (f32x4){lo_f(css[u].x), hi_f(css[u].x), lo_f(css[u].y), hi_f(css[u].y)};
            }
        }
    }
}

__device__ __forceinline__ void gla_out_phase(const CD& p) {
    const int lane = threadIdx.x & 63, fr = lane & 15, fq = lane >> 4;
    const int wv = threadIdx.x >> 6;
    const bool dealt = (gridDim.x == 256);
    const int cc = blockIdx.x & 3, g33 = (blockIdx.x >> 2) * 33;
    const int first = dealt ? g33 + (cc == 0 ? 0 : cc == 1 ? 10 : cc == 2 ? 18 : 26) : (int)(blockIdx.x * 8);
    const int cnt = dealt ? (cc == 0 ? 10 : cc == 3 ? 7 : 8) : 8;
    const int stride = dealt ? 8 : (int)(gridDim.x * 8);
    const int limit = dealt ? first + cnt : NGI * 4;
    for (int tix = first + wv; tix < limit; tix += stride) {
        const int item = tix >> 2, vt = tix & 3, bh = item / NCH, n = item - bh * NCH, b = bh >> 2, h = bh & 3;
        f32x4 acc[4][4]; zero_acc(acc);
        wave_tile_mma<2>(p.P + (size_t)item * 4096, 64, p.VT + ((size_t)item * 256 + vt * 64) * 64, 64, 0, 64, acc, fr, fq);
        wave_tile_mma<4>(p.QDEC + (size_t)item * 8192, 128, p.SPT + ((size_t)item * 256 + vt * 64) * 128, 128, 0, 128, acc, fr, fq);
#pragma unroll
        for (int mi = 0; mi < 4; ++mi) {
            const int t = n * 64 + mi * 16 + fr - 48;
            if (t >= 0 && t < L) {
#pragma unroll
                for (int ni = 0; ni < 4; ++ni) *(f32x4*)(p.O + (size_t)(b * L + t) * 1024 + h * 256 + vt * 64 + ni * 16 + fq * 4) = acc[mi][ni];
            }
        }
    }
}

__device__ __forceinline__ float oct_sum(float x) {
    x += __int_as_float(__builtin_amdgcn_update_dpp(0, __float_as_int(x), 0xB1, 0xF, 0xF, false));
    x += __int_as_float(__builtin_amdgcn_update_dpp(0, __float_as_int(x), 0x4E, 0xF, 0xF, false));
    x += __int_as_float(__builtin_amdgcn_update_dpp(0, __float_as_int(x), 0x141, 0xF, 0xF, false));
    return x;
}
struct StepOps { f32x4 r[2], w[2], k[2], kk[2], b[2]; float v; };
template <bool WITH_R>
__device__ __forceinline__ void ld_ops(StepOps& o, const LAS float* bp, int s, int j, int vidx) {
    const LAS float* sp = bp + s * 64 + j * 8;
    if (WITH_R) { o.r[0] = *(const LAS f32x4*)(sp); o.r[1] = *(const LAS f32x4*)(sp + 4); }
    o.w[0] = *(const LAS f32x4*)(sp + 2048); o.w[1] = *(const LAS f32x4*)(sp + 2048 + 4);
    o.k[0] = *(const LAS f32x4*)(sp + 4096); o.k[1] = *(const LAS f32x4*)(sp + 4096 + 4);
    o.kk[0] = *(const LAS f32x4*)(sp + 6144); o.kk[1] = *(const LAS f32x4*)(sp + 6144 + 4);
    o.b[0] = *(const LAS f32x4*)(sp + 8192); o.b[1] = *(const LAS f32x4*)(sp + 8192 + 4);
    o.v = bp[10240 + s * 64 + vidx];
}
template <bool WITH_V>
__device__ __forceinline__ void scan_update(f32x2 (&S)[4], const StepOps& o) {
    f32x2 sa2 = S[0] * o.kk[0].lo + S[1] * o.kk[0].hi;
    sa2 += S[2] * o.kk[1].lo + S[3] * o.kk[1].hi;
    const float sa = -oct_sum(sa2[0] + sa2[1]);
    const f32x2 sv = (f32x2){sa, sa};
    if (WITH_V) {
        const f32x2 vv = (f32x2){o.v, o.v};
        S[0] = S[0] * o.w[0].lo + (sv * o.b[0].lo + vv * o.k[0].lo);
        S[1] = S[1] * o.w[0].hi + (sv * o.b[0].hi + vv * o.k[0].hi);
        S[2] = S[2] * o.w[1].lo + (sv * o.b[1].lo + vv * o.k[1].lo);
        S[3] = S[3] * o.w[1].hi + (sv * o.b[1].hi + vv * o.k[1].hi);
    } else {
        S[0] = S[0] * o.w[0].lo + sv * o.b[0].lo;
        S[1] = S[1] * o.w[0].hi + sv * o.b[0].hi;
        S[2] = S[2] * o.w[1].lo + sv * o.b[1].lo;
        S[3] = S[3] * o.w[1].hi + sv * o.b[1].hi;
    }
}
__device__ __forceinline__ float scan_y(const f32x2 (&S)[4], const StepOps& o) {
    f32x2 y2 = S[0] * o.r[0].lo + S[1] * o.r[0].hi;
    y2 += S[2] * o.r[1].lo + S[3] * o.r[1].hi;
    return oct_sum(y2[0] + y2[1]);
}
template <int MODE>
__device__ __forceinline__ void rwkv_scan_pass(const CD& p, float* __restrict__ PSI, float* __restrict__ PHI, LAS unsigned char* lds) {
    constexpr int CL = L / 4, NSUB = (CL + 31) / 32;
    const int tid = threadIdx.x, wid = __builtin_amdgcn_readfirstlane(tid >> 6), lane = tid & 63;
    LAS float* buf = (LAS float*)lds;
    LAS float* Sm = (LAS float*)(lds + 98304);
    LAS float* Pm = (LAS float*)(lds + 114688);
    for (int item = blockIdx.x; item < 256; item += gridDim.x) {
        const int bh = item >> 2, c = item & 3, b = bh >> 4, h = bh & 15;
        const int rr = tid >> 4, c4 = (tid & 15) * 4;
        const size_t gbase = (size_t)(b * L + c * CL) * 1024 + h * 64 + c4;
        f32x4 st0, st1, st2, st4, st5;
        const f32x4 pkk = *(const f32x4*)(p.rw_kk + h * 64 + c4), pka = *(const f32x4*)(p.rw_ka + h * 64 + c4), prk = *(const f32x4*)(p.rw_rk + h * 64 + c4);
#define SCAN_LOADS(tn) do { const size_t _o = gbase + (size_t)(tn) * 1024; \
        if (MODE == 3) st0 = *(const f32x4*)(p.R + _o); st1 = *(const f32x4*)(p.DECAY + _o); st2 = *(const f32x4*)(p.KR + _o); \
        st4 = *(const f32x4*)(p.A + _o); st5 = *(const f32x4*)(p.VR + _o); } while (0)
#define SCAN_STORES(bb, tl) do { LAS float* _d = buf + (bb) * 12288 + rr * 64 + c4; \
        f32x4 _kk = st2 * pkk; const float _ss = sum16(_kk[0] * _kk[0] + _kk[1] * _kk[1] + _kk[2] * _kk[2] + _kk[3] * _kk[3]); \
        _kk = _kk * (1.0f / fmaxf(sqrtf(_ss), 1e-12f)); \
        const f32x4 _k = st2 * (1.0f + (st4 - 1.0f) * pka); \
        if (MODE == 3) { const f32x4 _rk = st0 * _k * prk; const float _bs = sum16((_rk[0] + _rk[1]) + (_rk[2] + _rk[3])); \
            if ((tid & 15) == 0 && (tl) < CL) p.BONUS[(size_t)(b * L + c * CL + (tl)) * 16 + h] = _bs; \
            *(LAS f32x4*)(_d) = st0; } \
        *(LAS f32x4*)(_d + 2048) = st1; *(LAS f32x4*)(_d + 4096) = _k; \
        *(LAS f32x4*)(_d + 6144) = _kk; *(LAS f32x4*)(_d + 8192) = _kk * st4; *(LAS f32x4*)(_d + 10240) = st5; } while (0)
        st0 = (f32x4){0.f, 0.f, 0.f, 0.f};
        SCAN_LOADS(rr);
        SCAN_STORES(0, rr);
        const int slot = lane >> 3, j = lane & 7, r = wid * 8 + slot;
        f32x2 S0[4], S1[4];
#pragma unroll
        for (int i = 0; i < 4; ++i) { S0[i] = (f32x2){0.f, 0.f}; S1[i] = (f32x2){(8 * j + 2 * i) == r ? 1.f : 0.f, (8 * j + 2 * i + 1) == r ? 1.f : 0.f}; }
        if (MODE == 3 && c > 0) {
            const float* ps0 = PSI + (size_t)(bh * 4) * 4096;
#pragma unroll
            for (int i = 0; i < 2; ++i) *(LAS f32x4*)(Sm + (tid + i * 512) * 4) = *(const f32x4*)(ps0 + (tid + i * 512) * 4);
            for (int cc = 1; cc < c; ++cc) {
                const float* ph = PHI + (size_t)(bh * 4 + cc) * 4096; const float* ps = PSI + (size_t)(bh * 4 + cc) * 4096;
#pragma unroll
                for (int i = 0; i < 2; ++i) *(LAS f32x4*)(Pm + (tid + i * 512) * 4) = *(const f32x4*)(ph + (tid + i * 512) * 4);
                const int v = tid >> 3, kq = (tid & 7) * 8;
                f32x4 a0 = *(const f32x4*)(ps + v * 64 + kq), a1 = *(const f32x4*)(ps + v * 64 + kq + 4);
                __syncthreads();
#pragma unroll 8
                for (int k = 0; k < 64; ++k) {
                    const float s = Sm[v * 64 + k];
                    a0 += s * *(const LAS f32x4*)(Pm + k * 64 + kq); a1 += s * *(const LAS f32x4*)(Pm + k * 64 + kq + 4);
                }
                __syncthreads();
                *(LAS f32x4*)(Sm + v * 64 + kq) = a0; *(LAS f32x4*)(Sm + v * 64 + kq + 4) = a1;
            }
            __syncthreads();
            const f32x4 i0 = *(const LAS f32x4*)(Sm + r * 64 + 8 * j), i1 = *(const LAS f32x4*)(Sm + r * 64 + 8 * j + 4);
            S0[0] = i0.lo; S0[1] = i0.hi; S0[2] = i1.lo; S0[3] = i1.hi;
        }
        __syncthreads();
        int cb = 0;
        for (int sc = 0; sc < NSUB; ++sc) {
            const int t0 = sc * 32;
            const bool more = (sc + 1 < NSUB);
            if (more) {
                const int tn = t0 + 32 + rr;
                if (tn < CL) SCAN_LOADS(tn);
                else { st0 = (f32x4){0.f, 0.f, 0.f, 0.f}; st1 = st0; st2 = st0; st4 = st0; st5 = st0; }
            }
            {
                const LAS float* bp = buf + cb * 12288;
                const int ns = (CL - t0) < 32 ? (CL - t0) : 32;
                LAS float* yt = (LAS float*)(lds + 98304) + cb * 2048 + r;
                StepOps A, B;
                ld_ops<MODE == 3>(A, bp, 0, j, r);
                for (int s = 0; s < ns; s += 2) {
                    ld_ops<MODE == 3>(B, bp, s + 1, j, r);
                    scan_update<true>(S0, A);
                    if (MODE == 1) scan_update<false>(S1, A);
                    if (MODE == 3) { const float ya = scan_y(S0, A); yt[s * 64] = ya; }
                    if (s + 2 < ns) ld_ops<MODE == 3>(A, bp, s + 2, j, r);
                    scan_update<true>(S0, B);
                    if (MODE == 1) scan_update<false>(S1, B);
                    if (MODE == 3) { const float yb = scan_y(S0, B); yt[(s + 1) * 64] = yb; }
                }
            }
            if (more) SCAN_STORES(cb ^ 1, t0 + 32 + rr);
            __syncthreads();
            if (MODE == 3 && t0 + rr < CL)
                *(f32x4*)(p.Y + (size_t)(b * L + c * CL + t0 + rr) * 1024 + h * 64 + c4) = *(const LAS f32x4*)((LAS float*)(lds + 98304) + cb * 2048 + rr * 64 + c4);
            cb ^= 1;
        }
        if (MODE == 1) {
            float* ps = PSI + ((size_t)(bh * 4 + c) * 64 + r) * 64 + 8 * j; float* ph = PHI + ((size_t)(bh * 4 + c) * 64 + r) * 64 + 8 * j;
            *(f32x4*)(ps) = (f32x4){S0[0][0], S0[0][1], S0[1][0], S0[1][1]}; *(f32x4*)(ps + 4) = (f32x4){S0[2][0], S0[2][1], S0[3][0], S0[3][1]};
            *(f32x4*)(ph) = (f32x4){S1[0][0], S1[0][1], S1[1][0], S1[1][1]}; *(f32x4*)(ph + 4) = (f32x4){S1[2][0], S1[2][1], S1[3][0], S1[3][1]};
        }
#undef SCAN_LOADS
#undef SCAN_STORES
    }
}

__device__ __forceinline__ void post_phase(const CD& p) {
    const int lane = threadIdx.x & 63;
    const int gw = blockIdx.x * 8 + (threadIdx.x >> 6), nw = gridDim.x * 8;
    for (int itb = gw; itb < M * 4; itb += nw * 4) {
        f32x4 vv[4]; u32x2 gv[4];
#pragma unroll
        for (int u = 0; u < 4; ++u) {
            const int it = itb + u * nw, ic = it < M * 4 ? it : 0;
            const size_t o = (size_t)(ic >> 2) * 1024 + (ic & 3) * 256 + lane * 4;
            vv[u] = *(const f32x4*)(p.O + o); gv[u] = *(const u32x2*)(p.GATE + o);
        }
#pragma unroll
        for (int u = 0; u < 4; ++u) {
            const int it = itb + u * nw;
            if (it >= M * 4) continue;
            const int row = it >> 2, h = it & 3;
            const f32x4 v = vv[u]; const u32x2 gt = gv[u];
            const float ss = wave_sum(v[0] * v[0] + v[1] * v[1] + v[2] * v[2] + v[3] * v[3]);
            const float rs = rsqrtf(ss * (1.0f / 256.0f) + 1e-6f);
            u32x2 w; w.x = pk2(v[0] * rs * lo_f(gt.x), v[1] * rs * hi_f(gt.x)); w.y = pk2(v[2] * rs * lo_f(gt.y), v[3] * rs * hi_f(gt.y));
            *(u32x2*)(p.CAT + (size_t)row * D + h * 256 + lane * 4) = w;
        }
    }
    for (int itb = gw; itb < M * 4; itb += nw * 4) {
        f32x4 yv[4], vrv[4], ggv[4]; float bnv[4];
#pragma unroll
        for (int u = 0; u < 4; ++u) {
            const int it = itb + u * nw, ic = it < M * 4 ? it : 0, hh = (ic & 3) * 4 + (lane >> 4);
            const size_t o = (size_t)(ic >> 2) * 1024 + hh * 64 + (lane & 15) * 4;
            yv[u] = *(const f32x4*)(p.Y + o); vrv[u] = *(const f32x4*)(p.VR + o); ggv[u] = *(const f32x4*)(p.G + o); bnv[u] = p.BONUS[(ic >> 2) * 16 + hh];
        }
#pragma unroll
        for (int u = 0; u < 4; ++u) {
        const int it = itb + u * nw;
        if (it >= M * 4) continue;
        const int row = it >> 2, h = (it & 3) * 4 + (lane >> 4), c = h * 64 + (lane & 15) * 4;
        const f32x4 y = yv[u];
        const float mu = sum16((y[0] + y[1]) + (y[2] + y[3])) * (1.0f / 64.0f);
        const f32x4 dv = y - mu;
        const float var = sum16(dv[0] * dv[0] + dv[1] * dv[1] + dv[2] * dv[2] + dv[3] * dv[3]) * (1.0f / 64.0f);
        const float rstd = rsqrtf(var + 64e-5f);
        const f32x4 yn = dv * rstd * *(const f32x4*)(p.rw_ln_g + c) + *(const f32x4*)(p.rw_ln_b + c);
        const f32x4 res = (yn + bnv[u] * vrv[u]) * ggv[u];
        u32x2 w; w.x = pk2(res[0], res[1]); w.y = pk2(res[2], res[3]);
        *(u32x2*)(p.CAT + (size_t)row * D + 1024 + c) = w;
        }
    }
}

struct Params { const float* in[31]; float* out; unsigned char* ws; };

__global__ void __launch_bounds__(NTHREADS, 2) fwd_megakernel(Params prm) {
    extern __shared__ __attribute__((aligned(16))) unsigned char lds_raw[];
    LAS unsigned char* lds = (LAS unsigned char*)lds_raw;
    cg::grid_group grid = cg::this_grid();
    size_t zoff = 0;
    unsigned char* ws = prm.ws;
    {
        unsigned* bw = (unsigned*)(ws + XO_BAR);
        if (blockIdx.x == 0) {
            for (int i = threadIdx.x; i < BAR_WORDS; i += NTHREADS) bw[i] = 0u;
            float* ss = (float*)(ws + XO_SS);
            for (int i = threadIdx.x; i < 3 * M; i += NTHREADS) ss[i] = 0.f;
        }
        if (threadIdx.x < 4) ((LAS unsigned*)(lds + LDS_ST_OFF))[threadIdx.x] = 0u;
        __syncthreads();
    }
    XcdBarrier xbar; xbar.bar = (unsigned*)(ws + XO_BAR); xbar.x = 0; xbar.st = (volatile LAS unsigned*)(lds + LDS_ST_OFF);
#ifndef PROBE_MASK
#define PROBE_MASK 0ull
#endif
#if PROBE_MASK
    unsigned long long tacc = 0ull, tprev = __builtin_amdgcn_s_memrealtime(); int tphase = 0;
#define TICK() do { const unsigned long long _n = __builtin_amdgcn_s_memrealtime(); if (((unsigned long long)(PROBE_MASK) >> tphase) & 1ull) tacc += _n - tprev; tprev = _n; ++tphase; } while (0)
#else
#define TICK() do {} while (0)
#endif
#if PROBE_MASK && defined(PROBE_SPLIT)
#define PSPLIT() do { SYNC(); TICK(); } while (0)
#else
#define PSPLIT() do {} while (0)
#endif
#define GEMM_FULL(FULLM_, A_, Bt_, N_, K_, EP_) do { pg8::StaticOrder S_; S_.init((FULLM_) ? 33 * 256 : MBIG, (N_), (int)gridDim.x, (int)blockIdx.x); const auto ep_ = EP_; \
        pg8::gemm_phase(lds, (A_), (Bt_), (K_), S_, ep_); PSPLIT(); if (!(FULLM_)) gemm_rem_phase(lds, (A_), (Bt_), (N_), (K_), ep_); PSPLIT(); } while (0)
#define SYNC() do { xcd_barrier(xbar); asm volatile("" : "+s"(zoff) :: "memory"); ws = prm.ws + zoff; } while (0)
#define SYNC0() do { grid.sync(); xbar = xcd_barrier_post((unsigned*)(ws + XO_BAR), (volatile LAS unsigned*)(lds + LDS_ST_OFF)); asm volatile("" : "+s"(zoff) :: "memory"); ws = prm.ws + zoff; } while (0)
#define WSF(off) ((float*)(ws + (off)))
#define WSB(off) ((bf16_t*)(ws + (off)))
#define CTR(j) ((unsigned*)(ws + XO_BAR) + 3456 + (j))
#define SSQ(j) (WSF(XO_SS) + (j) * M)
#define MKCD(p) CD p; \
        p.z2 = WSF(OFF_Z); p.gla_w2 = prm.in[10]; p.gla_b = prm.in[11]; p.gla_norm_g = prm.in[12]; p.rw_mu = prm.in[13]; p.rw_w0 = prm.in[14]; p.rw_a0 = prm.in[16]; \
        p.rw_kk = prm.in[19]; p.rw_ka = prm.in[20]; p.rw_rk = prm.in[21]; p.rw_ln_g = prm.in[22]; p.rw_ln_b = prm.in[23]; \
        p.R = WSF(XO_R); p.KR = WSF(XO_KR); p.VR = WSF(XO_VR); p.G = WSF(XO_G); p.Y = WSF(XO_Y); \
        p.CDEC = WSF(XO_CDEC); p.BONUS = WSF(XO_BONUS); p.DECAY = WSF(ZO_DECAY); p.A = WSF(ZO_A); p.KK = WSF(ZO_KK); p.O = WSF(ZO_O); \
        p.LW = WSB(XO_LW); p.LA = WSB(XO_LA); p.LG = WSB(XO_LG); p.GATE = WSB(XO_GATE); \
        p.QDEC = WSB(XO_QDEC); p.KDEC = WSB(XO_KDEC); p.K2T = WSB(XO_K2T); p.VT = WSB(XO_VT); \
        p.W2T = WSB(XO_W2T); p.A2T = WSB(XO_A2T); p.G2T = WSB(XO_G2T); \
        p.CST = WSB(ZO_CST); p.SPT = WSB(ZO_SPT); p.P = WSB(ZO_P); p.CAT = WSB(OFF_ACT);

    rms_phase<1>(nullptr, WSF(OFF_H), prm.in[0], prm.in[1], prm.in[25], WSB(OFF_HN), nullptr);
    convert_wt(prm.in[2], WSB(XO_WB), D, NAB, NAB, nullptr, lds);
    convert_wt(prm.in[15], WSB(XO_W2T), 64, 1024, 1024, nullptr, lds);
    convert_wt(prm.in[17], WSB(XO_A2T), 64, 1024, 1024, nullptr, lds);
    convert_wt(prm.in[18], WSB(XO_G2T), 128, 1024, 1024, nullptr, lds);
    SYNC0(); TICK();
    GEMM_FULL(1, WSB(OFF_HN), WSB(XO_WB), NAB, D, (EpStoreBf16{WSB(OFF_Z), NAB}));
    convert_steal(prm.in[8], WSB(XO_WC), D, D, D, nullptr, CTR(0), lds);
    convert_steal<true>(prm.in[27], WSB(OFF_W), D, NUP, NUP, prm.in[26], CTR(1), lds);
    SYNC(); TICK();
    mixer_ab_phase(WSB(OFF_Z), prm.in[3], prm.in[4], prm.in[5], prm.in[6], prm.in[7], WSB(OFF_ACT), lds);
    SYNC(); TICK();
    GEMM_FULL(0, WSB(OFF_ACT), WSB(XO_WC), D, D, (EpResid0{prm.in[0], prm.in[1], WSF(OFF_H), WSB(OFF_HN), SSQ(0)}));
    SYNC(); TICK();
    GEMM_FULL(1, WSB(OFF_HN), WSB(OFF_W), NUP, D, (EpGate{WSB(OFF_ACT), WSB(OFF_Z), SSQ(0), prm.in[28]}));
    convert_steal(prm.in[29], WSB(XO_WC), DFF, D, D, nullptr, CTR(2), lds);
    convert_steal(prm.in[9], WSB(XO_WB), D, NCD, NCDP, prm.in[25] + D, CTR(3), lds);
    SYNC(); TICK();
    gate_fixup_phase(WSB(OFF_Z), prm.in[28], WSB(OFF_ACT));
    SYNC(); TICK();
    GEMM_FULL(0, WSB(OFF_ACT), WSB(XO_WC), D, DFF, (EpResid{WSF(OFF_H), WSB(OFF_HN), SSQ(1)}));
    SYNC(); TICK();
    GEMM_FULL(1, WSB(OFF_HN), WSB(XO_WB), NCDP, D, (EpScaleStoreF32{WSF(OFF_Z), NCDP, SSQ(1)}));
    convert_steal(prm.in[24], WSB(XO_WC), D, D, D, nullptr, CTR(4), lds);
    convert_steal<true>(prm.in[27] + (size_t)D * NUP, WSB(OFF_W), D, NUP, NUP, prm.in[26] + D, CTR(5), lds);
    SYNC(); TICK();
    { MKCD(p) prep1_phase(p, lds); }
    SYNC(); TICK();
    { MKCD(p) small_gemm_phase(p); }
    SYNC(); TICK();
    { MKCD(p) prep2_phase(p); }
    { MKCD(p) rwkv_scan_pass<1>(p, WSF(ZO_PSI), WSF(ZO_PHI), lds); }
    SYNC(); TICK();
    { MKCD(p) gla_out_phase(p); }
    { MKCD(p) rwkv_scan_pass<3>(p, WSF(ZO_PSI), WSF(ZO_PHI), lds); }
    SYNC(); TICK();
    { MKCD(p) post_phase(p); }
    SYNC(); TICK();
    GEMM_FULL(0, WSB(OFF_ACT), WSB(XO_WC), D, D, (EpResid{WSF(OFF_H), WSB(OFF_HN), SSQ(2)}));
    SYNC(); TICK();
    GEMM_FULL(1, WSB(OFF_HN), WSB(OFF_W), NUP, D, (EpGate{WSB(OFF_ACT), WSB(OFF_Z), SSQ(2), prm.in[28] + (size_t)3 * NUP}));
    convert_steal(prm.in[29] + (size_t)DFF * D, WSB(XO_WC), DFF, D, D, nullptr, CTR(6), lds);
    SYNC(); TICK();
    gate_fixup_phase(WSB(OFF_Z), prm.in[28] + (size_t)3 * NUP, WSB(OFF_ACT));
    SYNC(); TICK();
    GEMM_FULL(0, WSB(OFF_ACT), WSB(XO_WC), D, DFF, (EpAddF32{WSF(OFF_H), D}));
    SYNC(); TICK();
    rms_phase<2>(WSF(OFF_H), nullptr, nullptr, nullptr, prm.in[30], nullptr, prm.out);
#if PROBE_MASK
    TICK();
    if (blockIdx.x == 0) { const unsigned long long t0 = __builtin_amdgcn_s_memrealtime(); while (__builtin_amdgcn_s_memrealtime() - t0 < tacc) __builtin_amdgcn_s_sleep(8); }
#endif
}

extern "C" void kernel_launch(void* const* d_in, const int* in_sizes, int n_in, void* d_out, int out_size, void* d_ws, size_t ws_size, hipStream_t stream) {
    static int grid_blocks = 0;
    if (!grid_blocks) {
        if (n_in != 31 || ws_size < WS_END) { fprintf(stderr, "kernel_launch: expected 31 inputs and >= %zu bytes of workspace (got %d, %zu)\n", (size_t)WS_END, n_in, ws_size); grid_blocks = -1; return; }
        int dev = 0, cus = 0, per_cu = 0;
        hipGetDevice(&dev);
        hipDeviceGetAttribute(&cus, hipDeviceAttributeMultiprocessorCount, dev);
        hipFuncSetAttribute((const void*)fwd_megakernel, hipFuncAttributeMaxDynamicSharedMemorySize, LDS_BYTES);
        hipOccupancyMaxActiveBlocksPerMultiprocessor(&per_cu, (const void*)fwd_megakernel, NTHREADS, LDS_BYTES);
        if (per_cu < 1) per_cu = 1;
        if (per_cu > 1) per_cu = 1;
        (void)hipGetLastError();
        grid_blocks = cus * per_cu;
    }
    if (grid_blocks < 0) return;
    Params p{};
    for (int i = 0; i < 31; ++i) p.in[i] = (const float*)d_in[i];
    p.out = (float*)d_out; p.ws = (unsigned char*)d_ws;
    void* args[] = {&p};
    hipError_t e = hipLaunchCooperativeKernel((const void*)fwd_megakernel, dim3(grid_blocks), dim3(NTHREADS), args, LDS_BYTES, stream);
    if (e != hipSuccess) fprintf(stderr, "cooperative launch failed: %s (grid %d)\n", hipGetErrorString(e), grid_blocks);
}
```

```cpp
#include <hip/hip_runtime.h>
#include <hip/hip_cooperative_groups.h>
#include <cstdio>
namespace cg = cooperative_groups;

#define LAS __attribute__((address_space(3)))
typedef unsigned short bf16_t;
typedef short bf16x8 __attribute__((ext_vector_type(8)));
typedef float f32x4 __attribute__((ext_vector_type(4)));
typedef float f32x2 __attribute__((ext_vector_type(2)));
typedef unsigned u32x4 __attribute__((ext_vector_type(4)));
typedef unsigned u32x2 __attribute__((ext_vector_type(2)));

constexpr int D = 2048, L = 2064, NBATCH = 4, SEQ = 2048, NMETA = 16, M = NBATCH * L  , MBIG = 8192;
constexpr int DFF = 5632, NUP = 2 * DFF, NAB = 5120, NCD = 6416, NCDP = 6656;
constexpr int NCH = 33;
constexpr int NGI = NBATCH * 4 * NCH;
constexpr int LDS_ST_OFF = 139264;
constexpr int LDS_BYTES = LDS_ST_OFF + 16;
constexpr int NTHREADS = 512;

constexpr size_t al256(size_t x) { return (x + 255) & ~(size_t)255; }
constexpr size_t OFF_H = 0;
constexpr size_t OFF_W = OFF_H + al256((size_t)M * D * 4);
constexpr size_t OFF_HN = OFF_W + al256((size_t)NUP * D * 2);
constexpr size_t OFF_Z = OFF_HN + al256((size_t)M * D * 2);
constexpr size_t OFF_ACT = OFF_Z + al256((size_t)M * NCDP * 4);
constexpr size_t OFF_X = OFF_ACT + al256((size_t)M * DFF * 2);
constexpr size_t SZ_M1024F = al256((size_t)M * 1024 * 4);
constexpr size_t XO_R = OFF_X;
constexpr size_t XO_KR = XO_R + SZ_M1024F;
constexpr size_t XO_VR = XO_KR + SZ_M1024F;
constexpr size_t XO_G = XO_VR + SZ_M1024F;
constexpr size_t XO_Y = OFF_HN;
constexpr size_t XO_LW = XO_G + SZ_M1024F;
constexpr size_t XO_LA = XO_LW + al256((size_t)M * 64 * 2);
constexpr size_t XO_LG = XO_LA + al256((size_t)M * 64 * 2);
constexpr size_t XO_GATE = XO_LG + al256((size_t)M * 128 * 2);
constexpr size_t XO_QDEC = XO_GATE + al256((size_t)M * 1024 * 2);
constexpr size_t XO_KDEC = XO_QDEC + al256((size_t)NGI * 64 * 128 * 2);
constexpr size_t XO_K2T = XO_KDEC + al256((size_t)NGI * 64 * 128 * 2);
constexpr size_t XO_VT = XO_K2T + al256((size_t)NGI * 64 * 128 * 2);
constexpr size_t XO_CDEC = XO_VT + al256((size_t)NGI * 256 * 64 * 2);
constexpr size_t XO_BONUS = XO_CDEC + al256((size_t)NGI * 128 * 4);
constexpr size_t XO_W2T = XO_BONUS + al256((size_t)M * 16 * 4);
constexpr size_t XO_A2T = XO_W2T + al256((size_t)1024 * 64 * 2);
constexpr size_t XO_G2T = XO_A2T + al256((size_t)1024 * 64 * 2);
constexpr size_t XO_BAR = XO_G2T + al256((size_t)1024 * 128 * 2);
constexpr int BAR_WORDS = 3456 + 64;
constexpr size_t XO_SS = XO_BAR + al256((size_t)BAR_WORDS * 4);
constexpr size_t XO_WB = XO_SS + al256((size_t)3 * M * 4);
constexpr size_t XO_WC = XO_WB + al256((size_t)NCDP * D * 2);
constexpr size_t WS_END = XO_WC + al256((size_t)D * DFF * 2);
constexpr size_t ZO_DECAY = OFF_Z;
constexpr size_t ZO_A = ZO_DECAY + SZ_M1024F;
constexpr size_t ZO_KK = ZO_A + SZ_M1024F;
constexpr size_t ZO_O = ZO_KK + SZ_M1024F;
constexpr size_t ZO_CST = ZO_O + SZ_M1024F;
constexpr size_t ZO_SPT = ZO_CST + al256((size_t)NGI * 256 * 128 * 2);
constexpr size_t ZO_P = ZO_SPT + al256((size_t)NGI * 256 * 128 * 2);
constexpr size_t ZO_END = ZO_P + al256((size_t)NGI * 64 * 64 * 2);
constexpr size_t ZO_PSI = ZO_END;
constexpr size_t ZO_PHI = ZO_PSI + al256((size_t)256 * 4096 * 4);
static_assert(ZO_PHI + al256((size_t)256 * 4096 * 4) <= OFF_ACT, "Z sub-regions overflow");
static_assert(SZ_M1024F <= (size_t)M * D * 2 + 256, "Y must fit in HN");

__device__ __forceinline__ float bf2f(unsigned b) { return __uint_as_float(b << 16); }
__device__ __forceinline__ unsigned f2bf(float f) { unsigned u = __float_as_uint(f); u += 0x7FFFu + ((u >> 16) & 1u); return u >> 16; }
typedef __bf16 bf16x2_t __attribute__((ext_vector_type(2)));
__device__ __forceinline__ unsigned pk2(float lo, float hi) { const f32x2 v = (f32x2){lo, hi}; const bf16x2_t b = __builtin_convertvector(v, bf16x2_t); return __builtin_bit_cast(unsigned, b); }
__device__ __forceinline__ float lo_f(unsigned w) { return __uint_as_float(w << 16); }
__device__ __forceinline__ float hi_f(unsigned w) { return __uint_as_float(w & 0xffff0000u); }
__device__ __forceinline__ float sigm(float x) { return 1.0f / (1.0f + expf(-x)); }
__device__ __forceinline__ float silu(float x) { return x * sigm(x); }
__device__ __forceinline__ float fsigm(float x) { return __builtin_amdgcn_rcpf(1.0f + __builtin_amdgcn_exp2f(x * -1.4426950408889634f)); }
__device__ __forceinline__ float fsilu(float x) { return x * fsigm(x); }
__device__ __forceinline__ float logsig(float x) { return fminf(x, 0.f) - log1pf(expf(-fabsf(x))); }
__device__ __forceinline__ float wave_sum(float v) {
#pragma unroll
    for (int o = 32; o >= 1; o >>= 1) v += __shfl_xor(v, o);
    return v;
}
__device__ __forceinline__ float sum16(float v) {
#pragma unroll
    for (int o = 8; o >= 1; o >>= 1) v += __shfl_xor(v, o);
    return v;
}
__device__ __forceinline__ float quad_sum(float x) {
    x += __int_as_float(__builtin_amdgcn_update_dpp(0, __float_as_int(x), 0xB1, 0xF, 0xF, false));
    x += __int_as_float(__builtin_amdgcn_update_dpp(0, __float_as_int(x), 0x4E, 0xF, 0xF, false));
    return x;
}


#define XB_TMO      128
#define XB_XCNT(j)  (256  + 64 * (j))
#define XB_XSUB(j)  (1280 + 64 * (j))
#define XB_XGEN(j)  (2304 + 64 * (j))
#define XB_TOP      3328
#define XB_TOPGEN   3392
#define XCD_BAR_WORDS 3456
#define XB_SPIN_CAP (1u << 20)
__device__ __forceinline__ unsigned xb_ld(unsigned* p)              { return __hip_atomic_load(p, __ATOMIC_RELAXED, __HIP_MEMORY_SCOPE_AGENT); }
__device__ __forceinline__ unsigned xb_add(unsigned* p, unsigned v) { return __hip_atomic_fetch_add(p, v, __ATOMIC_RELAXED, __HIP_MEMORY_SCOPE_AGENT); }
__device__ __forceinline__ unsigned xb_xcc_id() { return (unsigned)__builtin_amdgcn_s_getreg((3 << 11) | 20) & 0xFu; }
#define XB_SPIN(cond, bar) do { unsigned _sp = 0; while (cond) { __builtin_amdgcn_s_sleep(1); \
    if ((++_sp & 255u) == 0u) { if (xb_ld(&(bar)[XB_TMO])) break; if (_sp > XB_SPIN_CAP) { atomicAdd(&(bar)[XB_TMO], 1u); break; } } } } while (0)
struct XcdBarrier { unsigned* bar; unsigned x; volatile LAS unsigned* st; };
__device__ __forceinline__ XcdBarrier xcd_barrier_post(unsigned* bar, volatile LAS unsigned* st) {
    XcdBarrier b; b.bar = bar; b.x = xb_xcc_id(); b.st = st;
    if (threadIdx.x == 0) (void)xb_add(&bar[XB_XCNT(b.x)], 1u);
    return b;
}
__device__ __forceinline__ void xcd_barrier_complete(unsigned* bar, unsigned x, unsigned& nloc, unsigned& nx) {
    const unsigned G = gridDim.x * gridDim.y * gridDim.z;
    unsigned sum, cnt, mine, sp = 0u;
    for (;;) {
        sum = 0u; cnt = 0u; mine = 0u;
#pragma unroll
        for (unsigned j = 0; j < 16; ++j) { const unsigned c = xb_ld(&bar[XB_XCNT(j)]); sum += c; cnt += (c > 0u) ? 1u : 0u; mine = (j == x) ? c : mine; }
        if (sum == G) break;
        __builtin_amdgcn_s_sleep(1);
        if ((++sp & 255u) == 0u) { if (xb_ld(&bar[XB_TMO])) break; if (sp > XB_SPIN_CAP) { atomicAdd(&bar[XB_TMO], 1u); break; } }
    }
    nloc = mine > 0u ? mine : 1u; nx = cnt > 0u ? cnt : 1u;
}
__device__ __forceinline__ void xcd_barrier(const XcdBarrier& b) {
    asm volatile("s_waitcnt vmcnt(0)" ::: "memory");
    __syncthreads();
    if (threadIdx.x == 0) {
        unsigned* bar = b.bar;
        __builtin_amdgcn_s_waitcnt(0);
        unsigned nloc = b.st[0], nx = b.st[1];
        if (nloc == 0u) { xcd_barrier_complete(bar, b.x, nloc, nx); b.st[0] = nloc; b.st[1] = nx; }
        const unsigned old = xb_add(&bar[XB_XSUB(b.x)], 1u);
        const unsigned gen = old / nloc;
        if (old + 1u == (gen + 1u) * nloc) {
            __builtin_amdgcn_fence(__ATOMIC_RELEASE, "agent");
            asm volatile("s_waitcnt vmcnt(0)" ::: "memory");
            const unsigned og = xb_add(&bar[XB_TOP], 1u);
            const unsigned tg = og / nx;
            if (og + 1u == (tg + 1u) * nx) xb_add(&bar[XB_TOPGEN], 1u);
            else XB_SPIN(xb_ld(&bar[XB_TOPGEN]) == tg, bar);
            __builtin_amdgcn_fence(__ATOMIC_ACQUIRE, "agent");
            xb_add(&bar[XB_XGEN(b.x)], 1u);
            asm volatile("s_waitcnt vmcnt(0)" ::: "memory");
        } else {
            XB_SPIN(xb_ld(&bar[XB_XGEN(b.x)]) == gen, bar);
            __builtin_amdgcn_fence(__ATOMIC_ACQUIRE, "agent");
            asm volatile("s_waitcnt vmcnt(0)" ::: "memory");
        }
    }
    __syncthreads();
}

namespace pg8 {
constexpr int BM = 256, BK = 64, HALF = 128, HTB = HALF * BK * 2, NXCD = 8, WGM = 4;
__device__ __forceinline__ int lds_byte(int r, int c) { const int st = (r >> 4) * 2 + (c >> 5), rr = r & 15, cc = c & 31, ob = rr * 64 + cc * 2; return st * 1024 + (ob ^ (((ob >> 9) & 1) << 5)); }
__device__ __forceinline__ void stage_rc(int b, int& R, int& C) { const int st = b / 1024, sb = b % 1024, swz = sb ^ (((sb >> 9) & 1) << 5); R = (st >> 1) * 16 + swz / 64; C = (st & 1) * 32 + (swz % 64) / 2; }
struct Unit { int pm, pn; };
struct StaticOrder {
    int nM, nN, nwg, G, c;
    __device__ void init(int Mr, int N, int G_, int c_) { nM = Mr / BM; nN = N / BM; nwg = nM * nN; G = G_; c = c_; }
    __device__ bool next(int i, Unit& u) const {
        const long Lx = (long)i * G + c; if (Lx >= nwg) return false;
        int wgid = (int)Lx; { const int q = nwg / NXCD, r = nwg % NXCD, xcd = wgid % NXCD, off = wgid / NXCD; wgid = (xcd < r ? xcd * (q + 1) : r * (q + 1) + (xcd - r) * q) + off; }
        const int nig = WGM * nN, gid = wgid / nig, fm = gid * WGM, gsz = (nM - fm) < WGM ? (nM - fm) : WGM;
        u.pm = fm + ((wgid % nig) % gsz); u.pn = (wgid % nig) / gsz; return true;
    }
};
template <class F>
__device__ __forceinline__ void gemm_phase(LAS unsigned char* lds, const bf16_t* gA, const bf16_t* gBt, const int K, const StaticOrder& S, const F& f) {
    int tid = threadIdx.x; asm volatile("" : "+v"(tid));
    const int wid = __builtin_amdgcn_readfirstlane(tid >> 6), lane = tid & 63, wr = wid >> 2, wc = wid & 3, fr = lane & 15, fq = lane >> 4;
    const int nt = K / BK;
    unsigned voffA[2];
#pragma unroll
    for (int i = 0; i < 2; ++i) { int R, C; stage_rc(tid * 16 + i * 8192, R, C); voffA[i] = (unsigned)(R * K + C) * 2u; }
    const size_t kstep = (size_t)(BK * 2);
    const size_t hstep = (size_t)HALF * K * 2;
    const size_t tstep = 2 * hstep;
    const unsigned ldsw = (unsigned)wid * 1024u;
    const int aoff = lds_byte(wr * 64 + fr, fq * 8), boff = lds_byte(wc * 32 + fr, fq * 8);
#define PG8_SA(b, h) (((b) * 2 + (h)) * HTB)
#define PG8_SB(b, h) ((4 + (b) * 2 + (h)) * HTB)
#define PG8_STAGE(bufoff, gbase, voff) do { _Pragma("unroll") for (int _i = 0; _i < 2; ++_i) \
        __builtin_amdgcn_global_load_lds((const unsigned*)((const char*)(gbase) + (voff)[_i]), (LAS unsigned*)(lds + (bufoff) + ldsw + _i * 8192), 16, 0, 0); } while (0)
#define PG8_LDA(dst, b, h) do { _Pragma("unroll") for (int m = 0; m < 4; ++m) _Pragma("unroll") for (int k = 0; k < 2; ++k) dst[m][k] = *(const LAS bf16x8*)(lds + PG8_SA(b, h) + aoff + m * 2048 + k * 1024); } while (0)
#define PG8_LDB(dst, b, h) do { _Pragma("unroll") for (int n = 0; n < 2; ++n) _Pragma("unroll") for (int k = 0; k < 2; ++k) dst[n][k] = *(const LAS bf16x8*)(lds + PG8_SB(b, h) + boff + n * 2048 + k * 1024); } while (0)
#define PG8_MMA(ai, bj, At, Bt) do { __builtin_amdgcn_s_setprio(1); _Pragma("unroll") for (int m = 0; m < 4; ++m) _Pragma("unroll") for (int n = 0; n < 2; ++n) _Pragma("unroll") for (int k = 0; k < 2; ++k) \
        acc[ai][bj][m][n] = __builtin_amdgcn_mfma_f32_16x16x32_bf16(Bt[n][k], At[m][k], acc[ai][bj][m][n], 0, 0, 0); __builtin_amdgcn_s_setprio(0); } while (0)
#define PG8_WAIT_V(n) asm volatile("s_waitcnt vmcnt(" #n ")" ::: "memory")
#define PG8_WAIT_L(n) asm volatile("s_waitcnt lgkmcnt(" #n ")" ::: "memory")
#define PG8_BAR __builtin_amdgcn_s_barrier()
#define PG8_SCHED __builtin_amdgcn_sched_barrier(0)
    Unit cur, nxt; int ui = 0;
    if (!S.next(0, cur)) return;
    f32x4 acc[2][2][4][2];
#pragma unroll
    for (int a = 0; a < 2; ++a)
#pragma unroll
        for (int b = 0; b < 2; ++b)
#pragma unroll
            for (int m = 0; m < 4; ++m)
#pragma unroll
                for (int n = 0; n < 2; ++n) acc[a][b][m][n] = (f32x4){0.f, 0.f, 0.f, 0.f};
    bf16x8 At[4][2], B0[2][2], B1[2][2];
    const char* cA = (const char*)gA + (size_t)cur.pm * tstep; const char* cB = (const char*)gBt + (size_t)cur.pn * tstep;
    PG8_STAGE(PG8_SB(0, 0), cB, voffA); PG8_STAGE(PG8_SA(0, 0), cA, voffA); PG8_STAGE(PG8_SB(0, 1), cB + hstep, voffA); PG8_STAGE(PG8_SA(0, 1), cA + hstep, voffA);
    if (wr == 1) PG8_BAR;
    PG8_WAIT_V(4); PG8_BAR;
    PG8_STAGE(PG8_SB(1, 0), cB + kstep, voffA); PG8_STAGE(PG8_SA(1, 0), cA + kstep, voffA); PG8_STAGE(PG8_SB(1, 1), cB + hstep + kstep, voffA);
    PG8_WAIT_V(6); PG8_BAR;
    for (;;) {
        const bool has_next = S.next(ui + 1, nxt);
        const char* nA = has_next ? (const char*)gA + (size_t)nxt.pm * tstep : cA; const char* nB = has_next ? (const char*)gBt + (size_t)nxt.pn * tstep : cB;
        for (int t = 0; t < nt; t += 2) {
            const bool last = (t == nt - 2);
            const char* a1 = cA + (size_t)(t + 1) * kstep;
            const char* a2 = last ? nA : cA + (size_t)(t + 2) * kstep; const char* b2 = last ? nB : cB + (size_t)(t + 2) * kstep;
            const char* a3 = a2 + kstep; const char* b3 = b2 + kstep;
            PG8_LDB(B0, 0, 0); PG8_SCHED; PG8_LDA(At, 0, 0); PG8_STAGE(PG8_SA(1, 1), a1 + hstep, voffA);
            PG8_WAIT_L(8); PG8_BAR; PG8_WAIT_L(0); PG8_MMA(0, 0, At, B0); PG8_BAR; PG8_SCHED;
            PG8_LDB(B1, 0, 1); PG8_STAGE(PG8_SB(0, 0), b2, voffA);
            PG8_BAR; PG8_WAIT_L(0); PG8_MMA(0, 1, At, B1); PG8_BAR;
            PG8_LDA(At, 0, 1); PG8_STAGE(PG8_SA(0, 0), a2, voffA);
            PG8_BAR; PG8_WAIT_L(0); PG8_MMA(1, 0, At, B0); PG8_BAR; PG8_SCHED;
            PG8_STAGE(PG8_SB(0, 1), b2 + hstep, voffA);
            PG8_WAIT_V(6); PG8_BAR; PG8_MMA(1, 1, At, B1); PG8_BAR;
            PG8_LDB(B0, 1, 0); PG8_SCHED; PG8_LDA(At, 1, 0); PG8_STAGE(PG8_SA(0, 1), a2 + hstep, voffA);
            PG8_WAIT_L(8); PG8_BAR; PG8_WAIT_L(0); PG8_MMA(0, 0, At, B0); PG8_BAR; PG8_SCHED;
            PG8_LDB(B1, 1, 1); PG8_STAGE(PG8_SB(1, 0), b3, voffA);
            PG8_BAR; PG8_WAIT_L(0); PG8_MMA(0, 1, At, B1); PG8_BAR;
            PG8_LDA(At, 1, 1); PG8_STAGE(PG8_SA(1, 0), a3, voffA);
            PG8_BAR; PG8_WAIT_L(0); PG8_MMA(1, 0, At, B0); PG8_BAR; PG8_SCHED;
            PG8_STAGE(PG8_SB(1, 1), b3 + hstep, voffA);
            PG8_WAIT_V(6); PG8_BAR; PG8_MMA(1, 1, At, B1); PG8_BAR;
        }
        if constexpr (F::GATE) { f.tile(acc, cur.pm, cur.pn, wr, wc, fr, fq); }
        else {
            const int row0 = cur.pm * BM + wr * 64 + fr, col0 = cur.pn * BM + wc * 32 + 4 * fq;
            float sc[2][4];
#pragma unroll
            for (int ai = 0; ai < 2; ++ai)
#pragma unroll
                for (int m = 0; m < 4; ++m) sc[ai][m] = f.begin(row0 + ai * HALF + m * 16);
#pragma unroll
            for (int ai = 0; ai < 2; ++ai) {
                f32x4 hv[4][2][2];
#pragma unroll
                for (int m = 0; m < 4; ++m)
#pragma unroll
                    for (int bj = 0; bj < 2; ++bj)
#pragma unroll
                        for (int n = 0; n < 2; ++n) hv[m][bj][n] = f.pre(row0 + ai * HALF + m * 16, col0 + bj * HALF + n * 16);
#pragma unroll
                for (int m = 0; m < 4; ++m) {
                    const int row = row0 + ai * HALF + m * 16;
                    float ssq = 0.f;
#pragma unroll
                    for (int bj = 0; bj < 2; ++bj)
#pragma unroll
                        for (int n = 0; n < 2; ++n) ssq += f(row, col0 + bj * HALF + n * 16, acc[ai][bj][m][n], hv[m][bj][n], sc[ai][m]);
                    f.end(row, ssq, 0);
                }
            }
        }
        if (!has_next) break;
#pragma unroll
        for (int a = 0; a < 2; ++a)
#pragma unroll
            for (int b = 0; b < 2; ++b)
#pragma unroll
                for (int m = 0; m < 4; ++m)
#pragma unroll
                    for (int n = 0; n < 2; ++n) acc[a][b][m][n] = (f32x4){0.f, 0.f, 0.f, 0.f};
        cur = nxt; cA = nA; cB = nB; ++ui;
    }
    PG8_WAIT_V(0);
    if (wr == 0) PG8_BAR;
    PG8_BAR;
#undef PG8_SA
#undef PG8_SB
#undef PG8_STAGE
#undef PG8_LDA
#undef PG8_LDB
#undef PG8_MMA
#undef PG8_WAIT_V
#undef PG8_WAIT_L
#undef PG8_BAR
#undef PG8_SCHED
}
}

template <int UNR>
__device__ __forceinline__ void wave_tile_mma(const bf16_t* __restrict__ A, int lda, const bf16_t* __restrict__ Bt, int ldb, int k0, int k1, f32x4 (&acc)[4][4], int fr, int fq) {
    const bf16_t* ap = A + (size_t)fr * lda + fq * 8;
    const bf16_t* bp = Bt + (size_t)fr * ldb + fq * 8;
    int k = k0;
#pragma unroll 1
    for (; k + 32 * UNR <= k1; k += 32 * UNR) {
        bf16x8 a[UNR][4], b[UNR][4];
#pragma unroll
        for (int u = 0; u < UNR; ++u)
#pragma unroll
            for (int i = 0; i < 4; ++i) { a[u][i] = *(const bf16x8*)(ap + (size_t)i * 16 * lda + k + 32 * u); b[u][i] = *(const bf16x8*)(bp + (size_t)i * 16 * ldb + k + 32 * u); }
#pragma unroll
        for (int u = 0; u < UNR; ++u)
#pragma unroll
            for (int mi = 0; mi < 4; ++mi)
#pragma unroll
                for (int ni = 0; ni < 4; ++ni) acc[mi][ni] = __builtin_amdgcn_mfma_f32_16x16x32_bf16(b[u][ni], a[u][mi], acc[mi][ni], 0, 0, 0);
    }
#pragma unroll 1
    for (; k < k1; k += 32) {
        bf16x8 a[4], b[4];
#pragma unroll
        for (int i = 0; i < 4; ++i) { a[i] = *(const bf16x8*)(ap + (size_t)i * 16 * lda + k); b[i] = *(const bf16x8*)(bp + (size_t)i * 16 * ldb + k); }
#pragma unroll
        for (int mi = 0; mi < 4; ++mi)
#pragma unroll
            for (int ni = 0; ni < 4; ++ni) acc[mi][ni] = __builtin_amdgcn_mfma_f32_16x16x32_bf16(b[ni], a[mi], acc[mi][ni], 0, 0, 0);
    }
}
__device__ __forceinline__ void zero_acc(f32x4 (&acc)[4][4]) {
#pragma unroll
    for (int i = 0; i < 4; ++i)
#pragma unroll
        for (int j = 0; j < 4; ++j) acc[i][j] = (f32x4){0.f, 0.f, 0.f, 0.f};
}

template <class F>
__device__ __forceinline__ void gemm_rem_phase(LAS unsigned char* lds, const bf16_t* A, const bf16_t* Bt, int N, int K, const F& f) {
    const int tid = threadIdx.x, wid = __builtin_amdgcn_readfirstlane(tid >> 6), lane = tid & 63, fr = lane & 15, fq = lane >> 4;
    const int ntiles = N / 64, kw = K / 8;
    for (int tile = (int)gridDim.x - 1 - (int)blockIdx.x; tile < ntiles; tile += gridDim.x) {
        const int n0 = tile * 64;
        f32x4 acc[4][4]; zero_acc(acc);
        wave_tile_mma<4>(A + (size_t)MBIG * K, K, Bt + (size_t)n0 * K, K, wid * kw, (wid + 1) * kw, acc, fr, fq);
        LAS float* P = (LAS float*)lds + wid * 4096;
#pragma unroll
        for (int mi = 0; mi < 4; ++mi)
#pragma unroll
            for (int ni = 0; ni < 4; ++ni) *(LAS f32x4*)(P + ((mi * 4 + ni) * 64 + lane) * 4) = acc[mi][ni];
        __syncthreads();
#pragma unroll
        for (int i = 0; i < 2; ++i) {
            const int fg = wid + 8 * i, r = (fg >> 2) * 16 + fr, c4 = (fg & 3) * 16 + fq * 4;
            f32x4 s = (f32x4){0.f, 0.f, 0.f, 0.f};
#pragma unroll
            for (int w = 0; w < 8; ++w) s += *(const LAS f32x4*)((LAS float*)lds + w * 4096 + (fg * 64 + lane) * 4);
            const float sc = f.begin(MBIG + r);
            const f32x4 hv = f.pre(MBIG + r, n0 + c4);
            const float ssq = f(MBIG + r, n0 + c4, s, hv, sc);
            f.end(MBIG + r, ssq, 0);
        }
        __syncthreads();
    }
}

__device__ __forceinline__ float rstd_of(const float* SS, int row) { return rsqrtf(SS[row] * (1.0f / D) + 1e-6f); }
struct EpStoreBf16 { static constexpr bool GATE = false; bf16_t* O; int ld;
    __device__ __forceinline__ float begin(int) const { return 1.f; }
    __device__ __forceinline__ f32x4 pre(int, int) const { return (f32x4){0.f, 0.f, 0.f, 0.f}; }
    __device__ __forceinline__ float operator()(int row, int col, f32x4 v, f32x4, float) const { if (row < M) { u32x2 w; w.x = pk2(v[0], v[1]); w.y = pk2(v[2], v[3]); *(u32x2*)(O + (size_t)row * ld + col) = w; } return 0.f; }
    __device__ __forceinline__ void end(int, float, int) const {} };
struct EpScaleStoreBf16 { static constexpr bool GATE = false; bf16_t* O; int ld; const float* SS;
    __device__ __forceinline__ float begin(int row) const { return rstd_of(SS, row < M ? row : M - 1); }
    __device__ __forceinline__ f32x4 pre(int, int) const { return (f32x4){0.f, 0.f, 0.f, 0.f}; }
    __device__ __forceinline__ float operator()(int row, int col, f32x4 v, f32x4, float s) const { if (row < M) { v = v * s; u32x2 w; w.x = pk2(v[0], v[1]); w.y = pk2(v[2], v[3]); *(u32x2*)(O + (size_t)row * ld + col) = w; } return 0.f; }
    __device__ __forceinline__ void end(int, float, int) const {} };
struct EpScaleStoreF32 { static constexpr bool GATE = false; float* O; int ld; const float* SS;
    __device__ __forceinline__ float begin(int row) const { return rstd_of(SS, row < M ? row : M - 1); }
    __device__ __forceinline__ f32x4 pre(int, int) const { return (f32x4){0.f, 0.f, 0.f, 0.f}; }
    __device__ __forceinline__ float operator()(int row, int col, f32x4 v, f32x4, float s) const { if (row < M) *(f32x4*)(O + (size_t)row * ld + col) = v * s; return 0.f; }
    __device__ __forceinline__ void end(int, float, int) const {} };
struct EpAddF32 { static constexpr bool GATE = false; float* H; int ld;
    __device__ __forceinline__ float begin(int) const { return 1.f; }
    __device__ __forceinline__ f32x4 pre(int row, int col) const { return *(const f32x4*)(H + (size_t)row * ld + col); }
    __device__ __forceinline__ float operator()(int row, int col, f32x4 v, f32x4 h, float) const { *(f32x4*)(H + (size_t)row * ld + col) = h + v; return 0.f; }
    __device__ __forceinline__ void end(int, float, int) const {} };
struct EpResid { static constexpr bool GATE = false; float* H; bf16_t* HB; float* SS;
    __device__ __forceinline__ float begin(int) const { return 1.f; }
    __device__ __forceinline__ f32x4 pre(int row, int col) const { return *(const f32x4*)(H + (size_t)row * D + col); }
    __device__ __forceinline__ float operator()(int row, int col, f32x4 v, f32x4 h0, float) const {
        const f32x4 h = h0 + v; *(f32x4*)(H + (size_t)row * D + col) = h;
        u32x2 w; w.x = pk2(h[0], h[1]); w.y = pk2(h[2], h[3]); *(u32x2*)(HB + (size_t)row * D + col) = w;
        return (h[0] * h[0] + h[1] * h[1]) + (h[2] * h[2] + h[3] * h[3]); }
    __device__ __forceinline__ void end(int row, float ssq, int kind) const {
        const int lane = threadIdx.x & 63;
        if (kind == 0) { ssq += __shfl_xor(ssq, 16); ssq += __shfl_xor(ssq, 32); if (lane < 16) atomicAdd(SS + row, ssq); }
        else { ssq = sum16(ssq); if ((lane & 15) == 0) atomicAdd(SS + row, ssq); } } };

__device__ __forceinline__ f32x4 dpp_ror(f32x4 v, const int which) {
    f32x4 o;
#pragma unroll
    for (int e = 0; e < 4; ++e) o[e] = which == 1 ? __int_as_float(__builtin_amdgcn_update_dpp(0, __float_as_int(v[e]), 0x121, 0xF, 0xF, false))
                                                  : __int_as_float(__builtin_amdgcn_update_dpp(0, __float_as_int(v[e]), 0x122, 0xF, 0xF, false));
    return o;
}
struct EpGate { static constexpr bool GATE = true; bf16_t* G; bf16_t* U; const float* SS; const float* dw;
    __device__ __forceinline__ float begin(int) const { return 1.f; }
    __device__ __forceinline__ f32x4 pre(int, int) const { return (f32x4){0.f, 0.f, 0.f, 0.f}; }
    __device__ __forceinline__ float operator()(int, int, f32x4, f32x4, float) const { return 0.f; }
    __device__ __forceinline__ void end(int, float, int) const {}
    __device__ __forceinline__ void tile(f32x4 (&acc)[2][2][4][2], int pm, int pn, int wr, int wc, int fr, int fq) const {
        const int rowb = pm * 256 + wr * 64 + fr;
        f32x4 wva[2][3], wga[2][3];
#pragma unroll
        for (int n = 0; n < 2; ++n)
#pragma unroll
            for (int j = 0; j < 3; ++j) { const int chh = pn * 128 + wc * 32 + n * 16 + 4 * fq; wva[n][j] = *(const f32x4*)(dw + j * NUP + chh); wga[n][j] = *(const f32x4*)(dw + j * NUP + DFF + chh); }
#pragma unroll
        for (int ai = 0; ai < 2; ++ai)
#pragma unroll
            for (int m = 0; m < 4; ++m) {
                const int row = rowb + ai * 128 + m * 16;
                const float s = rstd_of(SS, row < M ? row : M - 1);
#pragma unroll
                for (int bj = 0; bj < 2; ++bj)
#pragma unroll
                    for (int n = 0; n < 2; ++n) acc[ai][bj][m][n] = acc[ai][bj][m][n] * s;
            }
#pragma unroll
        for (int n = 0; n < 2; ++n) {
            const int ch = pn * 128 + wc * 32 + n * 16 + 4 * fq;
            const int ucol = pn * 256 + wc * 32 + n * 16 + 4 * fq;
            f32x4 wv[3], wg[3];
#pragma unroll
            for (int j = 0; j < 3; ++j) { wv[j] = wva[n][j]; wg[j] = wga[n][j]; }
#pragma unroll
            for (int ai = 0; ai < 2; ++ai)
#pragma unroll
                for (int m = 0; m < 4; ++m) {
                    const int row = rowb + ai * 128 + m * 16;
                    const f32x4 cv = acc[ai][0][m][n], cg = acc[ai][1][m][n];
                    const f32x4 zv = (f32x4){0.f, 0.f, 0.f, 0.f};
                    const f32x4 pv = m > 0 ? acc[ai][0][m > 0 ? m - 1 : 0][n] : zv, pg = m > 0 ? acc[ai][1][m > 0 ? m - 1 : 0][n] : zv;
                    f32x4 v1 = dpp_ror(fr == 15 ? pv : cv, 1), v2 = dpp_ror(fr >= 14 ? pv : cv, 2);
                    f32x4 g1 = dpp_ror(fr == 15 ? pg : cg, 1), g2 = dpp_ror(fr >= 14 ? pg : cg, 2);
                    const int t = row % L;
                    if (t == 0) { v1 = zv; g1 = zv; }
                    if (t <= 1) { v2 = zv; g2 = zv; }
                    const f32x4 val = v2 * wv[0] + v1 * wv[1] + cv * wv[2], gat = g2 * wg[0] + g1 * wg[1] + cg * wg[2];
                    const bool edge_lo = (m == 0 && fr < 2), edge_hi = (m == 3 && fr >= 14);
                    if (row < M) {
                        if (!edge_lo) {
                            u32x2 w; w.x = pk2(fsilu(gat[0]) * val[0], fsilu(gat[1]) * val[1]); w.y = pk2(fsilu(gat[2]) * val[2], fsilu(gat[3]) * val[3]);
                            *(u32x2*)(G + (size_t)row * DFF + ch) = w;
                        }
                        if (edge_lo || edge_hi) {
                            u32x2 a, b; a.x = pk2(cv[0], cv[1]); a.y = pk2(cv[2], cv[3]); b.x = pk2(cg[0], cg[1]); b.y = pk2(cg[2], cg[3]);
                            *(u32x2*)(U + (size_t)row * NUP + ucol) = a; *(u32x2*)(U + (size_t)row * NUP + ucol + 128) = b;
                        }
                    }
                }
        }
    }
};
__device__ __forceinline__ void gate_fixup_phase(const bf16_t* __restrict__ U, const float* __restrict__ dw, bf16_t* __restrict__ G) {
    const int gtid = blockIdx.x * NTHREADS + threadIdx.x, nth = gridDim.x * NTHREADS;
    constexpr int NC4 = DFF / 4, NBLK = M / 64;
    for (int idx = gtid; idx < NBLK * 2 * NC4; idx += nth) {
        const int c4 = idx % NC4, rr = (idx / NC4) & 1, blk = idx / (2 * NC4);
        const int row = blk * 64 + rr, t = row % L, ch = c4 * 4;
        const int ucol = (ch >> 7) * 256 + (ch & 127);
        f32x4 val = (f32x4){0.f, 0.f, 0.f, 0.f}, gat = val;
#pragma unroll
        for (int j = 0; j < 3; ++j) {
            if (t - 2 + j >= 0) {
                const bf16_t* ur = U + (size_t)(row - 2 + j) * NUP + ucol;
                const u32x2 a = *(const u32x2*)(ur), b = *(const u32x2*)(ur + 128);
                const f32x4 wv = *(const f32x4*)(dw + j * NUP + ch), wg = *(const f32x4*)(dw + j * NUP + DFF + ch);
                val += (f32x4){lo_f(a.x), hi_f(a.x), lo_f(a.y), hi_f(a.y)} * wv; gat += (f32x4){lo_f(b.x), hi_f(b.x), lo_f(b.y), hi_f(b.y)} * wg;
            }
        }
        u32x2 w; w.x = pk2(fsilu(gat[0]) * val[0], fsilu(gat[1]) * val[1]); w.y = pk2(fsilu(gat[2]) * val[2], fsilu(gat[3]) * val[3]);
        *(u32x2*)(G + (size_t)row * DFF + ch) = w;
    }
}

struct EpResid0 { static constexpr bool GATE = false; const float* x; const float* meta; float* H; bf16_t* HB; float* SS;
    __device__ __forceinline__ float begin(int) const { return 1.f; }
    __device__ __forceinline__ f32x4 pre(int row, int col) const { const int b = row / L, t = row - b * L;
        return *(const f32x4*)((t < NMETA ? meta + (size_t)t * D : x + ((size_t)b * SEQ + (t - NMETA)) * D) + col); }
    __device__ __forceinline__ float operator()(int row, int col, f32x4 v, f32x4 h0, float) const {
        const f32x4 h = h0 + v; *(f32x4*)(H + (size_t)row * D + col) = h;
        u32x2 w; w.x = pk2(h[0], h[1]); w.y = pk2(h[2], h[3]); *(u32x2*)(HB + (size_t)row * D + col) = w;
        return (h[0] * h[0] + h[1] * h[1]) + (h[2] * h[2] + h[3] * h[3]); }
    __device__ __forceinline__ void end(int row, float ssq, int kind) const {
        const int lane = threadIdx.x & 63;
        if (kind == 0) { ssq += __shfl_xor(ssq, 16); ssq += __shfl_xor(ssq, 32); if (lane < 16) atomicAdd(SS + row, ssq); }
        else { ssq = sum16(ssq); if ((lane & 15) == 0) atomicAdd(SS + row, ssq); } } };

template <class F>
__device__ __forceinline__ void gemm_full(LAS unsigned char* lds, const bf16_t* A, const bf16_t* Bt, int N, int K, const F& f) {
    pg8::StaticOrder S; S.init(MBIG, N, (int)gridDim.x, (int)blockIdx.x);
    pg8::gemm_phase(lds, A, Bt, K, S, f);
    gemm_rem_phase(lds, A, Bt, N, K, f);
}

__device__ __forceinline__ void convert_item(const float* __restrict__ src, bf16_t* __restrict__ dst, int K, int N, const float* __restrict__ gain, int item, int lane) {
    const int tk = K / 64;
    const int kk0 = (item % tk) * 64 + (lane & 7) * 8, n4 = (item / tk) * 32 + (lane >> 3) * 4;
    f32x4 v[8];
#pragma unroll
    for (int i = 0; i < 8; ++i) v[i] = (n4 < N) ? *(const f32x4*)(src + (size_t)(kk0 + i) * N + n4) : (f32x4){0.f, 0.f, 0.f, 0.f};
    if (gain) {
        const f32x4 g0 = *(const f32x4*)(gain + kk0), g1 = *(const f32x4*)(gain + kk0 + 4);
#pragma unroll
        for (int i = 0; i < 4; ++i) { v[i] = v[i] * g0[i]; v[4 + i] = v[4 + i] * g1[i]; }
    }
#pragma unroll
    for (int e = 0; e < 4; ++e) {
        u32x4 w; w.x = pk2(v[0][e], v[1][e]); w.y = pk2(v[2][e], v[3][e]); w.z = pk2(v[4][e], v[5][e]); w.w = pk2(v[6][e], v[7][e]);
        *(u32x4*)(dst + (size_t)(n4 + e) * K + kk0) = w;
    }
}
__device__ __forceinline__ void convert_wt(const float* __restrict__ src, bf16_t* __restrict__ dst, int K, int N, int Npad, const float* __restrict__ gain, LAS unsigned char* lds) {
    const int nitems = (K / 64) * (Npad / 32), lane = threadIdx.x & 63;
    for (int it = blockIdx.x * 8 + (threadIdx.x >> 6); it < nitems; it += gridDim.x * 8) convert_item(src, dst, K, N, gain, it, lane);
}
__device__ __forceinline__ int up_src_col(int n) { return ((n & 128) ? DFF : 0) + ((n >> 8) << 7) + (n & 127); }
template <bool PERMUP>
__device__ __forceinline__ void convert_item2(const float* __restrict__ src, bf16_t* __restrict__ dst, int K, int N, const float* __restrict__ gain, int itemA, int itemB, bool hasB, int lane) {
    const int tk = K / 64;
    int kk0[2], n4[2];
    kk0[0] = (itemA % tk) * 64 + (lane & 7) * 8; n4[0] = (itemA / tk) * 32 + (lane >> 3) * 4;
    const int ib = hasB ? itemB : itemA;
    kk0[1] = (ib % tk) * 64 + (lane & 7) * 8; n4[1] = (ib / tk) * 32 + (lane >> 3) * 4;
    f32x4 v[2][8];
#pragma unroll
    for (int u = 0; u < 2; ++u)
#pragma unroll
        for (int i = 0; i < 8; ++i) v[u][i] = (n4[u] < N) ? *(const f32x4*)(src + (size_t)(kk0[u] + i) * N + (PERMUP ? up_src_col(n4[u]) : n4[u])) : (f32x4){0.f, 0.f, 0.f, 0.f};
#pragma unroll
    for (int u = 0; u < 2; ++u) {
        if (u == 1 && !hasB) break;
        if (gain) {
            const f32x4 g0 = *(const f32x4*)(gain + kk0[u]), g1 = *(const f32x4*)(gain + kk0[u] + 4);
#pragma unroll
            for (int i = 0; i < 4; ++i) { v[u][i] = v[u][i] * g0[i]; v[u][4 + i] = v[u][4 + i] * g1[i]; }
        }
#pragma unroll
        for (int e = 0; e < 4; ++e) {
            u32x4 w; w.x = pk2(v[u][0][e], v[u][1][e]); w.y = pk2(v[u][2][e], v[u][3][e]); w.z = pk2(v[u][4][e], v[u][5][e]); w.w = pk2(v[u][6][e], v[u][7][e]);
            *(u32x4*)(dst + (size_t)(n4[u] + e) * K + kk0[u]) = w;
        }
    }
}
template <bool PERMUP = false>
__device__ __forceinline__ void convert_steal(const float* __restrict__ src, bf16_t* __restrict__ dst, int K, int N, int Npad, const float* __restrict__ gain, unsigned* ctr, LAS unsigned char* lds) {
    const int nitems = (K / 64) * (Npad / 32), lane = threadIdx.x & 63, wid = threadIdx.x >> 6;
    volatile LAS unsigned* slot = (volatile LAS unsigned*)(lds + LDS_ST_OFF + 8);
    if (threadIdx.x == 0) *slot = __hip_atomic_fetch_add(ctr, 64u, __ATOMIC_RELAXED, __HIP_MEMORY_SCOPE_AGENT);
    __syncthreads();
    int t0 = (int)*slot;
    __syncthreads();
    while (t0 < nitems) {
        unsigned nxt = 0u;
        if (threadIdx.x == 0) nxt = __hip_atomic_fetch_add(ctr, 64u, __ATOMIC_RELAXED, __HIP_MEMORY_SCOPE_AGENT);
#pragma unroll 1
        for (int q = 0; q < 8; q += 2) {
            const int ia = t0 + wid + 8 * q, ib = ia + 8;
            if (ia < nitems) convert_item2<PERMUP>(src, dst, K, N, gain, ia, ib, ib < nitems, lane);
        }
        if (threadIdx.x == 0) *slot = nxt;
        __syncthreads();
        t0 = (int)*slot;
        __syncthreads();
    }
}

template <int MODE>
__device__ __forceinline__ void rms_phase(const float* __restrict__ h_in, float* __restrict__ h_out, const float* __restrict__ x, const float* __restrict__ meta,
                          const float* __restrict__ gain, bf16_t* __restrict__ hn, float* __restrict__ out) {
    const int lane = threadIdx.x & 63, gw = blockIdx.x * 8 + (threadIdx.x >> 6), nw = gridDim.x * 8;
    for (int row = gw; row < M; row += nw) {
        const int b = row / L, t = row - b * L;
        if (MODE == 2 && t < NMETA) continue;
        const float* src;
        if (MODE == 1) src = (t < NMETA) ? meta + (size_t)t * D : x + ((size_t)b * SEQ + (t - NMETA)) * D;
        else src = h_in + (size_t)row * D;
        f32x4 v[8]; float ss = 0.f;
#pragma unroll
        for (int i = 0; i < 8; ++i) { v[i] = *(const f32x4*)(src + (lane + i * 64) * 4); ss += v[i][0] * v[i][0] + v[i][1] * v[i][1] + v[i][2] * v[i][2] + v[i][3] * v[i][3]; }
        ss = wave_sum(ss);
        const float r = rsqrtf(ss * (1.0f / D) + 1e-6f);
#pragma unroll
        for (int i = 0; i < 8; ++i) {
            const int c = (lane + i * 64) * 4;
            const f32x4 g = *(const f32x4*)(gain + c);
            const f32x4 o = v[i] * r * g;
            if (MODE == 2) *(f32x4*)(out + ((size_t)b * SEQ + (t - NMETA)) * D + c) = o;
            else { u32x2 w; w.x = pk2(o[0], o[1]); w.y = pk2(o[2], o[3]); *(u32x2*)(hn + (size_t)row * D + c) = w; }
        }
    }
}

__device__ __forceinline__ void mixer_ab_phase(const bf16_t* __restrict__ z1, const float* __restrict__ conf_dw, const float* __restrict__ conf_b, const float* __restrict__ ln_g,
                               const float* __restrict__ ln_b, const float* __restrict__ sc_dw, bf16_t* __restrict__ cat, LAS unsigned char* lds) {
    const int tid = threadIdx.x, wid = __builtin_amdgcn_readfirstlane(tid >> 6), lane = tid & 63;
    constexpr int TT = 33, TPB = (L + TT - 1) / TT;
    LAS unsigned* S32 = (LAS unsigned*)lds;
    LAS float* C = (LAS float*)lds;
    for (int tile = blockIdx.x; tile < NBATCH * TPB; tile += gridDim.x) {
        const int b = tile / TPB, t0 = (tile % TPB) * TT;
        const int nt = (L - t0) < TT ? (L - t0) : TT;
        static_assert((TT + 30) % 7 == 0, "staging loop is unrolled by 7");
#pragma unroll 1
        for (int r0 = 0; r0 < TT + 30; r0 += 7) {
            unsigned av[7], gv[7];
#pragma unroll
            for (int u = 0; u < 7; ++u) {
                const int t = t0 - 30 + r0 + u, tc = t < 0 ? 0 : (t >= L ? L - 1 : t);
                const bf16_t* zr = z1 + (size_t)(b * L + tc) * NAB;
                av[u] = *(const unsigned*)(zr + 2 * tid); gv[u] = *(const unsigned*)(zr + 1024 + 2 * tid);
            }
#pragma unroll
            for (int u = 0; u < 7; ++u) {
                const int t = t0 - 30 + r0 + u;
                unsigned w = pk2(lo_f(av[u]) * fsigm(lo_f(gv[u])), hi_f(av[u]) * fsigm(hi_f(gv[u])));
                if (t < 0 || t >= L) w = 0u;
                S32[(r0 + u) * 512 + tid] = w;
            }
        }
        __syncthreads();
        f32x2 acc[TT];
#pragma unroll
        for (int t = 0; t < TT; ++t) acc[t] = (f32x2){0.f, 0.f};
        f32x2 wnext = *(const f32x2*)(conf_dw + 2 * tid);
#pragma unroll 1
        for (int j = 0; j < 31; ++j) {
            const f32x2 w = wnext;
            wnext = *(const f32x2*)(conf_dw + (j < 30 ? j + 1 : j) * 1024 + 2 * tid);
#pragma unroll
            for (int t = 0; t < TT; ++t) { const unsigned xw = S32[(t + j) * 512 + tid]; acc[t] += (f32x2){lo_f(xw), hi_f(xw)} * w; }
        }
        const f32x2 bias = *(const f32x2*)(conf_b + 2 * tid);
        __syncthreads();
#pragma unroll
        for (int t = 0; t < TT; ++t) *(LAS f32x2*)(C + t * 1024 + 2 * tid) = acc[t] + bias;
        __syncthreads();
        for (int q = 0; q < 5; ++q) {
            const int tt = wid + 8 * q;
            if (tt < nt) {
                f32x4 v[4]; float s = 0.f;
#pragma unroll
                for (int i = 0; i < 4; ++i) { v[i] = *(const LAS f32x4*)(C + tt * 1024 + (lane + i * 64) * 4); s += (v[i][0] + v[i][1]) + (v[i][2] + v[i][3]); }
                const float mean = wave_sum(s) * (1.0f / 1024.0f);
                float qv = 0.f;
#pragma unroll
                for (int i = 0; i < 4; ++i) { const f32x4 d = v[i] - mean; qv += d[0] * d[0] + d[1] * d[1] + d[2] * d[2] + d[3] * d[3]; }
                const float rstd = rsqrtf(wave_sum(qv) * (1.0f / 1024.0f) + 1e-5f);
                bf16_t* orow = cat + (size_t)(b * L + t0 + tt) * D;
#pragma unroll
                for (int i = 0; i < 4; ++i) {
                    const int c = (lane + i * 64) * 4;
                    const f32x4 g = *(const f32x4*)(ln_g + c), bb = *(const f32x4*)(ln_b + c);
                    const f32x4 y = (v[i] - mean) * rstd * g + bb;
                    u32x2 w; w.x = pk2(fsilu(y[0]), fsilu(y[1])); w.y = pk2(fsilu(y[2]), fsilu(y[3]));
                    *(u32x2*)(orow + c) = w;
                }
            }
        }
        __syncthreads();
    }
    const int gtid = blockIdx.x * NTHREADS + tid, nth = gridDim.x * NTHREADS;
    for (int idx = gtid; idx < M * 128; idx += nth) {
        const int row = idx >> 7, c = (idx & 127) * 8, t = row % L;
        float acc[8];
#pragma unroll
        for (int e = 0; e < 8; ++e) acc[e] = 0.f;
#pragma unroll
        for (int j = 0; j < 3; ++j) {
            if (t - 2 + j >= 0) {
                const bf16_t* zr = z1 + (size_t)(row - 2 + j) * NAB;
                const u32x4 sc = *(const u32x4*)(zr + 3072 + c), sx = *(const u32x4*)(zr + 4096 + c);
                const f32x4 w0 = *(const f32x4*)(sc_dw + j * 1024 + c), w1 = *(const f32x4*)(sc_dw + j * 1024 + c + 4);
                acc[0] += lo_f(sc.x) * lo_f(sx.x) * w0[0]; acc[1] += hi_f(sc.x) * hi_f(sx.x) * w0[1];
                acc[2] += lo_f(sc.y) * lo_f(sx.y) * w0[2]; acc[3] += hi_f(sc.y) * hi_f(sx.y) * w0[3];
                acc[4] += lo_f(sc.z) * lo_f(sx.z) * w1[0]; acc[5] += hi_f(sc.z) * hi_f(sx.z) * w1[1];
                acc[6] += lo_f(sc.w) * lo_f(sx.w) * w1[2]; acc[7] += hi_f(sc.w) * hi_f(sx.w) * w1[3];
            }
        }
        const u32x4 sb = *(const u32x4*)(z1 + (size_t)row * NAB + 2048 + c);
        u32x4 o;
        o.x = pk2(lo_f(sb.x) * acc[0], hi_f(sb.x) * acc[1]); o.y = pk2(lo_f(sb.y) * acc[2], hi_f(sb.y) * acc[3]);
        o.z = pk2(lo_f(sb.z) * acc[4], hi_f(sb.z) * acc[5]); o.w = pk2(lo_f(sb.w) * acc[6], hi_f(sb.w) * acc[7]);
        *(u32x4*)(cat + (size_t)row * D + 1024 + c) = o;
    }
}

__device__ __forceinline__ void ffn_gate_phase(const bf16_t* __restrict__ u, const float* __restrict__ dw  , bf16_t* __restrict__ g) {
    const int gtid = blockIdx.x * NTHREADS + threadIdx.x, nth = gridDim.x * NTHREADS;
    constexpr int NC8 = DFF / 8, NRUN = L / 16;
    for (int idx = gtid; idx < NBATCH * NRUN * NC8; idx += nth) {
        const int c = (idx % NC8) * 8, run = (idx / NC8) % NRUN, b = idx / (NC8 * NRUN), t0 = run * 16;
        float wv[3][8], wg[3][8];
#pragma unroll
        for (int j = 0; j < 3; ++j) {
            const f32x4 a0 = *(const f32x4*)(dw + j * NUP + c), a1 = *(const f32x4*)(dw + j * NUP + c + 4);
            const f32x4 g0 = *(const f32x4*)(dw + j * NUP + DFF + c), g1 = *(const f32x4*)(dw + j * NUP + DFF + c + 4);
#pragma unroll
            for (int e = 0; e < 4; ++e) { wv[j][e] = a0[e]; wv[j][4 + e] = a1[e]; wg[j][e] = g0[e]; wg[j][4 + e] = g1[e]; }
        }
        u32x4 v2 = (u32x4){0u, 0u, 0u, 0u}, v1 = v2, g2 = v2, g1 = v2;
        if (t0 >= 2) {
            const bf16_t* r2 = u + (size_t)(b * L + t0 - 2) * NUP; const bf16_t* r1 = r2 + NUP;
            v2 = *(const u32x4*)(r2 + c); g2 = *(const u32x4*)(r2 + DFF + c); v1 = *(const u32x4*)(r1 + c); g1 = *(const u32x4*)(r1 + DFF + c);
        }
#pragma unroll 4
        for (int i = 0; i < 16; ++i) {
            const size_t row = (size_t)(b * L + t0 + i);
            const u32x4 v0 = *(const u32x4*)(u + row * NUP + c), g0 = *(const u32x4*)(u + row * NUP + DFF + c);
            float val[8], gat[8];
#define TAP(e, W2, W1, W0, sel) \
            val[e] = sel(v2.W2) * wv[0][e] + sel(v1.W1) * wv[1][e] + sel(v0.W0) * wv[2][e]; gat[e] = sel(g2.W2) * wg[0][e] + sel(g1.W1) * wg[1][e] + sel(g0.W0) * wg[2][e];
            TAP(0, x, x, x, lo_f) TAP(1, x, x, x, hi_f) TAP(2, y, y, y, lo_f) TAP(3, y, y, y, hi_f)
            TAP(4, z, z, z, lo_f) TAP(5, z, z, z, hi_f) TAP(6, w, w, w, lo_f) TAP(7, w, w, w, hi_f)
#undef TAP
            u32x4 o;
            o.x = pk2(fsilu(gat[0]) * val[0], fsilu(gat[1]) * val[1]); o.y = pk2(fsilu(gat[2]) * val[2], fsilu(gat[3]) * val[3]);
            o.z = pk2(fsilu(gat[4]) * val[4], fsilu(gat[5]) * val[5]); o.w = pk2(fsilu(gat[6]) * val[6], fsilu(gat[7]) * val[7]);
            *(u32x4*)(g + row * DFF + c) = o;
            v2 = v1; g2 = g1; v1 = v0; g1 = g0;
        }
    }
}

struct CD {
    const float *z2, *gla_w2, *gla_b, *gla_norm_g, *rw_mu, *rw_w0, *rw_a0, *rw_kk, *rw_ka, *rw_rk, *rw_ln_g, *rw_ln_b;
    float *R, *KR, *VR, *G, *Y, *CDEC, *BONUS, *DECAY, *A, *KK, *O;
    bf16_t *LW, *LA, *LG, *GATE, *QDEC, *KDEC, *K2T, *VT, *W2T, *A2T, *G2T, *CST, *SPT, *P, *CAT;
};

__device__ __forceinline__ void prep1_phase(const CD& p, LAS unsigned char* lds) {
    const int tid = threadIdx.x, wid = __builtin_amdgcn_readfirstlane(tid >> 6), lane = tid & 63;
    LAS float* tot = (LAS float*)lds;
    for (int item = blockIdx.x; item < NGI; item += gridDim.x) {
        const int bh = item / NCH, n = item - bh * NCH, b = bh >> 2, h = bh & 3;
        const int pg = wid >> 1, d = (wid & 1) * 64 + lane;
        float w2r[16];
#pragma unroll
        for (int r = 0; r < 16; ++r) w2r[r] = p.gla_w2[r * 512 + h * 128 + d];
        const float bias = p.gla_b[h * 128 + d];
        float la[16]; float run = 0.f;
#pragma unroll
        for (int i = 0; i < 16; ++i) {
            const int t = n * 64 + pg * 16 + i - 48;
            float v = 0.f;
            if (t >= 0 && t < L) {
                const float* gl = p.z2 + (size_t)(b * L + t) * NCDP + 3072;
                float xx = bias;
#pragma unroll
                for (int r = 0; r < 16; ++r) xx += gl[r] * w2r[r];
                v = logsig(xx) * (1.0f / 16.0f);
            }
            run += v; la[i] = run;
        }
        tot[pg * 128 + d] = run;
        __syncthreads();
        float off = 0.f, last = 0.f;
#pragma unroll
        for (int g4 = 0; g4 < 4; ++g4) { const float tv = tot[g4 * 128 + d]; if (g4 < pg) off += tv; last += tv; }
        unsigned k2p[8];
#pragma unroll
        for (int i = 0; i < 16; ++i) {
            const int pp = pg * 16 + i, t = n * 64 + pp - 48;
            const float cum = off + la[i];
            float q = 0.f, k = 0.f;
            if (t >= 0 && t < L) { const float* zr = p.z2 + (size_t)(b * L + t) * NCDP; q = zr[h * 128 + d] * 0.08838834764831845f; k = zr[512 + h * 128 + d]; }
            const float qd = q * __builtin_amdgcn_exp2f(cum * 1.4426950408889634f), kd = k * __builtin_amdgcn_exp2f(cum * -1.4426950408889634f), k2 = k * __builtin_amdgcn_exp2f((last - cum) * 1.4426950408889634f);
            p.QDEC[((size_t)item * 64 + pp) * 128 + d] = (bf16_t)f2bf(qd);
            p.KDEC[((size_t)item * 64 + pp) * 128 + d] = (bf16_t)f2bf(kd);
            if (i & 1) k2p[i >> 1] |= f2bf(k2) << 16; else k2p[i >> 1] = f2bf(k2);
        }
        {
            bf16_t* dst = p.K2T + ((size_t)item * 128 + d) * 64 + pg * 16;
            *(u32x4*)(dst) = (u32x4){k2p[0], k2p[1], k2p[2], k2p[3]};
            *(u32x4*)(dst + 8) = (u32x4){k2p[4], k2p[5], k2p[6], k2p[7]};
        }
        if (pg == 0) p.CDEC[item * 128 + d] = expf(last);
        {
            const int v = tid & 255, ph = tid >> 8;
            unsigned vp[16];
#pragma unroll
            for (int i = 0; i < 32; ++i) {
                const int t = n * 64 + ph * 32 + i - 48;
                float xv = 0.f;
                if (t >= 0 && t < L) xv = p.z2[(size_t)(b * L + t) * NCDP + 1024 + h * 256 + v];
                if (i & 1) vp[i >> 1] |= f2bf(xv) << 16; else vp[i >> 1] = f2bf(xv);
            }
            bf16_t* dst = p.VT + ((size_t)item * 256 + v) * 64 + ph * 32;
#pragma unroll
            for (int s = 0; s < 4; ++s) *(u32x4*)(dst + s * 8) = (u32x4){vp[s * 4 + 0], vp[s * 4 + 1], vp[s * 4 + 2], vp[s * 4 + 3]};
        }
        __syncthreads();
    }
    const int gtid = blockIdx.x * NTHREADS + tid, nth = gridDim.x * NTHREADS;
    for (int base = gtid; base < M * 256; base += nth * 4) {
        f32x4 go[4], ng[4];
#pragma unroll
        for (int u = 0; u < 4; ++u) {
            const int idx = base + u * nth, ic = idx < M * 256 ? idx : 0, row = ic >> 8, c = (ic & 255) * 4;
            go[u] = *(const f32x4*)(p.z2 + (size_t)row * NCDP + 2048 + c); ng[u] = *(const f32x4*)(p.gla_norm_g + c);
        }
#pragma unroll
        for (int u = 0; u < 4; ++u) {
            const int idx = base + u * nth;
            if (idx < M * 256) {
                const int row = idx >> 8, c = (idx & 255) * 4;
                u32x2 w; w.x = pk2(fsilu(go[u][0]) * ng[u][0], fsilu(go[u][1]) * ng[u][1]); w.y = pk2(fsilu(go[u][2]) * ng[u][2], fsilu(go[u][3]) * ng[u][3]);
                *(u32x2*)(p.GATE + (size_t)row * 1024 + c) = w;
            }
        }
    }
    for (int base = gtid; base < M * 832; base += nth * 4) {
        f32x4 zv[4], zpv[4], muv[4];
#pragma unroll
        for (int u = 0; u < 4; ++u) {
            const int idx = base + u * nth, ic = idx < M * 832 ? idx : 0, row = ic / 832, c4 = (ic - row * 832) * 4, t = row % L;
            zv[u] = *(const f32x4*)(p.z2 + (size_t)row * NCDP + 3088 + c4);
            zpv[u] = *(const f32x4*)(p.z2 + (size_t)(t > 0 ? row - 1 : row) * NCDP + 3088 + c4);
            if (t == 0) zpv[u] = (f32x4){0.f, 0.f, 0.f, 0.f};
            muv[u] = *(const f32x4*)(p.rw_mu + c4);
        }
#pragma unroll
        for (int u = 0; u < 4; ++u) {
        const int idx = base + u * nth;
        if (idx >= M * 832) continue;
        const int row = idx / 832, c4 = (idx - row * 832) * 4;
        const f32x4 zr = zv[u] + (zpv[u] - zv[u]) * muv[u];
        if (c4 < 1024) *(f32x4*)(p.R + (size_t)row * 1024 + c4) = zr;
        else if (c4 < 2048) *(f32x4*)(p.KR + (size_t)row * 1024 + c4 - 1024) = zr;
        else if (c4 < 3072) *(f32x4*)(p.VR + (size_t)row * 1024 + c4 - 2048) = zr;
        else if (c4 < 3136) { u32x2 w; w.x = pk2(tanhf(zr[0]), tanhf(zr[1])); w.y = pk2(tanhf(zr[2]), tanhf(zr[3])); *(u32x2*)(p.LW + (size_t)row * 64 + c4 - 3072) = w; }
        else if (c4 < 3200) { u32x2 w; w.x = pk2(zr[0], zr[1]); w.y = pk2(zr[2], zr[3]); *(u32x2*)(p.LA + (size_t)row * 64 + c4 - 3136) = w; }
        else { u32x2 w; w.x = pk2(sigm(zr[0]), sigm(zr[1])); w.y = pk2(sigm(zr[2]), sigm(zr[3])); *(u32x2*)(p.LG + (size_t)row * 128 + c4 - 3200) = w; }
        }
    }
}

__device__ __forceinline__ void small_gemm_phase(const CD& p) {
    const int lane = threadIdx.x & 63, fr = lane & 15, fq = lane >> 4;
    const int gw = blockIdx.x * 8 + (threadIdx.x >> 6), nw = gridDim.x * 8;
    constexpr int TL = (M / 64) * 16;
    constexpr int T0 = 3 * TL, T1 = T0 + NGI, T2 = T1 + NGI * 8;
    for (int tix = gw; tix < T2; tix += nw) {
        f32x4 acc[4][4]; zero_acc(acc);
        if (tix < T0) {
            const int which = tix / TL, r = tix - which * TL, m0 = (r >> 4) * 64, n0 = (r & 15) * 64;
            if (which == 0) {
                f32x4 w0v[4];
#pragma unroll
                for (int ni = 0; ni < 4; ++ni) w0v[ni] = *(const f32x4*)(p.rw_w0 + n0 + ni * 16 + fq * 4);
                wave_tile_mma<2>(p.LW + (size_t)m0 * 64, 64, p.W2T + (size_t)n0 * 64, 64, 0, 64, acc, fr, fq);
#pragma unroll
                for (int mi = 0; mi < 4; ++mi)
#pragma unroll
                    for (int ni = 0; ni < 4; ++ni) {
                        const int row = m0 + mi * 16 + fr, col = n0 + ni * 16 + fq * 4;
                        const f32x4 w0 = w0v[ni]; f32x4 o;
#pragma unroll
                        for (int e = 0; e < 4; ++e) o[e] = expf(-0.6065306597126334f * sigm(w0[e] + acc[mi][ni][e]));
                        *(f32x4*)(p.DECAY + (size_t)row * 1024 + col) = o;
                    }
            } else if (which == 1) {
                f32x4 a0v[4];
#pragma unroll
                for (int ni = 0; ni < 4; ++ni) a0v[ni] = *(const f32x4*)(p.rw_a0 + n0 + ni * 16 + fq * 4);
                wave_tile_mma<2>(p.LA + (size_t)m0 * 64, 64, p.A2T + (size_t)n0 * 64, 64, 0, 64, acc, fr, fq);
#pragma unroll
                for (int mi = 0; mi < 4; ++mi)
#pragma unroll
                    for (int ni = 0; ni < 4; ++ni) {
                        const int row = m0 + mi * 16 + fr, col = n0 + ni * 16 + fq * 4;
                        const f32x4 a0 = a0v[ni]; f32x4 o;
#pragma unroll
                        for (int e = 0; e < 4; ++e) o[e] = fsigm(a0[e] + acc[mi][ni][e]);
                        *(f32x4*)(p.A + (size_t)row * 1024 + col) = o;
                    }
            } else {
                wave_tile_mma<4>(p.LG + (size_t)m0 * 128, 128, p.G2T + (size_t)n0 * 128, 128, 0, 128, acc, fr, fq);
#pragma unroll
                for (int mi = 0; mi < 4; ++mi)
#pragma unroll
                    for (int ni = 0; ni < 4; ++ni) {
                        const int row = m0 + mi * 16 + fr, col = n0 + ni * 16 + fq * 4;
                        *(f32x4*)(p.G + (size_t)row * 1024 + col) = acc[mi][ni];
                    }
            }
        } else if (tix < T1) {
            const int item = tix - T0;
            wave_tile_mma<4>(p.QDEC + (size_t)item * 8192, 128, p.KDEC + (size_t)item * 8192, 128, 0, 128, acc, fr, fq);
#pragma unroll
            for (int mi = 0; mi < 4; ++mi)
#pragma unroll
                for (int ni = 0; ni < 4; ++ni) {
                    const int pp = mi * 16 + fr, s0 = ni * 16 + fq * 4;
                    f32x4 v = acc[mi][ni];
#pragma unroll
                    for (int e = 0; e < 4; ++e) if (s0 + e > pp) v[e] = 0.f;
                    u32x2 w; w.x = pk2(v[0], v[1]); w.y = pk2(v[2], v[3]);
                    *(u32x2*)(p.P + (size_t)item * 4096 + pp * 64 + s0) = w;
                }
        } else {
            const int r = tix - T1, item = r >> 3, vt = (r >> 1) & 3, dt = r & 1;
            wave_tile_mma<2>(p.VT + ((size_t)item * 256 + vt * 64) * 64, 64, p.K2T + ((size_t)item * 128 + dt * 64) * 64, 64, 0, 64, acc, fr, fq);
#pragma unroll
            for (int mi = 0; mi < 4; ++mi)
#pragma unroll
                for (int ni = 0; ni < 4; ++ni) {
                    const int v = vt * 64 + mi * 16 + fr, d0 = dt * 64 + ni * 16 + fq * 4;
                    u32x2 w; w.x = pk2(acc[mi][ni][0], acc[mi][ni][1]); w.y = pk2(acc[mi][ni][2], acc[mi][ni][3]);
                    *(u32x2*)(p.CST + ((size_t)item * 256 + v) * 128 + d0) = w;
                }
        }
    }
}

__device__ __forceinline__ void prep2_phase(const CD& p) {
    const int gtid = blockIdx.x * NTHREADS + threadIdx.x, nth = gridDim.x * NTHREADS;
    for (int e = gtid; e < 16 * 256 * 32; e += nth) {
        const int d4 = (e & 31) * 4, v = (e >> 5) & 255, bh = e >> 13;
        f32x4 S = (f32x4){0.f, 0.f, 0.f, 0.f};
        const size_t o0 = ((size_t)(bh * NCH) * 256 + v) * 128 + d4;
        f32x4 decs[3]; u32x2 css[3];
#pragma unroll 1
        for (int n0 = 0; n0 < NCH; n0 += 3) {
#pragma unroll
            for (int u = 0; u < 3; ++u) { decs[u] = *(const f32x4*)(p.CDEC + (bh * NCH + n0 + u) * 128 + d4); css[u] = *(const u32x2*)(p.CST + o0 + (size_t)(n0 + u) * 32768); }
#pragma unroll
            for (int u = 0; u < 3; ++u) {
                u32x2 w; w.x = pk2(S[0], S[1]); w.y = pk2(S[2], S[3]);
                *(u32x2*)(p.SPT + o0 + (size_t)(n0 + u) * 32768) = w;
                S = S * decs[u] + (f32x4){lo_f(css[u].x), hi_f(css[u].x), lo_f(css[u].y), hi_f(css[u].y)};
            }
        }
    }
}

__device__ __forceinline__ void gla_out_phase(const CD& p) {
    const int lane = threadIdx.x & 63, fr = lane & 15, fq = lane >> 4;
    const int gw = blockIdx.x * 8 + (threadIdx.x >> 6), nw = gridDim.x * 8;
    for (int tix = gw; tix < NGI * 4; tix += nw) {
        const int item = tix >> 2, vt = tix & 3, bh = item / NCH, n = item - bh * NCH, b = bh >> 2, h = bh & 3;
        f32x4 acc[4][4]; zero_acc(acc);
        wave_tile_mma<2>(p.P + (size_t)item * 4096, 64, p.VT + ((size_t)item * 256 + vt * 64) * 64, 64, 0, 64, acc, fr, fq);
        wave_tile_mma<4>(p.QDEC + (size_t)item * 8192, 128, p.SPT + ((size_t)item * 256 + vt * 64) * 128, 128, 0, 128, acc, fr, fq);
#pragma unroll
        for (int mi = 0; mi < 4; ++mi) {
            const int t = n * 64 + mi * 16 + fr - 48;
            if (t >= 0 && t < L) {
#pragma unroll
                for (int ni = 0; ni < 4; ++ni) *(f32x4*)(p.O + (size_t)(b * L + t) * 1024 + h * 256 + vt * 64 + ni * 16 + fq * 4) = acc[mi][ni];
            }
        }
    }
}

__device__ __forceinline__ float oct_sum(float x) {
    x += __int_as_float(__builtin_amdgcn_update_dpp(0, __float_as_int(x), 0xB1, 0xF, 0xF, false));
    x += __int_as_float(__builtin_amdgcn_update_dpp(0, __float_as_int(x), 0x4E, 0xF, 0xF, false));
    x += __int_as_float(__builtin_amdgcn_update_dpp(0, __float_as_int(x), 0x141, 0xF, 0xF, false));
    return x;
}
struct StepOps { f32x4 r[2], w[2], k[2], kk[2], b[2]; float v; };
template <bool WITH_R>
__device__ __forceinline__ void ld_ops(StepOps& o, const LAS float* bp, int s, int j, int vidx) {
    const LAS float* sp = bp + s * 64 + j * 8;
    if (WITH_R) { o.r[0] = *(const LAS f32x4*)(sp); o.r[1] = *(const LAS f32x4*)(sp + 4); }
    o.w[0] = *(const LAS f32x4*)(sp + 2048); o.w[1] = *(const LAS f32x4*)(sp + 2048 + 4);
    o.k[0] = *(const LAS f32x4*)(sp + 4096); o.k[1] = *(const LAS f32x4*)(sp + 4096 + 4);
    o.kk[0] = *(const LAS f32x4*)(sp + 6144); o.kk[1] = *(const LAS f32x4*)(sp + 6144 + 4);
    o.b[0] = *(const LAS f32x4*)(sp + 8192); o.b[1] = *(const LAS f32x4*)(sp + 8192 + 4);
    o.v = bp[10240 + s * 64 + vidx];
}
template <bool WITH_V>
__device__ __forceinline__ void scan_update(f32x2 (&S)[4], const StepOps& o) {
    f32x2 sa2 = S[0] * o.kk[0].lo + S[1] * o.kk[0].hi;
    sa2 += S[2] * o.kk[1].lo + S[3] * o.kk[1].hi;
    const float sa = -oct_sum(sa2[0] + sa2[1]);
    const f32x2 sv = (f32x2){sa, sa};
    if (WITH_V) {
        const f32x2 vv = (f32x2){o.v, o.v};
        S[0] = S[0] * o.w[0].lo + (sv * o.b[0].lo + vv * o.k[0].lo);
        S[1] = S[1] * o.w[0].hi + (sv * o.b[0].hi + vv * o.k[0].hi);
        S[2] = S[2] * o.w[1].lo + (sv * o.b[1].lo + vv * o.k[1].lo);
        S[3] = S[3] * o.w[1].hi + (sv * o.b[1].hi + vv * o.k[1].hi);
    } else {
        S[0] = S[0] * o.w[0].lo + sv * o.b[0].lo;
        S[1] = S[1] * o.w[0].hi + sv * o.b[0].hi;
        S[2] = S[2] * o.w[1].lo + sv * o.b[1].lo;
        S[3] = S[3] * o.w[1].hi + sv * o.b[1].hi;
    }
}
__device__ __forceinline__ float scan_y(const f32x2 (&S)[4], const StepOps& o) {
    f32x2 y2 = S[0] * o.r[0].lo + S[1] * o.r[0].hi;
    y2 += S[2] * o.r[1].lo + S[3] * o.r[1].hi;
    return oct_sum(y2[0] + y2[1]);
}
template <int MODE>
__device__ __forceinline__ void rwkv_scan_pass(const CD& p, float* __restrict__ PSI, float* __restrict__ PHI, LAS unsigned char* lds) {
    constexpr int CL = L / 4, NSUB = (CL + 31) / 32;
    const int tid = threadIdx.x, wid = __builtin_amdgcn_readfirstlane(tid >> 6), lane = tid & 63;
    LAS float* buf = (LAS float*)lds;
    LAS float* Sm = (LAS float*)(lds + 98304);
    LAS float* Pm = (LAS float*)(lds + 114688);
    for (int item = blockIdx.x; item < 256; item += gridDim.x) {
        const int bh = item >> 2, c = item & 3, b = bh >> 4, h = bh & 15;
        const int rr = tid >> 4, c4 = (tid & 15) * 4;
        const size_t gbase = (size_t)(b * L + c * CL) * 1024 + h * 64 + c4;
        f32x4 st0, st1, st2, st4, st5;
        const f32x4 pkk = *(const f32x4*)(p.rw_kk + h * 64 + c4), pka = *(const f32x4*)(p.rw_ka + h * 64 + c4), prk = *(const f32x4*)(p.rw_rk + h * 64 + c4);
#define SCAN_LOADS(tn) do { const size_t _o = gbase + (size_t)(tn) * 1024; \
        if (MODE == 3) st0 = *(const f32x4*)(p.R + _o); st1 = *(const f32x4*)(p.DECAY + _o); st2 = *(const f32x4*)(p.KR + _o); \
        st4 = *(const f32x4*)(p.A + _o); st5 = *(const f32x4*)(p.VR + _o); } while (0)
#define SCAN_STORES(bb, tl) do { LAS float* _d = buf + (bb) * 12288 + rr * 64 + c4; \
        f32x4 _kk = st2 * pkk; const float _ss = sum16(_kk[0] * _kk[0] + _kk[1] * _kk[1] + _kk[2] * _kk[2] + _kk[3] * _kk[3]); \
        _kk = _kk * (1.0f / fmaxf(sqrtf(_ss), 1e-12f)); \
        const f32x4 _k = st2 * (1.0f + (st4 - 1.0f) * pka); \
        if (MODE == 3) { const f32x4 _rk = st0 * _k * prk; const float _bs = sum16((_rk[0] + _rk[1]) + (_rk[2] + _rk[3])); \
            if ((tid & 15) == 0 && (tl) < CL) p.BONUS[(size_t)(b * L + c * CL + (tl)) * 16 + h] = _bs; \
            *(LAS f32x4*)(_d) = st0; } \
        *(LAS f32x4*)(_d + 2048) = st1; *(LAS f32x4*)(_d + 4096) = _k; \
        *(LAS f32x4*)(_d + 6144) = _kk; *(LAS f32x4*)(_d + 8192) = _kk * st4; *(LAS f32x4*)(_d + 10240) = st5; } while (0)
        st0 = (f32x4){0.f, 0.f, 0.f, 0.f};
        SCAN_LOADS(rr);
        SCAN_STORES(0, rr);
        const int slot = lane >> 3, j = lane & 7, r = wid * 8 + slot;
        f32x2 S0[4], S1[4];
#pragma unroll
        for (int i = 0; i < 4; ++i) { S0[i] = (f32x2){0.f, 0.f}; S1[i] = (f32x2){(8 * j + 2 * i) == r ? 1.f : 0.f, (8 * j + 2 * i + 1) == r ? 1.f : 0.f}; }
        if (MODE == 3 && c > 0) {
            const float* ps0 = PSI + (size_t)(bh * 4) * 4096;
#pragma unroll
            for (int i = 0; i < 2; ++i) *(LAS f32x4*)(Sm + (tid + i * 512) * 4) = *(const f32x4*)(ps0 + (tid + i * 512) * 4);
            for (int cc = 1; cc < c; ++cc) {
                const float* ph = PHI + (size_t)(bh * 4 + cc) * 4096; const float* ps = PSI + (size_t)(bh * 4 + cc) * 4096;
#pragma unroll
                for (int i = 0; i < 2; ++i) *(LAS f32x4*)(Pm + (tid + i * 512) * 4) = *(const f32x4*)(ph + (tid + i * 512) * 4);
                const int v = tid >> 3, kq = (tid & 7) * 8;
                f32x4 a0 = *(const f32x4*)(ps + v * 64 + kq), a1 = *(const f32x4*)(ps + v * 64 + kq + 4);
                __syncthreads();
#pragma unroll 8
                for (int k = 0; k < 64; ++k) {
                    const float s = Sm[v * 64 + k];
                    a0 += s * *(const LAS f32x4*)(Pm + k * 64 + kq); a1 += s * *(const LAS f32x4*)(Pm + k * 64 + kq + 4);
                }
                __syncthreads();
                *(LAS f32x4*)(Sm + v * 64 + kq) = a0; *(LAS f32x4*)(Sm + v * 64 + kq + 4) = a1;
            }
            __syncthreads();
            const f32x4 i0 = *(const LAS f32x4*)(Sm + r * 64 + 8 * j), i1 = *(const LAS f32x4*)(Sm + r * 64 + 8 * j + 4);
            S0[0] = i0.lo; S0[1] = i0.hi; S0[2] = i1.lo; S0[3] = i1.hi;
        }
        __syncthreads();
        int cb = 0;
        for (int sc = 0; sc < NSUB; ++sc) {
            const int t0 = sc * 32;
            const bool more = (sc + 1 < NSUB);
            if (more) {
                const int tn = t0 + 32 + rr;
                if (tn < CL) SCAN_LOADS(tn);
                else { st0 = (f32x4){0.f, 0.f, 0.f, 0.f}; st1 = st0; st2 = st0; st4 = st0; st5 = st0; }
            }
            {
                const LAS float* bp = buf + cb * 12288;
                const int ns = (CL - t0) < 32 ? (CL - t0) : 32;
                LAS float* yt = (LAS float*)(lds + 98304) + cb * 2048 + r;
                StepOps A, B;
                ld_ops<MODE == 3>(A, bp, 0, j, r);
                for (int s = 0; s < ns; s += 2) {
                    ld_ops<MODE == 3>(B, bp, s + 1, j, r);
                    scan_update<true>(S0, A);
                    if (MODE == 1) scan_update<false>(S1, A);
                    if (MODE == 3) { const float ya = scan_y(S0, A); yt[s * 64] = ya; }
                    if (s + 2 < ns) ld_ops<MODE == 3>(A, bp, s + 2, j, r);
                    scan_update<true>(S0, B);
                    if (MODE == 1) scan_update<false>(S1, B);
                    if (MODE == 3) { const float yb = scan_y(S0, B); yt[(s + 1) * 64] = yb; }
                }
            }
            if (more) SCAN_STORES(cb ^ 1, t0 + 32 + rr);
            __syncthreads();
            if (MODE == 3 && t0 + rr < CL)
                *(f32x4*)(p.Y + (size_t)(b * L + c * CL + t0 + rr) * 1024 + h * 64 + c4) = *(const LAS f32x4*)((LAS float*)(lds + 98304) + cb * 2048 + rr * 64 + c4);
            cb ^= 1;
        }
        if (MODE == 1) {
            float* ps = PSI + ((size_t)(bh * 4 + c) * 64 + r) * 64 + 8 * j; float* ph = PHI + ((size_t)(bh * 4 + c) * 64 + r) * 64 + 8 * j;
            *(f32x4*)(ps) = (f32x4){S0[0][0], S0[0][1], S0[1][0], S0[1][1]}; *(f32x4*)(ps + 4) = (f32x4){S0[2][0], S0[2][1], S0[3][0], S0[3][1]};
            *(f32x4*)(ph) = (f32x4){S1[0][0], S1[0][1], S1[1][0], S1[1][1]}; *(f32x4*)(ph + 4) = (f32x4){S1[2][0], S1[2][1], S1[3][0], S1[3][1]};
        }
#undef SCAN_LOADS
#undef SCAN_STORES
    }
}

__device__ __forceinline__ void post_phase(const CD& p) {
    const int lane = threadIdx.x & 63;
    const int gw = blockIdx.x * 8 + (threadIdx.x >> 6), nw = gridDim.x * 8;
    for (int itb = gw; itb < M * 4; itb += nw * 4) {
        f32x4 vv[4]; u32x2 gv[4];
#pragma unroll
        for (int u = 0; u < 4; ++u) {
            const int it = itb + u * nw, ic = it < M * 4 ? it : 0;
            const size_t o = (size_t)(ic >> 2) * 1024 + (ic & 3) * 256 + lane * 4;
            vv[u] = *(const f32x4*)(p.O + o); gv[u] = *(const u32x2*)(p.GATE + o);
        }
#pragma unroll
        for (int u = 0; u < 4; ++u) {
            const int it = itb + u * nw;
            if (it >= M * 4) continue;
            const int row = it >> 2, h = it & 3;
            const f32x4 v = vv[u]; const u32x2 gt = gv[u];
            const float ss = wave_sum(v[0] * v[0] + v[1] * v[1] + v[2] * v[2] + v[3] * v[3]);
            const float rs = rsqrtf(ss * (1.0f / 256.0f) + 1e-6f);
            u32x2 w; w.x = pk2(v[0] * rs * lo_f(gt.x), v[1] * rs * hi_f(gt.x)); w.y = pk2(v[2] * rs * lo_f(gt.y), v[3] * rs * hi_f(gt.y));
            *(u32x2*)(p.CAT + (size_t)row * D + h * 256 + lane * 4) = w;
        }
    }
    for (int itb = gw; itb < M * 4; itb += nw * 4) {
        f32x4 yv[4], vrv[4], ggv[4]; float bnv[4];
#pragma unroll
        for (int u = 0; u < 4; ++u) {
            const int it = itb + u * nw, ic = it < M * 4 ? it : 0, hh = (ic & 3) * 4 + (lane >> 4);
            const size_t o = (size_t)(ic >> 2) * 1024 + hh * 64 + (lane & 15) * 4;
            yv[u] = *(const f32x4*)(p.Y + o); vrv[u] = *(const f32x4*)(p.VR + o); ggv[u] = *(const f32x4*)(p.G + o); bnv[u] = p.BONUS[(ic >> 2) * 16 + hh];
        }
#pragma unroll
        for (int u = 0; u < 4; ++u) {
        const int it = itb + u * nw;
        if (it >= M * 4) continue;
        const int row = it >> 2, h = (it & 3) * 4 + (lane >> 4), c = h * 64 + (lane & 15) * 4;
        const f32x4 y = yv[u];
        const float mu = sum16((y[0] + y[1]) + (y[2] + y[3])) * (1.0f / 64.0f);
        const f32x4 dv = y - mu;
        const float var = sum16(dv[0] * dv[0] + dv[1] * dv[1] + dv[2] * dv[2] + dv[3] * dv[3]) * (1.0f / 64.0f);
        const float rstd = rsqrtf(var + 64e-5f);
        const f32x4 yn = dv * rstd * *(const f32x4*)(p.rw_ln_g + c) + *(const f32x4*)(p.rw_ln_b + c);
        const f32x4 res = (yn + bnv[u] * vrv[u]) * ggv[u];
        u32x2 w; w.x = pk2(res[0], res[1]); w.y = pk2(res[2], res[3]);
        *(u32x2*)(p.CAT + (size_t)row * D + 1024 + c) = w;
        }
    }
}

struct Params { const float* in[31]; float* out; unsigned char* ws; };

__global__ void __launch_bounds__(NTHREADS, 2) fwd_megakernel(Params prm) {
    extern __shared__ __attribute__((aligned(16))) unsigned char lds_raw[];
    LAS unsigned char* lds = (LAS unsigned char*)lds_raw;
    cg::grid_group grid = cg::this_grid();
    size_t zoff = 0;
    unsigned char* ws = prm.ws;
    {
        unsigned* bw = (unsigned*)(ws + XO_BAR);
        if (blockIdx.x == 0) {
            for (int i = threadIdx.x; i < BAR_WORDS; i += NTHREADS) bw[i] = 0u;
            float* ss = (float*)(ws + XO_SS);
            for (int i = threadIdx.x; i < 3 * M; i += NTHREADS) ss[i] = 0.f;
        }
        if (threadIdx.x < 4) ((LAS unsigned*)(lds + LDS_ST_OFF))[threadIdx.x] = 0u;
        __syncthreads();
    }
    XcdBarrier xbar; xbar.bar = (unsigned*)(ws + XO_BAR); xbar.x = 0; xbar.st = (volatile LAS unsigned*)(lds + LDS_ST_OFF);
#ifndef PROBE_MASK
#define PROBE_MASK 0ull
#endif
#if PROBE_MASK
    unsigned long long tacc = 0ull, tprev = __builtin_amdgcn_s_memrealtime(); int tphase = 0;
#define TICK() do { const unsigned long long _n = __builtin_amdgcn_s_memrealtime(); if (((unsigned long long)(PROBE_MASK) >> tphase) & 1ull) tacc += _n - tprev; tprev = _n; ++tphase; } while (0)
#else
#define TICK() do {} while (0)
#endif
#if PROBE_MASK && defined(PROBE_SPLIT)
#define PSPLIT() do { SYNC(); TICK(); } while (0)
#else
#define PSPLIT() do {} while (0)
#endif
#define GEMM_FULL(FULLM_, A_, Bt_, N_, K_, EP_) do { pg8::StaticOrder S_; S_.init((FULLM_) ? 33 * 256 : MBIG, (N_), (int)gridDim.x, (int)blockIdx.x); const auto ep_ = EP_; \
        pg8::gemm_phase(lds, (A_), (Bt_), (K_), S_, ep_); PSPLIT(); if (!(FULLM_)) gemm_rem_phase(lds, (A_), (Bt_), (N_), (K_), ep_); PSPLIT(); } while (0)
#define SYNC() do { xcd_barrier(xbar); asm volatile("" : "+s"(zoff) :: "memory"); ws = prm.ws + zoff; } while (0)
#define SYNC0() do { grid.sync(); xbar = xcd_barrier_post((unsigned*)(ws + XO_BAR), (volatile LAS unsigned*)(lds + LDS_ST_OFF)); asm volatile("" : "+s"(zoff) :: "memory"); ws = prm.ws + zoff; } while (0)
#define WSF(off) ((float*)(ws + (off)))
#define WSB(off) ((bf16_t*)(ws + (off)))
#define CTR(j) ((unsigned*)(ws + XO_BAR) + 3456 + (j))
#define SSQ(j) (WSF(XO_SS) + (j) * M)
#define MKCD(p) CD p; \
        p.z2 = WSF(OFF_Z); p.gla_w2 = prm.in[10]; p.gla_b = prm.in[11]; p.gla_norm_g = prm.in[12]; p.rw_mu = prm.in[13]; p.rw_w0 = prm.in[14]; p.rw_a0 = prm.in[16]; \
        p.rw_kk = prm.in[19]; p.rw_ka = prm.in[20]; p.rw_rk = prm.in[21]; p.rw_ln_g = prm.in[22]; p.rw_ln_b = prm.in[23]; \
        p.R = WSF(XO_R); p.KR = WSF(XO_KR); p.VR = WSF(XO_VR); p.G = WSF(XO_G); p.Y = WSF(XO_Y); \
        p.CDEC = WSF(XO_CDEC); p.BONUS = WSF(XO_BONUS); p.DECAY = WSF(ZO_DECAY); p.A = WSF(ZO_A); p.KK = WSF(ZO_KK); p.O = WSF(ZO_O); \
        p.LW = WSB(XO_LW); p.LA = WSB(XO_LA); p.LG = WSB(XO_LG); p.GATE = WSB(XO_GATE); \
        p.QDEC = WSB(XO_QDEC); p.KDEC = WSB(XO_KDEC); p.K2T = WSB(XO_K2T); p.VT = WSB(XO_VT); \
        p.W2T = WSB(XO_W2T); p.A2T = WSB(XO_A2T); p.G2T = WSB(XO_G2T); \
        p.CST = WSB(ZO_CST); p.SPT = WSB(ZO_SPT); p.P = WSB(ZO_P); p.CAT = WSB(OFF_ACT);

    rms_phase<1>(nullptr, WSF(OFF_H), prm.in[0], prm.in[1], prm.in[25], WSB(OFF_HN), nullptr);
    convert_wt(prm.in[2], WSB(XO_WB), D, NAB, NAB, nullptr, lds);
    convert_wt(prm.in[15], WSB(XO_W2T), 64, 1024, 1024, nullptr, lds);
    convert_wt(prm.in[17], WSB(XO_A2T), 64, 1024, 1024, nullptr, lds);
    convert_wt(prm.in[18], WSB(XO_G2T), 128, 1024, 1024, nullptr, lds);
    SYNC0(); TICK();
    GEMM_FULL(1, WSB(OFF_HN), WSB(XO_WB), NAB, D, (EpStoreBf16{WSB(OFF_Z), NAB}));
    convert_steal(prm.in[8], WSB(XO_WC), D, D, D, nullptr, CTR(0), lds);
    convert_steal<true>(prm.in[27], WSB(OFF_W), D, NUP, NUP, prm.in[26], CTR(1), lds);
    SYNC(); TICK();
    mixer_ab_phase(WSB(OFF_Z), prm.in[3], prm.in[4], prm.in[5], prm.in[6], prm.in[7], WSB(OFF_ACT), lds);
    SYNC(); TICK();
    GEMM_FULL(0, WSB(OFF_ACT), WSB(XO_WC), D, D, (EpResid0{prm.in[0], prm.in[1], WSF(OFF_H), WSB(OFF_HN), SSQ(0)}));
    SYNC(); TICK();
    GEMM_FULL(1, WSB(OFF_HN), WSB(OFF_W), NUP, D, (EpGate{WSB(OFF_ACT), WSB(OFF_Z), SSQ(0), prm.in[28]}));
    convert_steal(prm.in[29], WSB(XO_WC), DFF, D, D, nullptr, CTR(2), lds);
    convert_steal(prm.in[9], WSB(XO_WB), D, NCD, NCDP, prm.in[25] + D, CTR(3), lds);
    SYNC(); TICK();
    gate_fixup_phase(WSB(OFF_Z), prm.in[28], WSB(OFF_ACT));
    SYNC(); TICK();
    GEMM_FULL(0, WSB(OFF_ACT), WSB(XO_WC), D, DFF, (EpResid{WSF(OFF_H), WSB(OFF_HN), SSQ(1)}));
    SYNC(); TICK();
    GEMM_FULL(1, WSB(OFF_HN), WSB(XO_WB), NCDP, D, (EpScaleStoreF32{WSF(OFF_Z), NCDP, SSQ(1)}));
    convert_steal(prm.in[24], WSB(XO_WC), D, D, D, nullptr, CTR(4), lds);
    convert_steal<true>(prm.in[27] + (size_t)D * NUP, WSB(OFF_W), D, NUP, NUP, prm.in[26] + D, CTR(5), lds);
    SYNC(); TICK();
    { MKCD(p) prep1_phase(p, lds); }
    SYNC(); TICK();
    { MKCD(p) small_gemm_phase(p); }
    SYNC(); TICK();
    { MKCD(p) prep2_phase(p); }
    { MKCD(p) rwkv_scan_pass<1>(p, WSF(ZO_PSI), WSF(ZO_PHI), lds); }
    SYNC(); TICK();
    { MKCD(p) gla_out_phase(p); }
    { MKCD(p) rwkv_scan_pass<3>(p, WSF(ZO_PSI), WSF(ZO_PHI), lds); }
    SYNC(); TICK();
    { MKCD(p) post_phase(p); }
    SYNC(); TICK();
    GEMM_FULL(0, WSB(OFF_ACT), WSB(XO_WC), D, D, (EpResid{WSF(OFF_H), WSB(OFF_HN), SSQ(2)}));
    SYNC(); TICK();
    GEMM_FULL(1, WSB(OFF_HN), WSB(OFF_W), NUP, D, (EpGate{WSB(OFF_ACT), WSB(OFF_Z), SSQ(2), prm.in[28] + (size_t)3 * NUP}));
    convert_steal(prm.in[29] + (size_t)DFF * D, WSB(XO_WC), DFF, D, D, nullptr, CTR(6), lds);
    SYNC(); TICK();
    gate_fixup_phase(WSB(OFF_Z), prm.in[28] + (size_t)3 * NUP, WSB(OFF_ACT));
    SYNC(); TICK();
    GEMM_FULL(0, WSB(OFF_ACT), WSB(XO_WC), D, DFF, (EpAddF32{WSF(OFF_H), D}));
    SYNC(); TICK();
    rms_phase<2>(WSF(OFF_H), nullptr, nullptr, nullptr, prm.in[30], nullptr, prm.out);
#if PROBE_MASK
    TICK();
    if (blockIdx.x == 0) { const unsigned long long t0 = __builtin_amdgcn_s_memrealtime(); while (__builtin_amdgcn_s_memrealtime() - t0 < tacc) __builtin_amdgcn_s_sleep(8); }
#endif
}

extern "C" void kernel_launch(void* const* d_in, const int* in_sizes, int n_in, void* d_out, int out_size, void* d_ws, size_t ws_size, hipStream_t stream) {
    static int grid_blocks = 0;
    if (!grid_blocks) {
        if (n_in != 31 || ws_size < WS_END) { fprintf(stderr, "kernel_launch: expected 31 inputs and >= %zu bytes of workspace (got %d, %zu)\n", (size_t)WS_END, n_in, ws_size); grid_blocks = -1; return; }
        int dev = 0, cus = 0, per_cu = 0;
        hipGetDevice(&dev);
        hipDeviceGetAttribute(&cus, hipDeviceAttributeMultiprocessorCount, dev);
        hipFuncSetAttribute((const void*)fwd_megakernel, hipFuncAttributeMaxDynamicSharedMemorySize, LDS_BYTES);
        hipOccupancyMaxActiveBlocksPerMultiprocessor(&per_cu, (const void*)fwd_megakernel, NTHREADS, LDS_BYTES);
        if (per_cu < 1) per_cu = 1;
        if (per_cu > 1) per_cu = 1;
        (void)hipGetLastError();
        grid_blocks = cus * per_cu;
    }
    if (grid_blocks < 0) return;
    Params p{};
    for (int i = 0; i < 31; ++i) p.in[i] = (const float*)d_in[i];
    p.out = (float*)d_out; p.ws = (unsigned char*)d_ws;
    void* args[] = {&p};
    hipError_t e = hipLaunchCooperativeKernel((const void*)fwd_megakernel, dim3(grid_blocks), dim3(NTHREADS), args, LDS_BYTES, stream);
    if (e != hipSuccess) fprintf(stderr, "cooperative launch failed: %s (grid %d)\n", hipGetErrorString(e), grid_blocks);
}
```
